# Optimizing an MI355X kernel written in HIP

```python
import jax, jax.numpy as jnp
from jax import lax
import numpy as np

D_MODEL = 1024
BATCH = 16
SEQ = 2048
DEPTH = 2
DEC_BATCH = 32
DEC_SEQ = 32
PAST_LEN = 4096

CHUNK = 64
Q_BLOCK = 128
D_PLE = 256
SB_HEADS = 8
SB_HEAD_DIM = 64
MLA_HEADS = 8
MLA_NOPE = 64
MLA_ROPE = 32
MLA_V = 64
KV_LORA = 128
D_FF = 2816
CONV_W = 3
ROPE_THETA = 10000.0
EPS = 1e-6

SB_W = SB_HEADS * SB_HEAD_DIM
MLA_QW = MLA_HEADS * (MLA_NOPE + MLA_ROPE)
MLA_OW = MLA_HEADS * MLA_V
IN_COLS = 3 * SB_W + MLA_QW + KV_LORA + MLA_ROPE + 2 * D_MODEL
SPLIT_POINTS = (SB_W, 2 * SB_W, 3 * SB_W, 3 * SB_W + MLA_QW, 3 * SB_W + MLA_QW + KV_LORA,
                3 * SB_W + MLA_QW + KV_LORA + MLA_ROPE, 3 * SB_W + MLA_QW + KV_LORA + MLA_ROPE + D_MODEL)
SB_SCALE = SB_HEAD_DIM ** -0.5
MLA_SCALE = (MLA_NOPE + MLA_ROPE) ** -0.5

kernel_name = 'stickbreak_mla_convffn_stream_step'


def rmsnorm(x, g):
    xf = x.astype(jnp.float32)
    y = xf * lax.rsqrt(jnp.mean(xf * xf, axis=-1, keepdims=True) + EPS)
    return (y * g.astype(jnp.float32)).astype(x.dtype)


def rope(x, pos):
    half = x.shape[-1] // 2
    freqs = jnp.power(ROPE_THETA, -jnp.arange(half, dtype=jnp.float32) / half)
    ang = pos.astype(jnp.float32)[:, None] * freqs[None, :]
    shape = (1, pos.shape[0]) + (1,) * (x.ndim - 3) + (half,)
    cos, sin = jnp.cos(ang).reshape(shape), jnp.sin(ang).reshape(shape)
    xf = x.astype(jnp.float32)
    x1, x2 = xf[..., :half], xf[..., half:]
    return jnp.concatenate([x1 * cos - x2 * sin, x1 * sin + x2 * cos], axis=-1).astype(x.dtype)


def sb_attend(q, k, v, q_pos, k_pos):
    z = jnp.einsum('bqhd,bkhd->bhqk', q, k).astype(jnp.float32) * SB_SCALE
    visible = k_pos[None, :] < q_pos[:, None]
    log_1mb = jnp.where(visible, jax.nn.log_sigmoid(-z), 0.0)
    suffix = lax.cumsum(log_1mb, axis=3, reverse=True) - log_1mb
    a = jnp.where(visible, jnp.exp(jax.nn.log_sigmoid(z) + suffix), 0.0)
    return jnp.einsum('bhqk,bkhd->bqhd', a.astype(v.dtype), v)


def mla_attend(q_lat, q_rope, c_kv, k_rope, q_pos, k_pos):
    s = (jnp.einsum('bqhl,bkl->bhqk', q_lat, c_kv).astype(jnp.float32)
         + jnp.einsum('bqhr,bkr->bhqk', q_rope, k_rope).astype(jnp.float32)) * MLA_SCALE
    visible = (k_pos[None, :] // CHUNK) <= (q_pos[:, None] // CHUNK)
    p = jax.nn.softmax(jnp.where(visible, s, -jnp.inf), axis=-1)
    return jnp.einsum('bhqk,bkl->bqhl', p.astype(c_kv.dtype), c_kv)


def sweep_query_blocks(fn, qs, q_pos):
    B, S = qs[0].shape[:2]
    nb = S // Q_BLOCK
    def to_blocks(a):
        return jnp.moveaxis(a.reshape((B, nb, Q_BLOCK) + a.shape[2:]), 1, 0)
    out = lax.map(lambda args: fn(args[0], args[1]),
                  (tuple(to_blocks(a) for a in qs), q_pos.reshape(nb, Q_BLOCK)))
    out = jnp.moveaxis(out, 0, 1)
    return out.reshape((B, S) + out.shape[3:])


def trunk_layer(x, p, pos, past, lw):
    (w_in, ckv_gain, w_uk, w_uv, w_proj_sb, w_proj_mla, w_out, g_pre_mix, g_post_mix,
     g_pre_ffn, g_post_ffn, w_up, conv_w, conv_b, w_down, w_ple_gate, w_ple_proj) = lw
    B, T, _ = x.shape
    h = rmsnorm(x, g_pre_mix)
    q_sb, k_sb, v_sb, q_mla, ckv, k_rope, gate_a, gate_b = jnp.split(h @ w_in, SPLIT_POINTS, axis=-1)
    q_sb = q_sb.reshape(B, T, SB_HEADS, SB_HEAD_DIM)
    k_sb = k_sb.reshape(B, T, SB_HEADS, SB_HEAD_DIM)
    v_sb = v_sb.reshape(B, T, SB_HEADS, SB_HEAD_DIM)
    q_mla = q_mla.reshape(B, T, MLA_HEADS, MLA_NOPE + MLA_ROPE)
    q_nope, q_rope = q_mla[..., :MLA_NOPE], rope(q_mla[..., MLA_NOPE:], pos)
    ckv = rmsnorm(ckv, ckv_gain)
    k_rope = rope(k_rope, pos)
    q_lat = jnp.einsum('bthn,lhn->bthl', q_nope, w_uk)
    if past is None:
        k_pos = pos
        conv_past = jnp.zeros((B, CONV_W - 1, 2 * D_FF), x.dtype)
        o_sb = sweep_query_blocks(lambda qs, qp: sb_attend(qs[0], k_sb, v_sb, qp, k_pos), (q_sb,), pos)
        o_lat = sweep_query_blocks(lambda qs, qp: mla_attend(qs[0], qs[1], ckv, k_rope, qp, k_pos),
                                   (q_lat, q_rope), pos)
    else:
        pk, pv, pc, pr, conv_past = past
        k_all = jnp.concatenate([pk, k_sb], axis=1)
        v_all = jnp.concatenate([pv, v_sb], axis=1)
        c_all = jnp.concatenate([pc, ckv], axis=1)
        r_all = jnp.concatenate([pr, k_rope], axis=1)
        k_pos = jnp.arange(pk.shape[1] + T, dtype=jnp.int32)
        o_sb = sb_attend(q_sb, k_all, v_all, pos, k_pos)
        o_lat = mla_attend(q_lat, q_rope, c_all, r_all, pos, k_pos)
    o_mla = jnp.einsum('bthl,lhv->bthv', o_lat, w_uv)
    y_a = o_sb.reshape(B, T, SB_W) @ w_proj_sb
    y_b = o_mla.reshape(B, T, MLA_OW) @ w_proj_mla
    mix = (jax.nn.sigmoid(gate_a) * y_a + jax.nn.sigmoid(gate_b) * y_b) @ w_out
    x = x + rmsnorm(mix, g_post_mix)
    u = rmsnorm(x, g_pre_ffn) @ w_up
    u_ext = jnp.concatenate([conv_past, u], axis=1)
    uc = conv_b
    for i in range(CONV_W):
        uc = uc + u_ext[:, i:i + T] * conv_w[i]
    gate, val = uc[..., :D_FF], uc[..., D_FF:]
    f = (jax.nn.gelu(gate, approximate=True) * val) @ w_down
    x = x + rmsnorm(f, g_post_ffn)
    x = x + jax.nn.sigmoid(x @ w_ple_gate) * (p @ w_ple_proj)
    new_conv = u_ext[:, -(CONV_W - 1):]
    return x, (k_sb, v_sb, ckv, k_rope, new_conv)


def setup_inputs(seed: int = 0) -> dict:
    key = jax.random.key(seed)
    ks = jax.random.split(key, 32)
    def nrm(k, shape, scale=1.0):
        return jax.random.normal(k, shape, jnp.float32) * scale
    def gain(k, n):
        return 1.0 + 0.01 * jax.random.normal(k, (DEPTH, n), jnp.float32)
    return {
        'x_prompt': nrm(ks[0], (BATCH, SEQ, D_MODEL)),
        'x_sample': nrm(ks[1], (DEC_BATCH, DEC_SEQ, D_MODEL)),
        'p_prompt': nrm(ks[2], (DEPTH, BATCH, SEQ, D_PLE)),
        'p_sample': nrm(ks[3], (DEPTH, DEC_BATCH, DEC_SEQ, D_PLE)),
        'cache_sb_k': nrm(ks[4], (DEPTH, DEC_BATCH, PAST_LEN, SB_HEADS, SB_HEAD_DIM)),
        'cache_sb_v': nrm(ks[5], (DEPTH, DEC_BATCH, PAST_LEN, SB_HEADS, SB_HEAD_DIM)),
        'cache_mla_ckv': nrm(ks[6], (DEPTH, DEC_BATCH, PAST_LEN, KV_LORA)),
        'cache_mla_krope': nrm(ks[7], (DEPTH, DEC_BATCH, PAST_LEN, MLA_ROPE)),
        'state_ffn_conv': nrm(ks[8], (DEPTH, DEC_BATCH, CONV_W - 1, 2 * D_FF)),
        'w_in': nrm(ks[9], (DEPTH, D_MODEL, IN_COLS), D_MODEL ** -0.5),
        'ckv_gain': gain(ks[10], KV_LORA),
        'w_uk': nrm(ks[11], (DEPTH, KV_LORA, MLA_HEADS, MLA_NOPE), KV_LORA ** -0.5),
        'w_uv': nrm(ks[12], (DEPTH, KV_LORA, MLA_HEADS, MLA_V), KV_LORA ** -0.5),
        'w_proj_sb': nrm(ks[13], (DEPTH, SB_W, D_MODEL), SB_W ** -0.5),
        'w_proj_mla': nrm(ks[14], (DEPTH, MLA_OW, D_MODEL), MLA_OW ** -0.5),
        'w_out': nrm(ks[15], (DEPTH, D_MODEL, D_MODEL), D_MODEL ** -0.5),
        'g_pre_mix': gain(ks[16], D_MODEL),
        'g_post_mix': gain(ks[17], D_MODEL),
        'g_pre_ffn': gain(ks[18], D_MODEL),
        'g_post_ffn': gain(ks[19], D_MODEL),
        'w_up': nrm(ks[20], (DEPTH, D_MODEL, 2 * D_FF), D_MODEL ** -0.5),
        'conv_w': nrm(ks[21], (DEPTH, CONV_W, 2 * D_FF), CONV_W ** -0.5),
        'conv_b': nrm(ks[22], (DEPTH, 2 * D_FF), 0.01),
        'w_down': nrm(ks[23], (DEPTH, D_FF, D_MODEL), D_FF ** -0.5),
        'w_ple_gate': nrm(ks[24], (DEPTH, D_MODEL, D_MODEL), D_MODEL ** -0.5),
        'w_ple_proj': nrm(ks[25], (DEPTH, D_PLE, D_MODEL), D_PLE ** -0.5),
    }


def reference(x_prompt, x_sample, p_prompt, p_sample, cache_sb_k, cache_sb_v, cache_mla_ckv,
              cache_mla_krope, state_ffn_conv, w_in, ckv_gain, w_uk, w_uv, w_proj_sb, w_proj_mla,
              w_out, g_pre_mix, g_post_mix, g_pre_ffn, g_post_ffn, w_up, conv_w, conv_b, w_down,
              w_ple_gate, w_ple_proj):
    T_p = x_prompt.shape[1]
    T_s = x_sample.shape[1]
    past_len = cache_sb_k.shape[2]
    pos_p = jnp.arange(T_p, dtype=jnp.int32)
    pos_s = past_len + jnp.arange(T_s, dtype=jnp.int32)
    xp, xs = x_prompt, x_sample
    st_p, st_s = [], []
    for i in range(DEPTH):
        lw = (w_in[i], ckv_gain[i], w_uk[i], w_uv[i], w_proj_sb[i], w_proj_mla[i], w_out[i],
              g_pre_mix[i], g_post_mix[i], g_pre_ffn[i], g_post_ffn[i], w_up[i], conv_w[i],
              conv_b[i], w_down[i], w_ple_gate[i], w_ple_proj[i])
        xp, sp = trunk_layer(xp, p_prompt[i], pos_p, None, lw)
        past = (cache_sb_k[i], cache_sb_v[i], cache_mla_ckv[i], cache_mla_krope[i], state_ffn_conv[i])
        xs, ss = trunk_layer(xs, p_sample[i], pos_s, past, lw)
        st_p.append(sp)
        st_s.append(ss)
    sbk_p = jnp.stack([s[0] for s in st_p])
    sbv_p = jnp.stack([s[1] for s in st_p])
    ckv_p = jnp.stack([s[2] for s in st_p])
    kr_p = jnp.stack([s[3] for s in st_p])
    conv_p = jnp.stack([s[4] for s in st_p])
    sbk_s = jnp.stack([s[0] for s in st_s])
    sbv_s = jnp.stack([s[1] for s in st_s])
    ckv_s = jnp.stack([s[2] for s in st_s])
    kr_s = jnp.stack([s[3] for s in st_s])
    conv_s = jnp.stack([s[4] for s in st_s])
    return (xp, xs, sbk_p, sbv_p, ckv_p, kr_p, conv_p, sbk_s, sbv_s, ckv_s, kr_s, conv_s)
```

```cpp
#include <hip/hip_runtime.h>
#include <cstdio>
#include <cstdint>
#include <cmath>
#define MK_PER_PHASE 0
namespace pg8 {
#define PG8_LAS __attribute__((address_space(3)))
typedef unsigned short bf16_t;
typedef short bf16x8 __attribute__((ext_vector_type(8)));
typedef float f32x4 __attribute__((ext_vector_type(4)));
typedef unsigned u32x4 __attribute__((ext_vector_type(4)));
constexpr int BM = 256, BK = 64, HALF = 128, HTB = HALF * BK * 2  , STAGE_BYTES = 8 * HTB, NXCD = 8, WGM = 8;

__host__ __device__ __forceinline__ int lds_byte(int r, int c) { const int st = (r >> 4) * 2 + (c >> 5), rr = r & 15, cc = c & 31, ob = rr * 64 + cc * 2; return st * 1024 + (ob ^ (((ob >> 9) & 1) << 5)); }
__host__ __device__ __forceinline__ void stage_rc(int b, int& R, int& C) { const int st = b / 1024, sb = b % 1024, swz = sb ^ (((sb >> 9) & 1) << 5); R = (st >> 1) * 16 + swz / 64; C = (st & 1) * 32 + (swz % 64) / 2; }
__host__ __device__ __forceinline__ int perm32(int rho) { const int n = rho >> 4, i = rho & 15; return 8 * (i >> 2) + 4 * n + (i & 3); }

struct Unit { int pm, pn; };
struct Gemm { const bf16_t* A; const bf16_t* Bt; int M, N, K; };

struct StaticOrder {
    int nM, nN, nwg, G, c;
    __host__ __device__ void init(int M, int N, int G_, int c_) { nM = M / BM; nN = N / BM; nwg = nM * nN; G = G_; c = c_; }
    __host__ __device__ bool next(int i, Unit& u) const {
        const long L = (long)i * G + c; if (L >= nwg) return false;
        int wgid = (int)L; { const int q = nwg / NXCD, r = nwg % NXCD, xcd = wgid % NXCD, off = wgid / NXCD; wgid = (xcd < r ? xcd * (q + 1) : r * (q + 1) + (xcd - r) * q) + off; }
        const int nig = WGM * nN, gid = wgid / nig, fm = gid * WGM, gsz = (nM - fm) < WGM ? (nM - fm) : WGM;
        u.pm = fm + ((wgid % nig) % gsz); u.pn = (wgid % nig) / gsz; return true;
    }
    __device__ __forceinline__ void a_ready(const Unit&) const {}
    __device__ __forceinline__ void done(const Unit&) const {}
};

typedef float f32x2_cv __attribute__((ext_vector_type(2))); typedef __bf16 bf16x2_cv __attribute__((ext_vector_type(2)));
__device__ __forceinline__ unsigned cvt_pk_bf16(float lo, float hi) { unsigned r; asm volatile("v_cvt_pk_bf16_f32 %0, %1, %2" : "=v"(r) : "v"(lo), "v"(hi)); return r; }
__device__ __forceinline__ unsigned cvt_pk_bf16_c(float lo, float hi) { f32x2_cv v = {lo, hi}; bf16x2_cv b = __builtin_convertvector(v, bf16x2_cv); return __builtin_bit_cast(unsigned, b); }
typedef float f32x2 __attribute__((ext_vector_type(2)));
template <class Epi, class Sched, bool ALIGN_EPI = false, bool SP2 = false>
__device__ __forceinline__ void gemm_phase(PG8_LAS unsigned char* lds, const Gemm g, const Sched& S, const Epi& E, const int wave_id) {
    int tid_; asm volatile("v_mbcnt_lo_u32_b32 %0, -1, 0\n\tv_mbcnt_hi_u32_b32 %0, -1, %0" : "=v"(tid_)); tid_ += wave_id * 64;
    const int tid = tid_, wid = __builtin_amdgcn_readfirstlane(tid >> 6), lane = tid & 63, wr = wid >> 2, wc = wid & 3, fr = lane & 15, fq = lane >> 4;
    const int K = g.K, nt = K / BK;
    unsigned voffA[2], voffB[2];
#pragma unroll
    for (int i = 0; i < 2; ++i) { int R, C; stage_rc(tid * 16 + i * 8192, R, C); const int Rb = Epi::PERM ? ((R & ~31) + perm32(R & 31)) : R;
        voffA[i] = (unsigned)(R * K + C) * 2u; voffB[i] = (unsigned)(Rb * K + C) * 2u; }
    const size_t kstep = (size_t)(BK * 2);
    const size_t hstep = (size_t)HALF * K * 2;
    const size_t tstep = 2 * hstep;
    const unsigned ldsw = (unsigned)wid * 1024u;
    const int aoff = lds_byte(wr * 64 + fr, fq * 8), boff = lds_byte(wc * 32 + fr, fq * 8);
#define PG8_SA(b, h) (((b) * 2 + (h)) * HTB)
#define PG8_SB(b, h) ((4 + (b) * 2 + (h)) * HTB)
#define PG8_STAGE(bufoff, gbase, voff) do { _Pragma("unroll") for (int _i = 0; _i < 2; ++_i) \
        __builtin_amdgcn_global_load_lds((const unsigned*)((const char*)(gbase) + (voff)[_i]), (PG8_LAS unsigned*)(lds + (bufoff) + ldsw + _i * 8192), 16, 0, 0); } while (0)
#define PG8_LDA(dst, b, h) do { _Pragma("unroll") for (int m = 0; m < 4; ++m) _Pragma("unroll") for (int k = 0; k < 2; ++k) dst[m][k] = *(const PG8_LAS bf16x8*)(lds + PG8_SA(b, h) + aoff + m * 2048 + k * 1024); } while (0)
#define PG8_LDB(dst, b, h) do { _Pragma("unroll") for (int n = 0; n < 2; ++n) _Pragma("unroll") for (int k = 0; k < 2; ++k) dst[n][k] = *(const PG8_LAS bf16x8*)(lds + PG8_SB(b, h) + boff + n * 2048 + k * 1024); } while (0)
#define PG8_MMA(ai, bj, At, Bt) do { __builtin_amdgcn_s_setprio(1); _Pragma("unroll") for (int m = 0; m < 4; ++m) _Pragma("unroll") for (int n = 0; n < 2; ++n) _Pragma("unroll") for (int k = 0; k < 2; ++k) \
        acc[ai][bj][m][n] = __builtin_amdgcn_mfma_f32_16x16x32_bf16(Bt[n][k], At[m][k], acc[ai][bj][m][n], 0, 0, 0); __builtin_amdgcn_s_setprio(0); } while (0)
#define PG8_WAIT_V(n) asm volatile("s_waitcnt vmcnt(" #n ")" ::: "memory")
#define PG8_WAIT_L(n) asm volatile("s_waitcnt lgkmcnt(" #n ")" ::: "memory")
#define PG8_BAR __builtin_amdgcn_s_barrier()
#define PG8_SCHED __builtin_amdgcn_sched_barrier(0)
    Unit cur, nxt; int ui = 0;
    if (!S.next(0, cur)) return;
    f32x4 acc[2][2][4][2];
#pragma unroll
    for (int a = 0; a < 2; ++a)
#pragma unroll
        for (int b = 0; b < 2; ++b)
#pragma unroll
            for (int m = 0; m < 4; ++m)
#pragma unroll
                for (int n = 0; n < 2; ++n) acc[a][b][m][n] = (f32x4){0.f, 0.f, 0.f, 0.f};
    bf16x8 At[4][2], B0[2][2], B1[2][2];
    const char* cA = (const char*)g.A + (size_t)cur.pm * tstep; const char* cB = (const char*)g.Bt + (size_t)cur.pn * tstep;
    S.a_ready(cur);
    if constexpr (SP2) {
        PG8_STAGE(PG8_SB(0, 0), cB, voffB); PG8_STAGE(PG8_SB(0, 1), cB + hstep, voffB); PG8_STAGE(PG8_SA(0, 0), cA, voffA); PG8_STAGE(PG8_SA(0, 1), cA + hstep, voffA);
        if (wr == 1) PG8_BAR;
        PG8_WAIT_V(2); PG8_BAR;
        PG8_STAGE(PG8_SB(1, 0), cB + kstep, voffB); PG8_STAGE(PG8_SA(1, 0), cA + kstep, voffA); PG8_STAGE(PG8_SB(1, 1), cB + hstep + kstep, voffB);
        PG8_WAIT_V(6); PG8_BAR;
    } else {
        PG8_STAGE(PG8_SB(0, 0), cB, voffB); PG8_STAGE(PG8_SA(0, 0), cA, voffA); PG8_STAGE(PG8_SB(0, 1), cB + hstep, voffB); PG8_STAGE(PG8_SA(0, 1), cA + hstep, voffA);
        if (wr == 1) PG8_BAR;
        PG8_WAIT_V(4); PG8_BAR;
        PG8_STAGE(PG8_SB(1, 0), cB + kstep, voffB); PG8_STAGE(PG8_SA(1, 0), cA + kstep, voffA); PG8_STAGE(PG8_SB(1, 1), cB + hstep + kstep, voffB);
        PG8_WAIT_V(6); PG8_BAR;
    }
    for (;;) {
        const bool has_next = S.next(ui + 1, nxt);
        const char* nA = has_next ? (const char*)g.A + (size_t)nxt.pm * tstep : cA; const char* nB = has_next ? (const char*)g.Bt + (size_t)nxt.pn * tstep : cB;
        for (int t = 0; t < nt; t += 2) {
            const bool last = (t == nt - 2);
            const char* a1 = cA + (size_t)(t + 1) * kstep;
            const char* a2 = last ? nA : cA + (size_t)(t + 2) * kstep; const char* b2 = last ? nB : cB + (size_t)(t + 2) * kstep;
            const char* a3 = a2 + kstep; const char* b3 = b2 + kstep;
            if (last && has_next) S.a_ready(nxt);
            if constexpr (SP2) {
            PG8_LDB(B0, 0, 0); PG8_LDB(B1, 0, 1); PG8_SCHED; PG8_LDA(At, 0, 0); PG8_STAGE(PG8_SA(1, 1), a1 + hstep, voffA);
            PG8_WAIT_V(8); PG8_WAIT_L(0); PG8_BAR; PG8_MMA(0, 0, At, B0); PG8_MMA(0, 1, At, B1); PG8_BAR; PG8_SCHED;
            PG8_LDA(At, 0, 1); PG8_STAGE(PG8_SB(0, 0), b2, voffB); PG8_STAGE(PG8_SB(0, 1), b2 + hstep, voffB); PG8_STAGE(PG8_SA(0, 0), a2, voffA);
            PG8_WAIT_V(8); PG8_WAIT_L(0); PG8_BAR; PG8_MMA(1, 0, At, B0); PG8_MMA(1, 1, At, B1); PG8_BAR; PG8_SCHED;
            PG8_LDB(B0, 1, 0); PG8_LDB(B1, 1, 1); PG8_SCHED; PG8_LDA(At, 1, 0); PG8_STAGE(PG8_SA(0, 1), a2 + hstep, voffA);
            PG8_WAIT_V(8); PG8_WAIT_L(0); PG8_BAR; PG8_MMA(0, 0, At, B0); PG8_MMA(0, 1, At, B1); PG8_BAR; PG8_SCHED;
            PG8_LDA(At, 1, 1); PG8_STAGE(PG8_SB(1, 0), b3, voffB); PG8_STAGE(PG8_SB(1, 1), b3 + hstep, voffB); PG8_STAGE(PG8_SA(1, 0), a3, voffA);
            PG8_WAIT_V(8); PG8_WAIT_L(0); PG8_BAR; PG8_MMA(1, 0, At, B0); PG8_MMA(1, 1, At, B1); PG8_BAR; PG8_SCHED;
            } else {
            PG8_LDB(B0, 0, 0); PG8_SCHED; PG8_LDA(At, 0, 0); PG8_STAGE(PG8_SA(1, 1), a1 + hstep, voffA);
            PG8_WAIT_L(8); PG8_BAR; PG8_WAIT_L(0); PG8_MMA(0, 0, At, B0); PG8_BAR; PG8_SCHED;
            PG8_LDB(B1, 0, 1); PG8_STAGE(PG8_SB(0, 0), b2, voffB);
            PG8_BAR; PG8_WAIT_L(0); PG8_MMA(0, 1, At, B1); PG8_BAR;
            PG8_LDA(At, 0, 1); PG8_STAGE(PG8_SA(0, 0), a2, voffA);
            PG8_BAR; PG8_WAIT_L(0); PG8_MMA(1, 0, At, B0); PG8_BAR; PG8_SCHED;
            PG8_STAGE(PG8_SB(0, 1), b2 + hstep, voffB);
            PG8_WAIT_V(6); PG8_BAR; PG8_MMA(1, 1, At, B1); PG8_BAR;
            PG8_LDB(B0, 1, 0); PG8_SCHED; PG8_LDA(At, 1, 0); PG8_STAGE(PG8_SA(0, 1), a2 + hstep, voffA);
            PG8_WAIT_L(8); PG8_BAR; PG8_WAIT_L(0); PG8_MMA(0, 0, At, B0); PG8_BAR; PG8_SCHED;
            PG8_LDB(B1, 1, 1); PG8_STAGE(PG8_SB(1, 0), b3, voffB);
            PG8_BAR; PG8_WAIT_L(0); PG8_MMA(0, 1, At, B1); PG8_BAR;
            PG8_LDA(At, 1, 1); PG8_STAGE(PG8_SA(1, 0), a3, voffA);
            PG8_BAR; PG8_WAIT_L(0); PG8_MMA(1, 0, At, B0); PG8_BAR; PG8_SCHED;
            PG8_STAGE(PG8_SB(1, 1), b3 + hstep, voffB);
            PG8_WAIT_V(6); PG8_BAR; PG8_MMA(1, 1, At, B1); PG8_BAR;
            }
        }
        if constexpr (ALIGN_EPI) { if (wr == 0) PG8_BAR; }
        if constexpr (!Epi::AFTER_DRAIN) { E(acc, cur, wr, wc, fr, fq); S.done(cur); }
        if (!has_next) break;
#pragma unroll
        for (int a = 0; a < 2; ++a)
#pragma unroll
            for (int b = 0; b < 2; ++b)
#pragma unroll
                for (int m = 0; m < 4; ++m)
#pragma unroll
                    for (int n = 0; n < 2; ++n) acc[a][b][m][n] = (f32x4){0.f, 0.f, 0.f, 0.f};
        cur = nxt; cA = nA; cB = nB; ++ui;
        if constexpr (ALIGN_EPI) { if (wr == 1) PG8_BAR; }
    }
    PG8_WAIT_V(0);
    if constexpr (!ALIGN_EPI) { if (wr == 0) PG8_BAR; }
    PG8_BAR;
    if constexpr (Epi::AFTER_DRAIN) { E.fused(acc, cur, wr, wc, fr, fq, lds, wid, lane); S.done(cur); }
#undef PG8_SA
#undef PG8_SB
#undef PG8_STAGE
#undef PG8_LDA
#undef PG8_LDB
#undef PG8_MMA
#undef PG8_WAIT_V
#undef PG8_WAIT_L
#undef PG8_BAR
#undef PG8_SCHED
}
}
#define GAS __attribute__((address_space(1)))
#define LAS __attribute__((address_space(3)))
typedef unsigned short bf16;
typedef unsigned v4u __attribute__((ext_vector_type(4)));
typedef float f32x4 __attribute__((ext_vector_type(4)));
typedef short bf16x8 __attribute__((ext_vector_type(8)));
typedef GAS unsigned gu32;
typedef GAS unsigned long long gu64;
#define RLX_AGENT __ATOMIC_RELAXED, __HIP_MEMORY_SCOPE_AGENT
#define LDS_WAIT() asm volatile("s_waitcnt lgkmcnt(0)" ::: "memory")
#define VM_WAIT() asm volatile("s_waitcnt vmcnt(0)" ::: "memory")
__device__ __forceinline__ unsigned long long rt() { return __builtin_amdgcn_s_memrealtime(); }
__device__ __forceinline__ unsigned f2bf(float f) { unsigned u = __builtin_bit_cast(unsigned, f); return (u + 0x7fffu + ((u >> 16) & 1u)) >> 16; }
__device__ __forceinline__ unsigned pk2(float lo, float hi) { return f2bf(lo) | (f2bf(hi) << 16); }

#define XB_TMO      128
#define XB_XCNT(j)  (256  + 64 * (j))
#define XB_XSUB(j)  (1280 + 64 * (j))
#define XB_XGEN(j)  (2304 + 64 * (j))
#define XB_TOP      3328
#define XB_TOPGEN   3392
#define XCD_BAR_WORDS 3456
#define XB_SPIN_CAP (1u << 18)

__device__ __forceinline__ unsigned xb_ld(unsigned* p)              { return __hip_atomic_load(p, __ATOMIC_RELAXED, __HIP_MEMORY_SCOPE_AGENT); }
__device__ __forceinline__ unsigned xb_add(unsigned* p, unsigned v) { return __hip_atomic_fetch_add(p, v, __ATOMIC_RELAXED, __HIP_MEMORY_SCOPE_AGENT); }
__device__ __forceinline__ unsigned xb_xcc_id() { return (unsigned)__builtin_amdgcn_s_getreg((3 << 11) | 20) & 0xFu; }
#define XB_SPIN(cond, bar) do { unsigned _sp = 0; while (cond) { __builtin_amdgcn_s_sleep(1); \
    if ((++_sp & 255u) == 0u) { if (xb_ld(&(bar)[XB_TMO])) break; if (_sp > XB_SPIN_CAP) { atomicAdd(&(bar)[XB_TMO], 1u); break; } } } } while (0)

struct XcdBarrier {
    unsigned* bar; unsigned x; unsigned w;
    volatile LAS unsigned* st;
};

__device__ __forceinline__ XcdBarrier xcd_barrier_post(unsigned* bar, volatile LAS unsigned* st) {
    XcdBarrier b; b.bar = bar; b.x = xb_xcc_id(); b.st = st; b.w = (unsigned)__builtin_amdgcn_readfirstlane((int)threadIdx.x >> 6);
    if (threadIdx.x == 0) (void)xb_add(&bar[XB_XCNT(b.x)], 1u);
    return b;
}
__device__ __forceinline__ void xcd_barrier_complete(unsigned* bar, unsigned x, unsigned& nloc, unsigned& nx) {
    const unsigned G = gridDim.x * gridDim.y * gridDim.z;
    unsigned sum, cnt, mine, sp = 0u;
    for (;;) {
        sum = 0u; cnt = 0u; mine = 0u;
#pragma unroll
        for (unsigned j = 0; j < 16; ++j) { const unsigned c = xb_ld(&bar[XB_XCNT(j)]); sum += c; cnt += (c > 0u) ? 1u : 0u; mine = (j == x) ? c : mine; }
        if (sum == G) break;
        __builtin_amdgcn_s_sleep(1);
        if ((++sp & 255u) == 0u) { if (xb_ld(&bar[XB_TMO])) break; if (sp > XB_SPIN_CAP) { atomicAdd(&bar[XB_TMO], 1u); break; } }
    }
    nloc = mine > 0u ? mine : 1u; nx = cnt > 0u ? cnt : 1u;
}

__device__ __forceinline__ void xcd_barrier(const XcdBarrier& b) {
    asm volatile("s_waitcnt vmcnt(0)" ::: "memory");
    __syncthreads();
    int l0_; asm volatile("v_mbcnt_lo_u32_b32 %0, -1, 0\n\tv_mbcnt_hi_u32_b32 %0, -1, %0" : "=v"(l0_));
    if (b.w == 0u && l0_ == 0) {
        unsigned* bar = b.bar;
        __builtin_amdgcn_s_waitcnt(0);
        unsigned nloc = b.st[0], nx = b.st[1];
        if (nloc == 0u) { xcd_barrier_complete(bar, b.x, nloc, nx); b.st[0] = nloc; b.st[1] = nx; }
        const unsigned old = xb_add(&bar[XB_XSUB(b.x)], 1u);
        const unsigned gen = old / nloc;
        if (old + 1u == (gen + 1u) * nloc) {
            __builtin_amdgcn_fence(__ATOMIC_RELEASE, "agent");
            asm volatile("s_waitcnt vmcnt(0)" ::: "memory");
            const unsigned og = xb_add(&bar[XB_TOP], 1u);
            const unsigned tg = og / nx;
            if (og + 1u == (tg + 1u) * nx) xb_add(&bar[XB_TOPGEN], 1u);
            else XB_SPIN(xb_ld(&bar[XB_TOPGEN]) == tg, bar);
            __builtin_amdgcn_fence(__ATOMIC_ACQUIRE, "agent");
            xb_add(&bar[XB_XGEN(b.x)], 1u);
            asm volatile("s_waitcnt vmcnt(0)" ::: "memory");
        } else {
            XB_SPIN(xb_ld(&bar[XB_XGEN(b.x)]) == gen, bar);
            __builtin_amdgcn_fence(__ATOMIC_ACQUIRE, "agent");
            asm volatile("s_waitcnt vmcnt(0)" ::: "memory");
        }
    }
    __syncthreads();
}

constexpr int DM = 1024, NB = 16, SEQ = 2048, DEPTH = 2, DBATCH = 32, DSEQ = 32, PAST = 4096;
constexpr int PR = NB * SEQ, SR = DBATCH * DSEQ, R = PR + SR;
constexpr int SBW = 512, LORA = 128, ROPE = 32, QLW = 1024, QRW = 256, DFF = 2816, UPW = 5632, DPLE = 256, NHEAD = 8;
constexpr int INC = 4512, NIN = 5120;
constexpr float EPS = 1e-6f, LOG2E = 1.4426950408889634f;
constexpr float QS_SB = 0.125f * LOG2E;
constexpr float QS_MLA = 0.10206207261596575f * LOG2E;
constexpr int NSLOT = 2048 + 32;

constexpr size_t O_Y = 0;
constexpr size_t O_SBK_P = (size_t)R * DM;
constexpr size_t O_SBV_P = O_SBK_P + (size_t)DEPTH * PR * SBW;
constexpr size_t O_CKV_P = O_SBV_P + (size_t)DEPTH * PR * SBW;
constexpr size_t O_KR_P = O_CKV_P + (size_t)DEPTH * PR * LORA;
constexpr size_t O_CONV_P = O_KR_P + (size_t)DEPTH * PR * ROPE;
constexpr size_t O_SBK_S = O_CONV_P + (size_t)DEPTH * NB * 2 * UPW;
constexpr size_t O_SBV_S = O_SBK_S + (size_t)DEPTH * SR * SBW;
constexpr size_t O_CKV_S = O_SBV_S + (size_t)DEPTH * SR * SBW;
constexpr size_t O_KR_S = O_CKV_S + (size_t)DEPTH * SR * LORA;
constexpr size_t O_CONV_S = O_KR_S + (size_t)DEPTH * SR * ROPE;
constexpr size_t O_END = O_CONV_S + (size_t)DEPTH * DBATCH * 2 * UPW;
static_assert(O_END == 115703808ull, "output map");

constexpr size_t MiB = 1u << 20;
constexpr size_t WS_CTL = 0, CTL_ZERO_BYTES = 1 * MiB;
constexpr size_t WS_ROPE = 1 * MiB;
constexpr size_t WS_W = 4 * MiB, WL = 36 * MiB;
constexpr size_t W_IN = 0, W_SB = 10 * MiB, W_YB = 11 * MiB, W_OUT = 13 * MiB, W_UP = 15 * MiB, W_DOWN = 26 * MiB, W_PG = 32 * MiB, W_PP = 34 * MiB;
constexpr size_t WS_XN = 80 * MiB, WS_QSB = 146 * MiB, WS_KSB = 179 * MiB, WS_VSB = 212 * MiB, WS_QLAT = 245 * MiB, WS_QROPE = 311 * MiB,
                 WS_CKVB = 328 * MiB, WS_KRB = 337 * MiB, WS_GA = 340 * MiB, WS_GB = 406 * MiB, WS_OSB = 472 * MiB, WS_OLAT = 505 * MiB,
                 WS_MG = 571 * MiB, WS_MIX = 637 * MiB, WS_XB = 769 * MiB, WS_PP = 835 * MiB, WS_PB = 967 * MiB, WS_U = 1000 * MiB,
                 WS_ACT = 1363 * MiB, WS_END = 1546 * MiB;
static_assert(W_PP + (size_t)DM * DPLE * 2 <= WL && WS_W + 2 * WL <= WS_XN, "weights map");
static_assert(WS_ACT + (size_t)R * DFF * 2 <= WS_END && WS_U + (size_t)R * UPW * 2 <= WS_ACT && WS_PB + 2 * (size_t)R * DPLE * 2 <= WS_U, "ws map");
constexpr int CW_BAR = 4096;

constexpr int RING_BYTES = 131072, XL_OFF = RING_BYTES, MISC_OFF = RING_BYTES + 8192, LDS_BYTES = 147456;

#ifndef MK_PER_PHASE
#define MK_PER_PHASE 0
#endif
#ifndef MK_PH_END
#define MK_PH_END (2 + 12 * DEPTH)
#endif
constexpr int NPHASE = MK_PH_END;

__device__ __forceinline__ float bf2f(unsigned short b) { return __uint_as_float((unsigned)b << 16); }
__device__ __forceinline__ float lo2f(unsigned w) { return __uint_as_float(w << 16); }
__device__ __forceinline__ float hi2f(unsigned w) { return __uint_as_float(w & 0xffff0000u); }
__device__ __forceinline__ float fexp2(float x) { return __builtin_amdgcn_exp2f(x); }
__device__ __forceinline__ float frcp(float x) { return __builtin_amdgcn_rcpf(x); }
__device__ __forceinline__ float sigm(float x) { return frcp(1.0f + fexp2(-LOG2E * x)); }
__device__ __forceinline__ float wave_sum(float v) {
#pragma unroll
    for (int o = 1; o < 64; o <<= 1) v += __shfl_xor(v, o);
    return v;
}
__device__ __forceinline__ v4u pack8(f32x4 a, f32x4 b) { v4u w; w.x = pg8::cvt_pk_bf16(a[0], a[1]); w.y = pg8::cvt_pk_bf16(a[2], a[3]); w.z = pg8::cvt_pk_bf16(b[0], b[1]); w.w = pg8::cvt_pk_bf16(b[2], b[3]); return w; }
__device__ __forceinline__ v4u pack8c(f32x4 a, f32x4 b) { v4u w; w.x = pg8::cvt_pk_bf16_c(a[0], a[1]); w.y = pg8::cvt_pk_bf16_c(a[2], a[3]); w.z = pg8::cvt_pk_bf16_c(b[0], b[1]); w.w = pg8::cvt_pk_bf16_c(b[2], b[3]); return w; }
__device__ __forceinline__ int ridx(int p) { return ((p >> 2) & 1) * 16 + 4 * (p >> 3) + (p & 3); }
__device__ __forceinline__ int pos_slot(int row) { return row < PR ? (row & (SEQ - 1)) : SEQ + ((row - PR) & (DSEQ - 1)); }

typedef pg8::f32x4 A4;

template <int NN> struct Ord {
    static constexpr int NM = R / 256, WG = 12, NWG = NM * NN, NIG = WG * NN, Q = NWG / 8, RM = NWG % 8;
    static_assert(NM % WG == 0, "row panels per group");
    int G, c;
    __device__ __forceinline__ void init(int G_, int c_) { G = G_; c = c_; }
    __device__ __forceinline__ bool next(int i, pg8::Unit& u) const {
        const int Lx = i * G + c; if (Lx >= NWG) return false;
        const int xcd = Lx & 7, off = Lx >> 3; const int wgid = (xcd < RM ? xcd * (Q + 1) : RM * (Q + 1) + (xcd - RM) * Q) + off;
        const int gid = wgid / NIG, rem = wgid - gid * NIG; u.pm = gid * WG + rem % WG; u.pn = rem / WG; return true;
    }
    __device__ __forceinline__ void a_ready(const pg8::Unit&) const {}
    __device__ __forceinline__ void done(const pg8::Unit&) const {}
};
struct EpiIn {
    static constexpr bool PERM = true, AFTER_DRAIN = false;
    unsigned char* ws_; float* out_; int L; const float* gain; LAS float* xl;
    __device__ __forceinline__ void operator()(const A4 (&acc)[2][2][4][2], const pg8::Unit& u, int wr, int wc, int fr, int fq) const {
        unsigned char* ws = ws_; float* out = out_; asm volatile("" : "+s"(ws), "+s"(out));
        bf16* const QSB = (bf16*)(ws + WS_QSB); bf16* const KSB = (bf16*)(ws + WS_KSB); bf16* const VSB = (bf16*)(ws + WS_VSB); bf16* const QLAT = (bf16*)(ws + WS_QLAT); bf16* const QROPE = (bf16*)(ws + WS_QROPE);
        bf16* const CKVB = (bf16*)(ws + WS_CKVB); bf16* const KRB = (bf16*)(ws + WS_KRB); bf16* const GA = (bf16*)(ws + WS_GA); bf16* const GB = (bf16*)(ws + WS_GB); const float* const tab = (const float*)(ws + WS_ROPE);
        float* const sbk_p = out + O_SBK_P + (size_t)L * PR * SBW; float* const sbv_p = out + O_SBV_P + (size_t)L * PR * SBW; float* const ckv_p = out + O_CKV_P + (size_t)L * PR * LORA; float* const kr_p = out + O_KR_P + (size_t)L * PR * ROPE;
        float* const sbk_s = out + O_SBK_S + (size_t)L * SR * SBW; float* const sbv_s = out + O_SBV_S + (size_t)L * SR * SBW; float* const ckv_s = out + O_CKV_S + (size_t)L * SR * LORA; float* const kr_s = out + O_KR_S + (size_t)L * SR * ROPE;
        const int pn = u.pn; const bool samp = u.pm >= PR / 256;
        const int row0 = u.pm * 256 + wr * 64 + fr;
        if (pn < 2) {
#pragma unroll
            for (int ai = 0; ai < 2; ++ai)
#pragma unroll
                for (int m = 0; m < 4; ++m) { const int row = row0 + ai * 128 + m * 16;
#pragma unroll
                    for (int bj = 0; bj < 2; ++bj) { const int col = pn * 256 + bj * 128 + wc * 32 + 8 * fq;
                        *(v4u*)(QSB + (size_t)row * SBW + col) = pack8(acc[ai][bj][m][0] * QS_SB, acc[ai][bj][m][1] * QS_SB); } }
        } else if (pn < 6) {
            const int which = (pn - 2) >> 1; bf16* B = which ? VSB : KSB;
            float* O = samp ? (which ? sbv_s : sbk_s) : (which ? sbv_p : sbk_p);
#pragma unroll
            for (int ai = 0; ai < 2; ++ai)
#pragma unroll
                for (int m = 0; m < 4; ++m) { const int row = row0 + ai * 128 + m * 16, prow = samp ? row - PR : row;
#pragma unroll
                    for (int bj = 0; bj < 2; ++bj) { const int col = ((pn - 2) & 1) * 256 + bj * 128 + wc * 32 + 8 * fq;
                        const A4 v0 = acc[ai][bj][m][0], v1 = acc[ai][bj][m][1];
                        float* op = O + (size_t)prow * SBW + col; *(A4*)op = v0; *(A4*)(op + 4) = v1;
                        *(v4u*)(B + (size_t)row * SBW + col) = pack8(v0, v1); } }
        } else if (pn < 10) {
#pragma unroll
            for (int ai = 0; ai < 2; ++ai)
#pragma unroll
                for (int m = 0; m < 4; ++m) { const int row = row0 + ai * 128 + m * 16;
#pragma unroll
                    for (int bj = 0; bj < 2; ++bj) { const int col = (pn - 6) * 256 + bj * 128 + wc * 32 + 8 * fq;
                        *(v4u*)(QLAT + (size_t)row * QLW + col) = pack8(acc[ai][bj][m][0] * QS_MLA, acc[ai][bj][m][1] * QS_MLA); } }
        } else if (pn == 10) {
#pragma unroll
            for (int ai = 0; ai < 2; ++ai)
#pragma unroll
                for (int m = 0; m < 4; ++m) { const int row = row0 + ai * 128 + m * 16; const float* tp = tab + pos_slot(row) * 32 + 4 * fq;
                    const A4 cs = *(const A4*)tp, sn = *(const A4*)(tp + 16);
#pragma unroll
                    for (int bj = 0; bj < 2; ++bj) { const int head = bj * 4 + wc; const A4 x1 = acc[ai][bj][m][0], x2 = acc[ai][bj][m][1];
                        const A4 y1 = (x1 * cs - x2 * sn) * QS_MLA, y2 = (x1 * sn + x2 * cs) * QS_MLA;
                        *(v4u*)(QROPE + (size_t)row * QRW + head * 32 + 8 * fq) = pack8(y1, y2); } }
        } else if (pn == 11) {
#pragma unroll
            for (int ai = 0; ai < 2; ++ai)
#pragma unroll
                for (int m = 0; m < 4; ++m) { const A4 a = acc[ai][0][m][0], b = acc[ai][0][m][1];
                    float s = (a[0] * a[0] + a[1] * a[1]) + (a[2] * a[2] + a[3] * a[3]) + (b[0] * b[0] + b[1] * b[1]) + (b[2] * b[2] + b[3] * b[3]);
                    s += __shfl_xor(s, 16); s += __shfl_xor(s, 32);
                    if (fq == 0) xl[(ai * 128 + wr * 64 + m * 16 + fr) * 4 + wc] = s; }
            asm volatile("s_waitcnt lgkmcnt(0)" ::: "memory"); __builtin_amdgcn_s_barrier(); asm volatile("" ::: "memory");
            const int ccol = wc * 32 + 8 * fq; const A4 g0 = *(const A4*)(gain + ccol), g1 = *(const A4*)(gain + ccol + 4);
#pragma unroll
            for (int ai = 0; ai < 2; ++ai)
#pragma unroll
                for (int m = 0; m < 4; ++m) { const int row = row0 + ai * 128 + m * 16, prow = samp ? row - PR : row;
                    const A4 p = *(const LAS A4*)(xl + (ai * 128 + wr * 64 + m * 16 + fr) * 4);
                    const float rs = 1.0f / sqrtf(((p[0] + p[1]) + (p[2] + p[3])) * (1.0f / LORA) + EPS);
                    const A4 v0 = acc[ai][0][m][0] * rs * g0, v1 = acc[ai][0][m][1] * rs * g1;
                    float* op = (samp ? ckv_s : ckv_p) + (size_t)prow * LORA + ccol; *(A4*)op = v0; *(A4*)(op + 4) = v1;
                    *(v4u*)(CKVB + (size_t)row * LORA + ccol) = pack8(v0, v1);
                    if (wc == 0) {
                        const float* tp = tab + pos_slot(row) * 32 + 4 * fq; const A4 cs = *(const A4*)tp, sn = *(const A4*)(tp + 16);
                        const A4 x1 = acc[ai][1][m][0], x2 = acc[ai][1][m][1];
                        const A4 y1 = x1 * cs - x2 * sn, y2 = x1 * sn + x2 * cs;
                        float* kp = (samp ? kr_s : kr_p) + (size_t)prow * ROPE + 4 * fq; *(A4*)kp = y1; *(A4*)(kp + 16) = y2;
                        *(v4u*)(KRB + (size_t)row * ROPE + 8 * fq) = pack8(y1, y2); } }
        } else {
            bf16* G = pn < 16 ? GA : GB;
#pragma unroll
            for (int ai = 0; ai < 2; ++ai)
#pragma unroll
                for (int m = 0; m < 4; ++m) { const int row = row0 + ai * 128 + m * 16;
#pragma unroll
                    for (int bj = 0; bj < 2; ++bj) { const int col = ((pn - 12) & 3) * 256 + bj * 128 + wc * 32 + 8 * fq;
                        const A4 a = acc[ai][bj][m][0], b = acc[ai][bj][m][1];
                        const A4 sa = {sigm(a[0]), sigm(a[1]), sigm(a[2]), sigm(a[3])}, sb = {sigm(b[0]), sigm(b[1]), sigm(b[2]), sigm(b[3])};
                        *(v4u*)(G + (size_t)row * DM + col) = pack8c(sa, sb); } }
        }
    }
};
template <bool ADD> struct EpiGate {
    static constexpr bool PERM = true, AFTER_DRAIN = false;
    const bf16* G; bf16* MG;
    __device__ __forceinline__ void operator()(const A4 (&acc)[2][2][4][2], const pg8::Unit& u, int wr, int wc, int fr, int fq) const {
        const int row0 = u.pm * 256 + wr * 64 + fr;
#pragma unroll
        for (int ai = 0; ai < 2; ++ai)
#pragma unroll
            for (int m = 0; m < 4; ++m) { const int row = row0 + ai * 128 + m * 16;
#pragma unroll
                for (int bj = 0; bj < 2; ++bj) { const size_t off = (size_t)row * DM + u.pn * 256 + bj * 128 + wc * 32 + 8 * fq;
                    const v4u g = *(const v4u*)(G + off);
                    A4 a = acc[ai][bj][m][0] * (A4){lo2f(g.x), hi2f(g.x), lo2f(g.y), hi2f(g.y)}, b = acc[ai][bj][m][1] * (A4){lo2f(g.z), hi2f(g.z), lo2f(g.w), hi2f(g.w)};
                    if (ADD) { const v4u o = *(const v4u*)(MG + off); a += (A4){lo2f(o.x), hi2f(o.x), lo2f(o.y), hi2f(o.y)}; b += (A4){lo2f(o.z), hi2f(o.z), lo2f(o.w), hi2f(o.w)}; }
                    *(v4u*)(MG + off) = pack8(a, b); } }
    }
};
struct EpiF32 {
    static constexpr bool PERM = true, AFTER_DRAIN = false;
    float* O; int ldc;
    __device__ __forceinline__ void operator()(const A4 (&acc)[2][2][4][2], const pg8::Unit& u, int wr, int wc, int fr, int fq) const {
        const int row0 = u.pm * 256 + wr * 64 + fr;
#pragma unroll
        for (int ai = 0; ai < 2; ++ai)
#pragma unroll
            for (int m = 0; m < 4; ++m) { const int row = row0 + ai * 128 + m * 16;
#pragma unroll
                for (int bj = 0; bj < 2; ++bj) { float* op = O + (size_t)row * ldc + u.pn * 256 + bj * 128 + wc * 32 + 8 * fq;
                    *(A4*)op = acc[ai][bj][m][0]; *(A4*)(op + 4) = acc[ai][bj][m][1]; } }
    }
};
struct EpiBf {
    static constexpr bool PERM = true, AFTER_DRAIN = false;
    bf16* O; int ldc; float* conv_p; float* conv_s;
    __device__ __forceinline__ void operator()(const A4 (&acc)[2][2][4][2], const pg8::Unit& u, int wr, int wc, int fr, int fq) const {
        const int row0 = u.pm * 256 + wr * 64 + fr; const bool samp = u.pm >= PR / 256;
#pragma unroll
        for (int ai = 0; ai < 2; ++ai)
#pragma unroll
            for (int m = 0; m < 4; ++m) { const int row = row0 + ai * 128 + m * 16;
                int ci = -1;
                if (conv_p) { if (!samp) { const int t = row & (SEQ - 1); if (t >= SEQ - 2) ci = (row >> 11) * 2 + (t - (SEQ - 2)); }
                              else { const int t = (row - PR) & (DSEQ - 1); if (t >= DSEQ - 2) ci = ((row - PR) >> 5) * 2 + (t - (DSEQ - 2)); } }
#pragma unroll
                for (int bj = 0; bj < 2; ++bj) { const int col = u.pn * 256 + bj * 128 + wc * 32 + 8 * fq;
                    *(v4u*)(O + (size_t)row * ldc + col) = pack8(acc[ai][bj][m][0], acc[ai][bj][m][1]);
                    if (ci >= 0) { float* cp = (samp ? conv_s : conv_p) + (size_t)ci * UPW + col; *(A4*)cp = acc[ai][bj][m][0]; *(A4*)(cp + 4) = acc[ai][bj][m][1]; } } }
    }
};
struct EpiPle {
    static constexpr bool PERM = true, AFTER_DRAIN = false;
    float* X; const bf16* PP;
    __device__ __forceinline__ void operator()(const A4 (&acc)[2][2][4][2], const pg8::Unit& u, int wr, int wc, int fr, int fq) const {
        const int row0 = u.pm * 256 + wr * 64 + fr;
#pragma unroll
        for (int ai = 0; ai < 2; ++ai)
#pragma unroll
            for (int m = 0; m < 4; ++m) { const int row = row0 + ai * 128 + m * 16;
#pragma unroll
                for (int bj = 0; bj < 2; ++bj) { const size_t off = (size_t)row * DM + u.pn * 256 + bj * 128 + wc * 32 + 8 * fq;
                    const v4u p = *(const v4u*)(PP + off); float* xp = X + off; const A4 x0 = *(const A4*)xp, x1 = *(const A4*)(xp + 4);
                    const A4 a = acc[ai][bj][m][0], b = acc[ai][bj][m][1];
                    const A4 sa = {sigm(a[0]), sigm(a[1]), sigm(a[2]), sigm(a[3])}, sb = {sigm(b[0]), sigm(b[1]), sigm(b[2]), sigm(b[3])};
                    *(A4*)xp = x0 + sa * (A4){lo2f(p.x), hi2f(p.x), lo2f(p.y), hi2f(p.y)}; *(A4*)(xp + 4) = x1 + sb * (A4){lo2f(p.z), hi2f(p.z), lo2f(p.w), hi2f(p.w)}; } }
    }
};

struct Args { const float* in[26]; float* out; unsigned char* ws; int ph_lo, ph_hi; };
typedef const __attribute__((address_space(4))) Args* CArgs;

__device__ __forceinline__ void row_op(int lane, const float* xin, const float* addsrc, const float* g_add, float* xout, bf16* bout, const float* g_out) {
    const f32x4* xr = (const f32x4*)xin + lane; f32x4 v[4];
#pragma unroll
    for (int j = 0; j < 4; ++j) v[j] = xr[64 * j];
    if (addsrc) {
        const f32x4* ar = (const f32x4*)addsrc + lane; const f32x4* gr = (const f32x4*)g_add + lane; f32x4 a[4]; float s = 0.f;
#pragma unroll
        for (int j = 0; j < 4; ++j) { a[j] = ar[64 * j]; s += (a[j].x * a[j].x + a[j].y * a[j].y) + (a[j].z * a[j].z + a[j].w * a[j].w); }
        const float r = 1.0f / sqrtf(wave_sum(s) * (1.0f / DM) + EPS);
#pragma unroll
        for (int j = 0; j < 4; ++j) v[j] += a[j] * r * gr[64 * j];
    }
    if (xout) { f32x4* xo = (f32x4*)xout + lane;
#pragma unroll
        for (int j = 0; j < 4; ++j) xo[64 * j] = v[j]; }
    if (bout) {
        if (g_out) { float s = 0.f; const f32x4* gr = (const f32x4*)g_out + lane;
#pragma unroll
            for (int j = 0; j < 4; ++j) s += (v[j].x * v[j].x + v[j].y * v[j].y) + (v[j].z * v[j].z + v[j].w * v[j].w);
            const float r = 1.0f / sqrtf(wave_sum(s) * (1.0f / DM) + EPS);
#pragma unroll
            for (int j = 0; j < 4; ++j) v[j] = v[j] * r * gr[64 * j]; }
        unsigned long long* o8 = (unsigned long long*)bout + lane;
#pragma unroll
        for (int j = 0; j < 4; ++j) o8[64 * j] = (unsigned long long)pg8::cvt_pk_bf16(v[j].x, v[j].y) | ((unsigned long long)pg8::cvt_pk_bf16(v[j].z, v[j].w) << 32);
    }
}

__device__ __forceinline__ void tr_item(const float* W, int N, bf16* WT, int K, int k0, int n0, int s0, bool perm, bool zero, LAS float* scr, int lane) {
    if (!zero) {
#pragma unroll 8
        for (int i = 0; i < 32; ++i) { const int kk = 2 * i + (lane >> 5); scr[kk * 33 + (lane & 31)] = W[(size_t)(k0 + kk) * N + s0 + (lane & 31)]; }
    }
    LDS_WAIT(); asm volatile("" ::: "memory");
    const int c = lane & 7;
#pragma unroll
    for (int j = 0; j < 4; ++j) { const int n = (lane >> 3) + 8 * j; const int sc = perm ? ridx(n) : n; const LAS float* s = scr + (8 * c) * 33 + sc;
        v4u o; o.x = pk2(s[0 * 33], s[1 * 33]); o.y = pk2(s[2 * 33], s[3 * 33]); o.z = pk2(s[4 * 33], s[5 * 33]); o.w = pk2(s[6 * 33], s[7 * 33]);
        if (zero) o = (v4u){0u, 0u, 0u, 0u};
        *(GAS v4u*)(WT + (size_t)(n0 + n) * K + k0 + 8 * c) = o; }
    LDS_WAIT(); asm volatile("" ::: "memory");
}
struct Seg { const float* W; bf16* WT; int N, K, n0, s0, sstride, ng, perm, zero; };
__device__ __forceinline__ Seg get_seg(CArgs a, int L, int s) {
    unsigned char* wb = a->ws + WS_W + (size_t)L * WL; const float* win = a->in[9] + (size_t)L * DM * INC; bf16* wint = (bf16*)(wb + W_IN);
    Seg g{win, wint, INC, DM, 0, 0, 32, 0, 0, 0};
    switch (s) {
        case 0: g.n0 = 0; g.s0 = 0; g.ng = 48; break;
        case 1: g.n0 = 2560; g.s0 = 1536 + 64; g.sstride = 96; g.ng = 8; g.perm = 1; break;
        case 2: g.n0 = 2816; g.s0 = 2304; g.ng = 4; break;
        case 3: g.n0 = 2944; g.s0 = 2432; g.ng = 1; g.perm = 1; break;
        case 4: g.n0 = 2976; g.s0 = 0; g.sstride = 0; g.ng = 3; g.zero = 1; break;
        case 5: g.n0 = 3072; g.s0 = 2464; g.ng = 64; break;
        case 6: g.W = a->in[13] + (size_t)L * SBW * DM; g.WT = (bf16*)(wb + W_SB); g.N = DM; g.K = SBW; g.ng = 32; break;
        case 7: g.W = a->in[15] + (size_t)L * DM * DM; g.WT = (bf16*)(wb + W_OUT); g.N = DM; g.K = DM; g.ng = 32; break;
        case 8: g.W = a->in[20] + (size_t)L * DM * UPW; g.WT = (bf16*)(wb + W_UP); g.N = UPW; g.K = DM; g.ng = 176; break;
        case 9: g.W = a->in[23] + (size_t)L * DFF * DM; g.WT = (bf16*)(wb + W_DOWN); g.N = DM; g.K = DFF; g.ng = 32; break;
        case 10: g.W = a->in[24] + (size_t)L * DM * DM; g.WT = (bf16*)(wb + W_PG); g.N = DM; g.K = DM; g.ng = 32; break;
        default: g.W = a->in[25] + (size_t)L * DPLE * DM; g.WT = (bf16*)(wb + W_PP); g.N = DM; g.K = DPLE; g.ng = 32; break;
    }
    return g;
}
constexpr int NSEG = 12;

__device__ __forceinline__ void sincos_d(float ang, float& s, float& c) {
    const double x = (double)ang; const double q = rint(x * 0.63661977236758134308); const double r = x - q * 1.57079632679489661923; const double r2 = r * r;
    double sp = -2.5052108385441718775e-08; sp = sp * r2 + 2.7557319223985890653e-06; sp = sp * r2 - 1.9841269841269841270e-04; sp = sp * r2 + 8.3333333333333333333e-03; sp = sp * r2 - 1.6666666666666666667e-01; sp = r + r * r2 * sp;
    double cp = 2.0876756987868098979e-09; cp = cp * r2 - 2.7557319223985890653e-07; cp = cp * r2 + 2.4801587301587301587e-05; cp = cp * r2 - 1.3888888888888888889e-03; cp = cp * r2 + 4.1666666666666666667e-02; cp = cp * r2 - 0.5; cp = 1.0 + r2 * cp;
    const int qi = (int)((long long)q & 3);
    const double ss = (qi == 0) ? sp : (qi == 1) ? cp : (qi == 2) ? -sp : -cp;
    const double cc = (qi == 0) ? cp : (qi == 1) ? -sp : (qi == 2) ? -cp : sp;
    s = (float)ss; c = (float)cc;
}

__device__ __forceinline__ void p0_prologue(CArgs a, LAS unsigned char* lds, int vcu, int G, int wave, int lane) {
    const int gw = vcu * 8 + wave, NGW = G * 8, gt = gw * 64 + lane, NGT = NGW * 64;
    LAS float* scr = (LAS float*)(lds + wave * 16384);
    for (int L = 0; L < DEPTH; ++L)
        for (int s = 0; s < NSEG; ++s) { const Seg g = get_seg(a, L, s); const int nit = (g.K / 64) * g.ng;
            for (int it = gw; it < nit; it += NGW) { const int kb = it / g.ng, gi = it - kb * g.ng;
                tr_item(g.W, g.N, g.WT, g.K, 64 * kb, g.n0 + 32 * gi, g.s0 + g.sstride * gi, g.perm != 0, g.zero != 0, scr, lane); } }
    for (int L = 0; L < DEPTH; ++L) { const float* win = a->in[9] + (size_t)L * DM * INC; const float* wuk = a->in[11] + (size_t)L * LORA * NHEAD * 64;
        bf16* wint = (bf16*)(a->ws + WS_W + (size_t)L * WL + W_IN);
        for (int e = gt; e < QLW * DM; e += NGT) { const int k = e & (DM - 1), nr = e >> 10, h = nr >> 7, l = nr & 127;
            const f32x4* wp = (const f32x4*)(win + (size_t)k * INC + 1536 + 96 * h); const f32x4* up = (const f32x4*)(wuk + ((size_t)l * NHEAD + h) * 64); float s = 0.f;
#pragma unroll 4
            for (int j = 0; j < 16; ++j) { const f32x4 w = wp[j], u = up[j]; s += (w.x * u.x + w.y * u.y) + (w.z * u.z + w.w * u.w); }
            wint[(size_t)(1536 + nr) * DM + k] = (bf16)f2bf(s); } }
    for (int L = 0; L < DEPTH; ++L) { const float* wuv = a->in[12] + (size_t)L * LORA * NHEAD * 64; const float* wpm = a->in[14] + (size_t)L * SBW * DM;
        bf16* wyb = (bf16*)(a->ws + WS_W + (size_t)L * WL + W_YB);
        for (int e = gt; e < DM * QLW; e += NGT) { const int hl = e & (QLW - 1), n = e >> 10, h = hl >> 7, l = hl & 127;
            const f32x4* up = (const f32x4*)(wuv + ((size_t)l * NHEAD + h) * 64); const float* pp = wpm + (size_t)(h * 64) * DM + n; float s = 0.f;
#pragma unroll 4
            for (int j = 0; j < 16; ++j) { const f32x4 u = up[j]; s += (u.x * pp[(size_t)(4 * j) * DM] + u.y * pp[(size_t)(4 * j + 1) * DM]) + (u.z * pp[(size_t)(4 * j + 2) * DM] + u.w * pp[(size_t)(4 * j + 3) * DM]); }
            wyb[(size_t)n * QLW + hl] = (bf16)f2bf(s); } }
    { float* tab = (float*)(a->ws + WS_ROPE);
        for (int e = gt; e < NSLOT * 16; e += NGT) { const int slot = e >> 4, i = e & 15; const int pos = slot < SEQ ? slot : PAST + (slot - SEQ);
            const float freq = exp2f(-(float)i * (13.287712379549449f / 16.0f));
            float s, c; sincos_d((float)pos * freq, s, c); tab[slot * 32 + i] = c; tab[slot * 32 + 16 + i] = s; } }
    for (int m = gw; m < R; m += NGW) { const float* xin = m < PR ? a->in[0] + (size_t)m * DM : a->in[1] + (size_t)(m - PR) * DM;
        row_op(lane, xin, nullptr, nullptr, a->out + O_Y + (size_t)m * DM, (bf16*)(a->ws + WS_XN) + (size_t)m * DM, a->in[16]); }
    for (int e = gt; e < DEPTH * R * (DPLE / 8); e += NGT) { const int c8 = e & 31, rr = e >> 5, L = rr / R, row = rr - L * R;
        const float* src = row < PR ? a->in[2] + ((size_t)L * PR + row) * DPLE + 8 * c8 : a->in[3] + ((size_t)L * SR + (row - PR)) * DPLE + 8 * c8;
        const f32x4 x0 = *(const f32x4*)src, x1 = *(const f32x4*)(src + 4);
        *(v4u*)((bf16*)(a->ws + WS_PB) + ((size_t)L * R + row) * DPLE + 8 * c8) = pack8(x0, x1); }
}

__device__ __forceinline__ void conv_phase(CArgs a, int L, int vcu, int G, int wave, int lane) {
    const int gw = vcu * 8 + wave, NGW = G * 8; constexpr int NCG = (DFF / 8 + 63) / 64;
    const bf16* U = (const bf16*)(a->ws + WS_U); bf16* ACT = (bf16*)(a->ws + WS_ACT);
    const float* cw = a->in[21] + (size_t)L * 3 * UPW; const float* cb = a->in[22] + (size_t)L * UPW;
    for (int it = gw; it < (R / 32) * NCG; it += NGW) { const int strip = it / NCG, cg = it - strip * NCG; const int c8 = cg * 64 + lane; if (c8 >= DFF / 8) continue;
        const int col = 8 * c8, r0 = strip * 32; const bool samp = r0 >= PR;
        float w[2][3][8], bs[2][8], p2[2][8], p1[2][8];
#pragma unroll
        for (int gv = 0; gv < 2; ++gv) {
#pragma unroll
            for (int i = 0; i < 3; ++i) { const f32x4 x0 = *(const f32x4*)(cw + (size_t)i * UPW + gv * DFF + col), x1 = *(const f32x4*)(cw + (size_t)i * UPW + gv * DFF + col + 4);
                w[gv][i][0] = x0.x; w[gv][i][1] = x0.y; w[gv][i][2] = x0.z; w[gv][i][3] = x0.w; w[gv][i][4] = x1.x; w[gv][i][5] = x1.y; w[gv][i][6] = x1.z; w[gv][i][7] = x1.w; }
            const f32x4 b0 = *(const f32x4*)(cb + gv * DFF + col), b1 = *(const f32x4*)(cb + gv * DFF + col + 4);
            bs[gv][0] = b0.x; bs[gv][1] = b0.y; bs[gv][2] = b0.z; bs[gv][3] = b0.w; bs[gv][4] = b1.x; bs[gv][5] = b1.y; bs[gv][6] = b1.z; bs[gv][7] = b1.w;
            if (samp) { const float* st = a->in[8] + (((size_t)L * DBATCH + ((r0 - PR) >> 5)) * 2) * UPW + gv * DFF + col;
                const f32x4 a0 = *(const f32x4*)st, a1 = *(const f32x4*)(st + 4), c0 = *(const f32x4*)(st + UPW), c1 = *(const f32x4*)(st + UPW + 4);
                p2[gv][0] = a0.x; p2[gv][1] = a0.y; p2[gv][2] = a0.z; p2[gv][3] = a0.w; p2[gv][4] = a1.x; p2[gv][5] = a1.y; p2[gv][6] = a1.z; p2[gv][7] = a1.w;
                p1[gv][0] = c0.x; p1[gv][1] = c0.y; p1[gv][2] = c0.z; p1[gv][3] = c0.w; p1[gv][4] = c1.x; p1[gv][5] = c1.y; p1[gv][6] = c1.z; p1[gv][7] = c1.w;
            } else if ((r0 & (SEQ - 1)) == 0) {
#pragma unroll
                for (int e = 0; e < 8; ++e) { p2[gv][e] = 0.f; p1[gv][e] = 0.f; }
            } else { const v4u x2 = *(const v4u*)(U + (size_t)(r0 - 2) * UPW + gv * DFF + col), x1 = *(const v4u*)(U + (size_t)(r0 - 1) * UPW + gv * DFF + col);
                p2[gv][0] = lo2f(x2.x); p2[gv][1] = hi2f(x2.x); p2[gv][2] = lo2f(x2.y); p2[gv][3] = hi2f(x2.y); p2[gv][4] = lo2f(x2.z); p2[gv][5] = hi2f(x2.z); p2[gv][6] = lo2f(x2.w); p2[gv][7] = hi2f(x2.w);
                p1[gv][0] = lo2f(x1.x); p1[gv][1] = hi2f(x1.x); p1[gv][2] = lo2f(x1.y); p1[gv][3] = hi2f(x1.y); p1[gv][4] = lo2f(x1.z); p1[gv][5] = hi2f(x1.z); p1[gv][6] = lo2f(x1.w); p1[gv][7] = hi2f(x1.w); }
        }
        for (int t = 0; t < 32; ++t) { const int row = r0 + t; float cur[2][8], uc[2][8];
#pragma unroll
            for (int gv = 0; gv < 2; ++gv) { const v4u x = *(const v4u*)(U + (size_t)row * UPW + gv * DFF + col);
                cur[gv][0] = lo2f(x.x); cur[gv][1] = hi2f(x.x); cur[gv][2] = lo2f(x.y); cur[gv][3] = hi2f(x.y); cur[gv][4] = lo2f(x.z); cur[gv][5] = hi2f(x.z); cur[gv][6] = lo2f(x.w); cur[gv][7] = hi2f(x.w);
#pragma unroll
                for (int e = 0; e < 8; ++e) { uc[gv][e] = bs[gv][e] + p2[gv][e] * w[gv][0][e] + p1[gv][e] * w[gv][1][e] + cur[gv][e] * w[gv][2][e]; p2[gv][e] = p1[gv][e]; p1[gv][e] = cur[gv][e]; } }
            float o[8];
#pragma unroll
            for (int e = 0; e < 8; ++e) { const float x = uc[0][e]; const float y = 1.5957691216057308f * (x + 0.044715f * x * x * x); o[e] = x * frcp(1.0f + fexp2(-LOG2E * y)) * uc[1][e]; }
            *(v4u*)(ACT + (size_t)row * DFF + col) = pack8((f32x4){o[0], o[1], o[2], o[3]}, (f32x4){o[4], o[5], o[6], o[7]}); }
    }
}

__device__ __forceinline__ void naive_sb(CArgs a, int L, int vcu, int G, int wave, int lane) {
    const int gw = vcu * 8 + wave, NGW = G * 8;
    const bf16* QSB = (const bf16*)(a->ws + WS_QSB); const bf16* KSB = (const bf16*)(a->ws + WS_KSB); const bf16* VSB = (const bf16*)(a->ws + WS_VSB); bf16* OSB = (bf16*)(a->ws + WS_OSB);
    constexpr int NP = NB * NHEAD * (SEQ / 64), NS = DBATCH * NHEAD;
    for (int it = gw; it < NP + NS; it += NGW) {
        const bool samp = it >= NP; int b, h, t, qrow, nown, rowbase;
        if (!samp) { b = it >> 8; h = (it >> 5) & 7; int tb = it & 31; if ((it / NGW) & 1) tb = 31 - tb; t = tb * 64 + lane; rowbase = b * SEQ; qrow = rowbase + t; nown = tb * 64 + 63; }
        else { const int bh = it - NP; b = bh >> 3; h = bh & 7; t = lane & 31; rowbase = PR + b * DSEQ; qrow = rowbase + t; nown = DSEQ - 1; }
        b = __builtin_amdgcn_readfirstlane(b); h = __builtin_amdgcn_readfirstlane(h); rowbase = __builtin_amdgcn_readfirstlane(rowbase); nown = __builtin_amdgcn_readfirstlane(nown);
        float q[64], o[64];
        { const v4u* qp = (const v4u*)(QSB + (size_t)qrow * SBW + h * 64);
#pragma unroll
            for (int c = 0; c < 8; ++c) { const v4u x = qp[c]; q[8 * c] = lo2f(x.x); q[8 * c + 1] = hi2f(x.x); q[8 * c + 2] = lo2f(x.y); q[8 * c + 3] = hi2f(x.y); q[8 * c + 4] = lo2f(x.z); q[8 * c + 5] = hi2f(x.z); q[8 * c + 6] = lo2f(x.w); q[8 * c + 7] = hi2f(x.w); } }
#pragma unroll
        for (int d = 0; d < 64; ++d) o[d] = 0.f;
        float carry = 1.0f; int vz = 0; asm volatile("" : "+v"(vz));
        for (int s = nown - 1; s >= 0; --s) {
            const v4u* kp = (const v4u*)(KSB + (size_t)(rowbase + s) * SBW + h * 64 + vz); const v4u* vp = (const v4u*)(VSB + (size_t)(rowbase + s) * SBW + h * 64 + vz);
            float z = 0.f;
#pragma unroll
            for (int c = 0; c < 8; ++c) { const v4u x = kp[c]; z += q[8 * c] * lo2f(x.x) + q[8 * c + 1] * hi2f(x.x) + q[8 * c + 2] * lo2f(x.y) + q[8 * c + 3] * hi2f(x.y) + q[8 * c + 4] * lo2f(x.z) + q[8 * c + 5] * hi2f(x.z) + q[8 * c + 6] * lo2f(x.w) + q[8 * c + 7] * hi2f(x.w); }
            const float e = fexp2(z), rr = frcp(1.0f + e), beta = 1.0f - rr; const bool vis = s < t;
            const float w = vis ? beta * carry : 0.f; carry = vis ? carry * rr : carry;
#pragma unroll
            for (int c = 0; c < 8; ++c) { const v4u x = vp[c]; o[8 * c] += w * lo2f(x.x); o[8 * c + 1] += w * hi2f(x.x); o[8 * c + 2] += w * lo2f(x.y); o[8 * c + 3] += w * hi2f(x.y); o[8 * c + 4] += w * lo2f(x.z); o[8 * c + 5] += w * hi2f(x.z); o[8 * c + 6] += w * lo2f(x.w); o[8 * c + 7] += w * hi2f(x.w); }
        }
        if (samp) {
            const float* ck = a->in[4] + ((((size_t)L * DBATCH + b) * PAST) * NHEAD + h) * 64; const float* cv = a->in[5] + ((((size_t)L * DBATCH + b) * PAST) * NHEAD + h) * 64;
            for (int s = PAST - 1; s >= 0; --s) { const f32x4* kp = (const f32x4*)(ck + (size_t)s * SBW + vz); const f32x4* vp = (const f32x4*)(cv + (size_t)s * SBW + vz);
                float z = 0.f;
#pragma unroll
                for (int c = 0; c < 16; ++c) { const f32x4 x = kp[c]; z += q[4 * c] * x.x + q[4 * c + 1] * x.y + q[4 * c + 2] * x.z + q[4 * c + 3] * x.w; }
                const float e = fexp2(z), rr = frcp(1.0f + e), beta = 1.0f - rr; const float w = beta * carry; carry *= rr;
#pragma unroll
                for (int c = 0; c < 16; ++c) { const f32x4 x = vp[c]; o[4 * c] += w * x.x; o[4 * c + 1] += w * x.y; o[4 * c + 2] += w * x.z; o[4 * c + 3] += w * x.w; }
            }
        }
        if (!samp || lane < 32) { v4u* op = (v4u*)(OSB + (size_t)qrow * SBW + h * 64);
#pragma unroll
            for (int c = 0; c < 8; ++c) op[c] = pack8((f32x4){o[8 * c], o[8 * c + 1], o[8 * c + 2], o[8 * c + 3]}, (f32x4){o[8 * c + 4], o[8 * c + 5], o[8 * c + 6], o[8 * c + 7]}); }
    }
}
__device__ __forceinline__ void naive_mla(CArgs a, int L, int vcu, int G, int wave, int lane) {
    const int gw = vcu * 8 + wave, NGW = G * 8;
    const bf16* QLAT = (const bf16*)(a->ws + WS_QLAT); const bf16* QROPE = (const bf16*)(a->ws + WS_QROPE); const bf16* CKVB = (const bf16*)(a->ws + WS_CKVB); const bf16* KRB = (const bf16*)(a->ws + WS_KRB);
    bf16* OLAT = (bf16*)(a->ws + WS_OLAT);
    for (int it = gw; it < R * NHEAD; it += NGW) { const int row = it >> 3, h = it & 7; const bool samp = row >= PR;
        const unsigned qw = *(const unsigned*)(QLAT + (size_t)row * QLW + h * 128 + 2 * lane); const float q0 = lo2f(qw), q1 = hi2f(qw);
        const float qr = lane < 32 ? bf2f(QROPE[(size_t)row * QRW + h * 32 + lane]) : 0.f;
        int rowbase, nk; if (!samp) { rowbase = row & ~(SEQ - 1); nk = 64 * (((row & (SEQ - 1)) >> 6) + 1); } else { rowbase = PR + (((row - PR) >> 5) << 5); nk = DSEQ; }
        float m = -INFINITY, l = 0.f, o0 = 0.f, o1 = 0.f;
        for (int s = 0; s < nk; s += 4) { float sc[4], c0[4], c1[4];
#pragma unroll
            for (int j = 0; j < 4; ++j) { const size_t kr = (size_t)(rowbase + s + j); const unsigned cw = *(const unsigned*)(CKVB + kr * LORA + 2 * lane); c0[j] = lo2f(cw); c1[j] = hi2f(cw);
                const float r = lane < 32 ? bf2f(KRB[kr * ROPE + lane]) : 0.f; sc[j] = q0 * c0[j] + q1 * c1[j] + qr * r; }
#pragma unroll
            for (int off = 1; off < 64; off <<= 1) {
#pragma unroll
                for (int j = 0; j < 4; ++j) sc[j] += __shfl_xor(sc[j], off); }
#pragma unroll
            for (int j = 0; j < 4; ++j) { const float mn = fmaxf(m, sc[j]), al = fexp2(m - mn), p = fexp2(sc[j] - mn); l = l * al + p; o0 = o0 * al + p * c0[j]; o1 = o1 * al + p * c1[j]; m = mn; }
        }
        if (samp) { const int b = (row - PR) >> 5; const float* cc = a->in[6] + ((size_t)L * DBATCH + b) * PAST * LORA; const float* cr = a->in[7] + ((size_t)L * DBATCH + b) * PAST * ROPE; const int ri = ridx(lane & 31);
            for (int s = 0; s < PAST; s += 4) { float sc[4], c0[4], c1[4];
#pragma unroll
                for (int j = 0; j < 4; ++j) { const float2 cv = *(const float2*)(cc + (size_t)(s + j) * LORA + 2 * lane); c0[j] = cv.x; c1[j] = cv.y;
                    const float r = lane < 32 ? cr[(size_t)(s + j) * ROPE + ri] : 0.f; sc[j] = q0 * c0[j] + q1 * c1[j] + qr * r; }
#pragma unroll
                for (int off = 1; off < 64; off <<= 1) {
#pragma unroll
                    for (int j = 0; j < 4; ++j) sc[j] += __shfl_xor(sc[j], off); }
#pragma unroll
                for (int j = 0; j < 4; ++j) { const float mn = fmaxf(m, sc[j]), al = fexp2(m - mn), p = fexp2(sc[j] - mn); l = l * al + p; o0 = o0 * al + p * c0[j]; o1 = o1 * al + p * c1[j]; m = mn; }
            } }
        const float il = 1.0f / l;
        *(unsigned*)(OLAT + (size_t)row * QLW + h * 128 + 2 * lane) = pg8::cvt_pk_bf16(o0 * il, o1 * il);
    }
}

__device__ __forceinline__ int lane_now() { int l; asm volatile("v_mbcnt_lo_u32_b32 %0, -1, 0\n\tv_mbcnt_hi_u32_b32 %0, -1, %0" : "=v"(l)); return l; }
__device__ __forceinline__ CArgs fresh_args() { CArgs p = (CArgs)__builtin_amdgcn_kernarg_segment_ptr(); asm volatile("" : "+s"(p)); return p; }
__global__ void __launch_bounds__(512, 2) fwd(Args args_byval) {
    extern __shared__ __attribute__((aligned(16))) unsigned char lds_raw[];
    LAS unsigned char* lds = (LAS unsigned char*)lds_raw;
    volatile LAS unsigned* MISC = (volatile LAS unsigned*)(lds + MISC_OFF);
    const int wave = __builtin_amdgcn_readfirstlane((int)threadIdx.x >> 6);
    const int G = gridDim.x; const int bx = blockIdx.x; const int vcu = (G % 8 == 0) ? (bx % 8) * (G / 8) + bx / 8 : bx;
    if (threadIdx.x < 32) MISC[threadIdx.x] = 0u;
    __syncthreads();
    XcdBarrier bar = xcd_barrier_post((unsigned*)(fresh_args()->ws + WS_CTL) + CW_BAR, MISC + 8);
    const int lo = fresh_args()->ph_lo, hi = fresh_args()->ph_hi;
#define IN(k) (lo <= (k) && (k) < hi)
#define SEAM(k) do { if (IN(k) && IN((k) + 1)) xcd_barrier(bar); } while (0)
    const int gw = vcu * 8 + wave, NGW = G * 8;

    if (IN(0)) p0_prologue(fresh_args(), lds, vcu, G, wave, lane_now());
    SEAM(0);
    if (IN(1)) {
#pragma unroll 1
        for (int L = 0; L < DEPTH; ++L) { unsigned char* ws = fresh_args()->ws;
            pg8::Gemm g{(const bf16*)(ws + WS_PB) + (size_t)L * R * DPLE, (const bf16*)(ws + WS_W + (size_t)L * WL + W_PP), R, DM, DPLE}; Ord<DM / 256> S; S.init(G, bx);
            EpiBf E{(bf16*)(ws + WS_PP) + (size_t)L * R * DM, DM, nullptr, nullptr};
            pg8::gemm_phase<EpiBf, decltype(S), true, true>(lds, g, S, E, wave); }
    }
    SEAM(1);
#pragma unroll 1
    for (int L = 0; L < DEPTH; ++L) {
        const int pb = 2 + 12 * L;
        if (IN(pb + 0)) {
            CArgs a = fresh_args(); unsigned char* ws = a->ws;
            pg8::Gemm g{(const bf16*)(ws + WS_XN), (const bf16*)(ws + WS_W + (size_t)L * WL + W_IN), R, NIN, DM}; Ord<NIN / 256> S; S.init(G, bx);
            EpiIn E{ws, a->out, L, a->in[10] + (size_t)L * LORA, (LAS float*)(lds + XL_OFF)};
            pg8::gemm_phase<EpiIn, decltype(S), true, true>(lds, g, S, E, wave);
        }
        SEAM(pb + 0);
        if (IN(pb + 1)) {
#ifndef NO_SB
            naive_sb(fresh_args(), L, vcu, G, wave, lane_now());
#endif
#ifndef NO_MLA
            naive_mla(fresh_args(), L, vcu, G, wave, lane_now());
#endif
        }
        SEAM(pb + 1);
        if (IN(pb + 2)) {
            unsigned char* ws = fresh_args()->ws;
            pg8::Gemm g{(const bf16*)(ws + WS_OSB), (const bf16*)(ws + WS_W + (size_t)L * WL + W_SB), R, DM, SBW}; Ord<DM / 256> S; S.init(G, bx);
            EpiGate<false> E{(const bf16*)(ws + WS_GA), (bf16*)(ws + WS_MG)};
            pg8::gemm_phase<EpiGate<false>, decltype(S), true, true>(lds, g, S, E, wave);
        }
        SEAM(pb + 2);
        if (IN(pb + 3)) {
            unsigned char* ws = fresh_args()->ws;
            pg8::Gemm g{(const bf16*)(ws + WS_OLAT), (const bf16*)(ws + WS_W + (size_t)L * WL + W_YB), R, DM, QLW}; Ord<DM / 256> S; S.init(G, bx);
            EpiGate<true> E{(const bf16*)(ws + WS_GB), (bf16*)(ws + WS_MG)};
            pg8::gemm_phase<EpiGate<true>, decltype(S), true, true>(lds, g, S, E, wave);
        }
        SEAM(pb + 3);
        if (IN(pb + 4)) {
            unsigned char* ws = fresh_args()->ws;
            pg8::Gemm g{(const bf16*)(ws + WS_MG), (const bf16*)(ws + WS_W + (size_t)L * WL + W_OUT), R, DM, DM}; Ord<DM / 256> S; S.init(G, bx);
            EpiF32 E{(float*)(ws + WS_MIX), DM};
            pg8::gemm_phase<EpiF32, decltype(S), true, true>(lds, g, S, E, wave);
        }
        SEAM(pb + 4);
        if (IN(pb + 5)) {
            CArgs a = fresh_args(); float* X = a->out + O_Y; const float* MIX = (const float*)(a->ws + WS_MIX); bf16* XN = (bf16*)(a->ws + WS_XN);
            const float* g1 = a->in[17] + (size_t)L * DM; const float* g2 = a->in[18] + (size_t)L * DM;
            const int lane = lane_now();
            for (int m = gw; m < R; m += NGW) row_op(lane, X + (size_t)m * DM, MIX + (size_t)m * DM, g1, X + (size_t)m * DM, XN + (size_t)m * DM, g2);
        }
        SEAM(pb + 5);
        if (IN(pb + 6)) {
            CArgs a = fresh_args(); unsigned char* ws = a->ws;
            pg8::Gemm g{(const bf16*)(ws + WS_XN), (const bf16*)(ws + WS_W + (size_t)L * WL + W_UP), R, UPW, DM}; Ord<UPW / 256> S; S.init(G, bx);
            EpiBf E{(bf16*)(ws + WS_U), UPW, a->out + O_CONV_P + (size_t)L * NB * 2 * UPW, a->out + O_CONV_S + (size_t)L * DBATCH * 2 * UPW};
            pg8::gemm_phase<EpiBf, decltype(S), true, true>(lds, g, S, E, wave);
        }
        SEAM(pb + 6);
#ifndef NO_CONV
        if (IN(pb + 7)) conv_phase(fresh_args(), L, vcu, G, wave, lane_now());
#endif
        SEAM(pb + 7);
        if (IN(pb + 8)) {
            unsigned char* ws = fresh_args()->ws;
            pg8::Gemm g{(const bf16*)(ws + WS_ACT), (const bf16*)(ws + WS_W + (size_t)L * WL + W_DOWN), R, DM, DFF}; Ord<DM / 256> S; S.init(G, bx);
            EpiF32 E{(float*)(ws + WS_MIX), DM};
            pg8::gemm_phase<EpiF32, decltype(S), true, true>(lds, g, S, E, wave);
        }
        SEAM(pb + 8);
        if (IN(pb + 9)) {
            CArgs a = fresh_args(); float* X = a->out + O_Y; const float* MIX = (const float*)(a->ws + WS_MIX); bf16* XB = (bf16*)(a->ws + WS_XB);
            const float* g1 = a->in[19] + (size_t)L * DM;
            const int lane = lane_now();
            for (int m = gw; m < R; m += NGW) row_op(lane, X + (size_t)m * DM, MIX + (size_t)m * DM, g1, X + (size_t)m * DM, XB + (size_t)m * DM, nullptr);
        }
        SEAM(pb + 9);
        if (IN(pb + 10)) {
            CArgs a = fresh_args(); unsigned char* ws = a->ws;
            pg8::Gemm g{(const bf16*)(ws + WS_XB), (const bf16*)(ws + WS_W + (size_t)L * WL + W_PG), R, DM, DM}; Ord<DM / 256> S; S.init(G, bx);
            EpiPle E{a->out + O_Y, (const bf16*)(ws + WS_PP) + (size_t)L * R * DM};
            pg8::gemm_phase<EpiPle, decltype(S), true, true>(lds, g, S, E, wave);
        }
        SEAM(pb + 10);
        if (IN(pb + 11) && L + 1 < DEPTH) {
            CArgs a = fresh_args(); const float* X = a->out + O_Y; bf16* XN = (bf16*)(a->ws + WS_XN); const float* g2 = a->in[16] + (size_t)(L + 1) * DM;
            const int lane = lane_now();
            for (int m = gw; m < R; m += NGW) row_op(lane, X + (size_t)m * DM, nullptr, nullptr, nullptr, XN + (size_t)m * DM, g2);
        }
        SEAM(pb + 11);
    }

#ifdef MK_DUMP
    {
        __syncthreads(); const int lane = lane_now(); unsigned char* ws = fresh_args()->ws; float* X = fresh_args()->out + O_Y;
        if (fresh_args()->ph_lo == NPHASE)
        for (int m = gw; m < R; m += NGW) for (int j = 0; j < 16; ++j) { const int c = j * 64 + lane; float v = 0.f;
            if (MK_DUMP & 1) v += bf2f(((const bf16*)(ws + WS_OSB))[(size_t)m * SBW + (c & 511)]);
            if (MK_DUMP & 2) v += bf2f(((const bf16*)(ws + WS_OLAT))[(size_t)m * QLW + c]);
            if (MK_DUMP & 4) v += bf2f(((const bf16*)(ws + WS_GA))[(size_t)m * DM + c]) + bf2f(((const bf16*)(ws + WS_GB))[(size_t)m * DM + c]);
            if (MK_DUMP & 8) v += bf2f(((const bf16*)(ws + WS_QLAT))[(size_t)m * QLW + c]) + bf2f(((const bf16*)(ws + WS_QSB))[(size_t)m * SBW + (c & 511)]) + bf2f(((const bf16*)(ws + WS_QROPE))[(size_t)m * QRW + (c & 255)]);
            if (MK_DUMP & 16) v += bf2f(((const bf16*)(ws + WS_PP))[(size_t)m * DM + c]) + bf2f(((const bf16*)(ws + WS_PP))[((size_t)R + m) * DM + c]);
            if (MK_DUMP & 32) v += bf2f(((const bf16*)(ws + WS_MG))[(size_t)m * DM + c]);
            if (MK_DUMP & 64) v += ((const float*)(ws + WS_MIX))[(size_t)m * DM + c];
            X[(size_t)m * DM + c] = v; }
    }
#endif
#undef IN
#undef SEAM
}

extern "C" void kernel_launch(void* const* d_in, const int* in_sizes, int n_in, void* d_out, int out_size, void* d_ws, size_t ws_size, hipStream_t stream) {
    static int grid = 0;
    if (grid == 0) {
        if (n_in != 26 || (size_t)out_size != O_END || ws_size < WS_END) { fprintf(stderr, "kernel_launch: unexpected shapes (n_in %d, out %d, ws %zu); nothing launched\n", n_in, out_size, ws_size); grid = -1; return; }
        int dev = 0, cus = 0, per_cu = 0;
        if (hipGetDevice(&dev) != hipSuccess || hipDeviceGetAttribute(&cus, hipDeviceAttributeMultiprocessorCount, dev) != hipSuccess) { grid = -1; return; }
        if (hipFuncSetAttribute((const void*)fwd, hipFuncAttributeMaxDynamicSharedMemorySize, LDS_BYTES) != hipSuccess) { fprintf(stderr, "kernel_launch: hipFuncSetAttribute failed\n"); grid = -1; return; }
        if (hipOccupancyMaxActiveBlocksPerMultiprocessor(&per_cu, (const void*)fwd, 512, LDS_BYTES) != hipSuccess || per_cu < 1) fprintf(stderr, "kernel_launch: occupancy query reports %d\n", per_cu);
        (void)hipGetLastError();
        grid = cus;
    }
    if (grid < 0) return;
    if (hipMemsetAsync((char*)d_ws + WS_CTL, 0, CTL_ZERO_BYTES, stream) != hipSuccess) return;
    Args a{};
    for (int i = 0; i < 26; ++i) a.in[i] = (const float*)d_in[i];
    a.out = (float*)d_out; a.ws = (unsigned char*)d_ws;
#if MK_PER_PHASE
    for (int ph = 0; ph < NPHASE; ++ph) { a.ph_lo = ph; a.ph_hi = ph + 1; hipLaunchKernelGGL(fwd, dim3(grid), dim3(512), LDS_BYTES, stream, a); }
#ifdef MK_DUMP
    a.ph_lo = NPHASE; a.ph_hi = NPHASE + 1; hipLaunchKernelGGL(fwd, dim3(grid), dim3(512), LDS_BYTES, stream, a);
#endif
#else
    a.ph_lo = 0; a.ph_hi = NPHASE; hipLaunchKernelGGL(fwd, dim3(grid), dim3(512), LDS_BYTES, stream, a);
#endif
}
```

```cpp
#include <hip/hip_runtime.h>
#include <cstdio>
#include <cstdint>
#include <cmath>
#define MK_PER_PHASE 0
namespace pg8 {
#define PG8_LAS __attribute__((address_space(3)))
typedef unsigned short bf16_t;
typedef short bf16x8 __attribute__((ext_vector_type(8)));
typedef float f32x4 __attribute__((ext_vector_type(4)));
typedef unsigned u32x4 __attribute__((ext_vector_type(4)));
constexpr int BM = 256, BK = 64, HALF = 128, HTB = HALF * BK * 2  , STAGE_BYTES = 8 * HTB, NXCD = 8, WGM = 8;

__host__ __device__ __forceinline__ int lds_byte(int r, int c) { const int st = (r >> 4) * 2 + (c >> 5), rr = r & 15, cc = c & 31, ob = rr * 64 + cc * 2; return st * 1024 + (ob ^ (((ob >> 9) & 1) << 5)); }
__host__ __device__ __forceinline__ void stage_rc(int b, int& R, int& C) { const int st = b / 1024, sb = b % 1024, swz = sb ^ (((sb >> 9) & 1) << 5); R = (st >> 1) * 16 + swz / 64; C = (st & 1) * 32 + (swz % 64) / 2; }
__host__ __device__ __forceinline__ int perm32(int rho) { const int n = rho >> 4, i = rho & 15; return 8 * (i >> 2) + 4 * n + (i & 3); }

struct Unit { int pm, pn; };
struct Gemm { const bf16_t* A; const bf16_t* Bt; int M, N, K; };

struct StaticOrder {
    int nM, nN, nwg, G, c;
    __host__ __device__ void init(int M, int N, int G_, int c_) { nM = M / BM; nN = N / BM; nwg = nM * nN; G = G_; c = c_; }
    __host__ __device__ bool next(int i, Unit& u) const {
        const long L = (long)i * G + c; if (L >= nwg) return false;
        int wgid = (int)L; { const int q = nwg / NXCD, r = nwg % NXCD, xcd = wgid % NXCD, off = wgid / NXCD; wgid = (xcd < r ? xcd * (q + 1) : r * (q + 1) + (xcd - r) * q) + off; }
        const int nig = WGM * nN, gid = wgid / nig, fm = gid * WGM, gsz = (nM - fm) < WGM ? (nM - fm) : WGM;
        u.pm = fm + ((wgid % nig) % gsz); u.pn = (wgid % nig) / gsz; return true;
    }
    __device__ __forceinline__ void a_ready(const Unit&) const {}
    __device__ __forceinline__ void done(const Unit&) const {}
};

typedef float f32x2_cv __attribute__((ext_vector_type(2))); typedef __bf16 bf16x2_cv __attribute__((ext_vector_type(2)));
__device__ __forceinline__ unsigned cvt_pk_bf16(float lo, float hi) { unsigned r; asm volatile("v_cvt_pk_bf16_f32 %0, %1, %2" : "=v"(r) : "v"(lo), "v"(hi)); return r; }
__device__ __forceinline__ unsigned cvt_pk_bf16_c(float lo, float hi) { f32x2_cv v = {lo, hi}; bf16x2_cv b = __builtin_convertvector(v, bf16x2_cv); return __builtin_bit_cast(unsigned, b); }
typedef float f32x2 __attribute__((ext_vector_type(2)));
template <class Epi, class Sched, bool ALIGN_EPI = false, bool SP2 = false>
__device__ __forceinline__ void gemm_phase(PG8_LAS unsigned char* lds, const Gemm g, const Sched& S, const Epi& E, const int wave_id) {
    int tid_; asm volatile("v_mbcnt_lo_u32_b32 %0, -1, 0\n\tv_mbcnt_hi_u32_b32 %0, -1, %0" : "=v"(tid_)); tid_ += wave_id * 64;
    const int tid = tid_, wid = __builtin_amdgcn_readfirstlane(tid >> 6), lane = tid & 63, wr = wid >> 2, wc = wid & 3, fr = lane & 15, fq = lane >> 4;
    const int K = g.K, nt = K / BK;
    unsigned voffA[2], voffB[2];
#pragma unroll
    for (int i = 0; i < 2; ++i) { int R, C; stage_rc(tid * 16 + i * 8192, R, C); const int Rb = Epi::PERM ? ((R & ~31) + perm32(R & 31)) : R;
        voffA[i] = (unsigned)(R * K + C) * 2u; voffB[i] = (unsigned)(Rb * K + C) * 2u; }
    const size_t kstep = (size_t)(BK * 2);
    const size_t hstep = (size_t)HALF * K * 2;
    const size_t tstep = 2 * hstep;
    const unsigned ldsw = (unsigned)wid * 1024u;
    const int aoff = lds_byte(wr * 64 + fr, fq * 8), boff = lds_byte(wc * 32 + fr, fq * 8);
#define PG8_SA(b, h) (((b) * 2 + (h)) * HTB)
#define PG8_SB(b, h) ((4 + (b) * 2 + (h)) * HTB)
#define PG8_STAGE(bufoff, gbase, voff) do { _Pragma("unroll") for (int _i = 0; _i < 2; ++_i) \
        __builtin_amdgcn_global_load_lds((const unsigned*)((const char*)(gbase) + (voff)[_i]), (PG8_LAS unsigned*)(lds + (bufoff) + ldsw + _i * 8192), 16, 0, 0); } while (0)
#define PG8_LDA(dst, b, h) do { _Pragma("unroll") for (int m = 0; m < 4; ++m) _Pragma("unroll") for (int k = 0; k < 2; ++k) dst[m][k] = *(const PG8_LAS bf16x8*)(lds + PG8_SA(b, h) + aoff + m * 2048 + k * 1024); } while (0)
#define PG8_LDB(dst, b, h) do { _Pragma("unroll") for (int n = 0; n < 2; ++n) _Pragma("unroll") for (int k = 0; k < 2; ++k) dst[n][k] = *(const PG8_LAS bf16x8*)(lds + PG8_SB(b, h) + boff + n * 2048 + k * 1024); } while (0)
#define PG8_MMA(ai, bj, At, Bt) do { __builtin_amdgcn_s_setprio(1); _Pragma("unroll") for (int m = 0; m < 4; ++m) _Pragma("unroll") for (int n = 0; n < 2; ++n) _Pragma("unroll") for (int k = 0; k < 2; ++k) \
        acc[ai][bj][m][n] = __builtin_amdgcn_mfma_f32_16x16x32_bf16(Bt[n][k], At[m][k], acc[ai][bj][m][n], 0, 0, 0); __builtin_amdgcn_s_setprio(0); } while (0)
#define PG8_WAIT_V(n) asm volatile("s_waitcnt vmcnt(" #n ")" ::: "memory")
#define PG8_WAIT_L(n) asm volatile("s_waitcnt lgkmcnt(" #n ")" ::: "memory")
#define PG8_BAR __builtin_amdgcn_s_barrier()
#define PG8_SCHED __builtin_amdgcn_sched_barrier(0)
    Unit cur, nxt; int ui = 0;
    if (!S.next(0, cur)) return;
    f32x4 acc[2][2][4][2];
#pragma unroll
    for (int a = 0; a < 2; ++a)
#pragma unroll
        for (int b = 0; b < 2; ++b)
#pragma unroll
            for (int m = 0; m < 4; ++m)
#pragma unroll
                for (int n = 0; n < 2; ++n) acc[a][b][m][n] = (f32x4){0.f, 0.f, 0.f, 0.f};
    bf16x8 At[4][2], B0[2][2], B1[2][2];
    const char* cA = (const char*)g.A + (size_t)cur.pm * tstep; const char* cB = (const char*)g.Bt + (size_t)cur.pn * tstep;
    S.a_ready(cur);
    if constexpr (SP2) {
        PG8_STAGE(PG8_SB(0, 0), cB, voffB); PG8_STAGE(PG8_SB(0, 1), cB + hstep, voffB); PG8_STAGE(PG8_SA(0, 0), cA, voffA); PG8_STAGE(PG8_SA(0, 1), cA + hstep, voffA);
        if (wr == 1) PG8_BAR;
        PG8_WAIT_V(2); PG8_BAR;
        PG8_STAGE(PG8_SB(1, 0), cB + kstep, voffB); PG8_STAGE(PG8_SA(1, 0), cA + kstep, voffA); PG8_STAGE(PG8_SB(1, 1), cB + hstep + kstep, voffB);
        PG8_WAIT_V(6); PG8_BAR;
    } else {
        PG8_STAGE(PG8_SB(0, 0), cB, voffB); PG8_STAGE(PG8_SA(0, 0), cA, voffA); PG8_STAGE(PG8_SB(0, 1), cB + hstep, voffB); PG8_STAGE(PG8_SA(0, 1), cA + hstep, voffA);
        if (wr == 1) PG8_BAR;
        PG8_WAIT_V(4); PG8_BAR;
        PG8_STAGE(PG8_SB(1, 0), cB + kstep, voffB); PG8_STAGE(PG8_SA(1, 0), cA + kstep, voffA); PG8_STAGE(PG8_SB(1, 1), cB + hstep + kstep, voffB);
        PG8_WAIT_V(6); PG8_BAR;
    }
    for (;;) {
        const bool has_next = S.next(ui + 1, nxt);
        const char* nA = has_next ? (const char*)g.A + (size_t)nxt.pm * tstep : cA; const char* nB = has_next ? (const char*)g.Bt + (size_t)nxt.pn * tstep : cB;
        for (int t = 0; t < nt; t += 2) {
            const bool last = (t == nt - 2);
            const char* a1 = cA + (size_t)(t + 1) * kstep;
            const char* a2 = last ? nA : cA + (size_t)(t + 2) * kstep; const char* b2 = last ? nB : cB + (size_t)(t + 2) * kstep;
            const char* a3 = a2 + kstep; const char* b3 = b2 + kstep;
            if (last && has_next) S.a_ready(nxt);
            if constexpr (SP2) {
            PG8_LDB(B0, 0, 0); PG8_LDB(B1, 0, 1); PG8_SCHED; PG8_LDA(At, 0, 0); PG8_STAGE(PG8_SA(1, 1), a1 + hstep, voffA);
            PG8_WAIT_V(8); PG8_WAIT_L(0); PG8_BAR; PG8_MMA(0, 0, At, B0); PG8_MMA(0, 1, At, B1); PG8_BAR; PG8_SCHED;
            PG8_LDA(At, 0, 1); PG8_STAGE(PG8_SB(0, 0), b2, voffB); PG8_STAGE(PG8_SB(0, 1), b2 + hstep, voffB); PG8_STAGE(PG8_SA(0, 0), a2, voffA);
            PG8_WAIT_V(8); PG8_WAIT_L(0); PG8_BAR; PG8_MMA(1, 0, At, B0); PG8_MMA(1, 1, At, B1); PG8_BAR; PG8_SCHED;
            PG8_LDB(B0, 1, 0); PG8_LDB(B1, 1, 1); PG8_SCHED; PG8_LDA(At, 1, 0); PG8_STAGE(PG8_SA(0, 1), a2 + hstep, voffA);
            PG8_WAIT_V(8); PG8_WAIT_L(0); PG8_BAR; PG8_MMA(0, 0, At, B0); PG8_MMA(0, 1, At, B1); PG8_BAR; PG8_SCHED;
            PG8_LDA(At, 1, 1); PG8_STAGE(PG8_SB(1, 0), b3, voffB); PG8_STAGE(PG8_SB(1, 1), b3 + hstep, voffB); PG8_STAGE(PG8_SA(1, 0), a3, voffA);
            PG8_WAIT_V(8); PG8_WAIT_L(0); PG8_BAR; PG8_MMA(1, 0, At, B0); PG8_MMA(1, 1, At, B1); PG8_BAR; PG8_SCHED;
            } else {
            PG8_LDB(B0, 0, 0); PG8_SCHED; PG8_LDA(At, 0, 0); PG8_STAGE(PG8_SA(1, 1), a1 + hstep, voffA);
            PG8_WAIT_L(8); PG8_BAR; PG8_WAIT_L(0); PG8_MMA(0, 0, At, B0); PG8_BAR; PG8_SCHED;
            PG8_LDB(B1, 0, 1); PG8_STAGE(PG8_SB(0, 0), b2, voffB);
            PG8_BAR; PG8_WAIT_L(0); PG8_MMA(0, 1, At, B1); PG8_BAR;
            PG8_LDA(At, 0, 1); PG8_STAGE(PG8_SA(0, 0), a2, voffA);
            PG8_BAR; PG8_WAIT_L(0); PG8_MMA(1, 0, At, B0); PG8_BAR; PG8_SCHED;
            PG8_STAGE(PG8_SB(0, 1), b2 + hstep, voffB);
            PG8_WAIT_V(6); PG8_BAR; PG8_MMA(1, 1, At, B1); PG8_BAR;
            PG8_LDB(B0, 1, 0); PG8_SCHED; PG8_LDA(At, 1, 0); PG8_STAGE(PG8_SA(0, 1), a2 + hstep, voffA);
            PG8_WAIT_L(8); PG8_BAR; PG8_WAIT_L(0); PG8_MMA(0, 0, At, B0); PG8_BAR; PG8_SCHED;
            PG8_LDB(B1, 1, 1); PG8_STAGE(PG8_SB(1, 0), b3, voffB);
            PG8_BAR; PG8_WAIT_L(0); PG8_MMA(0, 1, At, B1); PG8_BAR;
            PG8_LDA(At, 1, 1); PG8_STAGE(PG8_SA(1, 0), a3, voffA);
            PG8_BAR; PG8_WAIT_L(0); PG8_MMA(1, 0, At, B0); PG8_BAR; PG8_SCHED;
            PG8_STAGE(PG8_SB(1, 1), b3 + hstep, voffB);
            PG8_WAIT_V(6); PG8_BAR; PG8_MMA(1, 1, At, B1); PG8_BAR;
            }
        }
        if constexpr (ALIGN_EPI) { if (wr == 0) PG8_BAR; }
        if constexpr (!Epi::AFTER_DRAIN) { E(acc, cur, wr, wc, fr, fq); S.done(cur); }
        if (!has_next) break;
#pragma unroll
        for (int a = 0; a < 2; ++a)
#pragma unroll
            for (int b = 0; b < 2; ++b)
#pragma unroll
                for (int m = 0; m < 4; ++m)
#pragma unroll
                    for (int n = 0; n < 2; ++n) acc[a][b][m][n] = (f32x4){0.f, 0.f, 0.f, 0.f};
        cur = nxt; cA = nA; cB = nB; ++ui;
        if constexpr (ALIGN_EPI) { if (wr == 1) PG8_BAR; }
    }
    PG8_WAIT_V(0);
    if constexpr (!ALIGN_EPI) { if (wr == 0) PG8_BAR; }
    PG8_BAR;
    if constexpr (Epi::AFTER_DRAIN) { E.fused(acc, cur, wr, wc, fr, fq, lds, wid, lane); S.done(cur); }
#undef PG8_SA
#undef PG8_SB
#undef PG8_STAGE
#undef PG8_LDA
#undef PG8_LDB
#undef PG8_MMA
#undef PG8_WAIT_V
#undef PG8_WAIT_L
#undef PG8_BAR
#undef PG8_SCHED
}
}
#define GAS __attribute__((address_space(1)))
#define LAS __attribute__((address_space(3)))
typedef unsigned short bf16;
typedef unsigned v4u __attribute__((ext_vector_type(4)));
typedef float f32x4 __attribute__((ext_vector_type(4)));
typedef short bf16x8 __attribute__((ext_vector_type(8)));
typedef GAS unsigned gu32;
typedef GAS unsigned long long gu64;
#define RLX_AGENT __ATOMIC_RELAXED, __HIP_MEMORY_SCOPE_AGENT
#define LDS_WAIT() asm volatile("s_waitcnt lgkmcnt(0)" ::: "memory")
#define VM_WAIT() asm volatile("s_waitcnt vmcnt(0)" ::: "memory")
__device__ __forceinline__ unsigned long long rt() { return __builtin_amdgcn_s_memrealtime(); }
__device__ __forceinline__ unsigned f2bf(float f) { unsigned u = __builtin_bit_cast(unsigned, f); return (u + 0x7fffu + ((u >> 16) & 1u)) >> 16; }
__device__ __forceinline__ unsigned pk2(float lo, float hi) { return f2bf(lo) | (f2bf(hi) << 16); }

#define XB_TMO      128
#define XB_XCNT(j)  (256  + 64 * (j))
#define XB_XSUB(j)  (1280 + 64 * (j))
#define XB_XGEN(j)  (2304 + 64 * (j))
#define XB_TOP      3328
#define XB_TOPGEN   3392
#define XCD_BAR_WORDS 3456
#define XB_SPIN_CAP (1u << 18)

__device__ __forceinline__ unsigned xb_ld(unsigned* p)              { return __hip_atomic_load(p, __ATOMIC_RELAXED, __HIP_MEMORY_SCOPE_AGENT); }
__device__ __forceinline__ unsigned xb_add(unsigned* p, unsigned v) { return __hip_atomic_fetch_add(p, v, __ATOMIC_RELAXED, __HIP_MEMORY_SCOPE_AGENT); }
__device__ __forceinline__ unsigned xb_xcc_id() { return (unsigned)__builtin_amdgcn_s_getreg((3 << 11) | 20) & 0xFu; }
#define XB_SPIN(cond, bar) do { unsigned _sp = 0; while (cond) { __builtin_amdgcn_s_sleep(1); \
    if ((++_sp & 255u) == 0u) { if (xb_ld(&(bar)[XB_TMO])) break; if (_sp > XB_SPIN_CAP) { atomicAdd(&(bar)[XB_TMO], 1u); break; } } } } while (0)

struct XcdBarrier {
    unsigned* bar; unsigned x; unsigned w;
    volatile LAS unsigned* st;
};

__device__ __forceinline__ XcdBarrier xcd_barrier_post(unsigned* bar, volatile LAS unsigned* st) {
    XcdBarrier b; b.bar = bar; b.x = xb_xcc_id(); b.st = st; b.w = (unsigned)__builtin_amdgcn_readfirstlane((int)threadIdx.x >> 6);
    if (threadIdx.x == 0) (void)xb_add(&bar[XB_XCNT(b.x)], 1u);
    return b;
}
__device__ __forceinline__ void xcd_barrier_complete(unsigned* bar, unsigned x, unsigned& nloc, unsigned& nx) {
    const unsigned G = gridDim.x * gridDim.y * gridDim.z;
    unsigned sum, cnt, mine, sp = 0u;
    for (;;) {
        sum = 0u; cnt = 0u; mine = 0u;
#pragma unroll
        for (unsigned j = 0; j < 16; ++j) { const unsigned c = xb_ld(&bar[XB_XCNT(j)]); sum += c; cnt += (c > 0u) ? 1u : 0u; mine = (j == x) ? c : mine; }
        if (sum == G) break;
        __builtin_amdgcn_s_sleep(1);
        if ((++sp & 255u) == 0u) { if (xb_ld(&bar[XB_TMO])) break; if (sp > XB_SPIN_CAP) { atomicAdd(&bar[XB_TMO], 1u); break; } }
    }
    nloc = mine > 0u ? mine : 1u; nx = cnt > 0u ? cnt : 1u;
}

__device__ __forceinline__ void xcd_barrier(const XcdBarrier& b) {
    asm volatile("s_waitcnt vmcnt(0)" ::: "memory");
    __syncthreads();
    int l0_; asm volatile("v_mbcnt_lo_u32_b32 %0, -1, 0\n\tv_mbcnt_hi_u32_b32 %0, -1, %0" : "=v"(l0_));
    if (b.w == 0u && l0_ == 0) {
        unsigned* bar = b.bar; unsigned bx_ = b.x; asm volatile("" : "+s"(bar), "+s"(bx_));
        __builtin_amdgcn_s_waitcnt(0);
        unsigned nloc = b.st[0], nx = b.st[1];
        if (nloc == 0u) { xcd_barrier_complete(bar, bx_, nloc, nx); b.st[0] = nloc; b.st[1] = nx; }
        const unsigned old = xb_add(&bar[XB_XSUB(bx_)], 1u);
        const unsigned gen = old / nloc;
        if (old + 1u == (gen + 1u) * nloc) {
            __builtin_amdgcn_fence(__ATOMIC_RELEASE, "agent");
            asm volatile("s_waitcnt vmcnt(0)" ::: "memory");
            const unsigned og = xb_add(&bar[XB_TOP], 1u);
            const unsigned tg = og / nx;
            if (og + 1u == (tg + 1u) * nx) xb_add(&bar[XB_TOPGEN], 1u);
            else XB_SPIN(xb_ld(&bar[XB_TOPGEN]) == tg, bar);
            __builtin_amdgcn_fence(__ATOMIC_ACQUIRE, "agent");
            xb_add(&bar[XB_XGEN(bx_)], 1u);
            asm volatile("s_waitcnt vmcnt(0)" ::: "memory");
        } else {
            XB_SPIN(xb_ld(&bar[XB_XGEN(bx_)]) == gen, bar);
            __builtin_amdgcn_fence(__ATOMIC_ACQUIRE, "agent");
            asm volatile("s_waitcnt vmcnt(0)" ::: "memory");
        }
    }
    __syncthreads();
}

constexpr int DM = 1024, NB = 16, SEQ = 2048, DEPTH = 2, DBATCH = 32, DSEQ = 32, PAST = 4096;
constexpr int PR = NB * SEQ, SR = DBATCH * DSEQ, R = PR + SR;
constexpr int SBW = 512, LORA = 128, ROPE = 32, QLW = 1024, QRW = 256, DFF = 2816, UPW = 5632, DPLE = 256, NHEAD = 8;
constexpr int INC = 4512, NIN = 5120;
constexpr float EPS = 1e-6f, LOG2E = 1.4426950408889634f;
constexpr float QS_SB = 0.125f * LOG2E;
constexpr float QS_MLA = 0.10206207261596575f * LOG2E;
constexpr int NSLOT = 2048 + 32;

constexpr size_t O_Y = 0;
constexpr size_t O_SBK_P = (size_t)R * DM;
constexpr size_t O_SBV_P = O_SBK_P + (size_t)DEPTH * PR * SBW;
constexpr size_t O_CKV_P = O_SBV_P + (size_t)DEPTH * PR * SBW;
constexpr size_t O_KR_P = O_CKV_P + (size_t)DEPTH * PR * LORA;
constexpr size_t O_CONV_P = O_KR_P + (size_t)DEPTH * PR * ROPE;
constexpr size_t O_SBK_S = O_CONV_P + (size_t)DEPTH * NB * 2 * UPW;
constexpr size_t O_SBV_S = O_SBK_S + (size_t)DEPTH * SR * SBW;
constexpr size_t O_CKV_S = O_SBV_S + (size_t)DEPTH * SR * SBW;
constexpr size_t O_KR_S = O_CKV_S + (size_t)DEPTH * SR * LORA;
constexpr size_t O_CONV_S = O_KR_S + (size_t)DEPTH * SR * ROPE;
constexpr size_t O_END = O_CONV_S + (size_t)DEPTH * DBATCH * 2 * UPW;
static_assert(O_END == 115703808ull, "output map");

constexpr size_t MiB = 1u << 20;
constexpr size_t WS_CTL = 0, CTL_ZERO_BYTES = 1 * MiB;
constexpr size_t WS_ROPE = 1 * MiB;
constexpr size_t WS_W = 4 * MiB, WL = 36 * MiB;
constexpr size_t W_IN = 0, W_SB = 10 * MiB, W_YB = 11 * MiB, W_OUT = 13 * MiB, W_UP = 15 * MiB, W_DOWN = 26 * MiB, W_PG = 32 * MiB, W_PP = 34 * MiB;
constexpr size_t WS_XN = 80 * MiB, WS_QSB = 146 * MiB, WS_KSB = 179 * MiB, WS_VSB = 212 * MiB, WS_QLAT = 245 * MiB, WS_QROPE = 311 * MiB,
                 WS_CKVB = 328 * MiB, WS_KRB = 337 * MiB, WS_GA = 340 * MiB, WS_GB = 406 * MiB, WS_OSB = 472 * MiB, WS_OLAT = 505 * MiB,
                 WS_MG = 571 * MiB, WS_MIX = 637 * MiB, WS_XB = 769 * MiB, WS_PP = 835 * MiB, WS_PB = 967 * MiB, WS_U = 1000 * MiB,
                 WS_ACT = 1363 * MiB, WS_END = 1546 * MiB;
static_assert(W_PP + (size_t)DM * DPLE * 2 <= WL && WS_W + 2 * WL <= WS_XN, "weights map");
static_assert(WS_ACT + (size_t)R * DFF * 2 <= WS_END && WS_U + (size_t)R * UPW * 2 <= WS_ACT && WS_PB + 2 * (size_t)R * DPLE * 2 <= WS_U, "ws map");
constexpr int CW_BAR = 4096;

constexpr int RING_BYTES = 131072, XL_OFF = RING_BYTES, MISC_OFF = RING_BYTES + 8192, LDS_BYTES = 147456;

#ifndef MK_PER_PHASE
#define MK_PER_PHASE 0
#endif
#ifndef MK_PH_END
#define MK_PH_END (2 + 12 * DEPTH)
#endif
constexpr int NPHASE = MK_PH_END;
#ifndef FAST_SB
#define FAST_SB 1
#endif
#ifndef FAST_MLA
#define FAST_MLA 1
#endif
#ifndef FAST_SSB
#define FAST_SSB 1
#endif
#ifndef FAST_SMLA
#define FAST_SMLA 1
#endif

__device__ __forceinline__ float bf2f(unsigned short b) { return __uint_as_float((unsigned)b << 16); }
__device__ __forceinline__ float lo2f(unsigned w) { return __uint_as_float(w << 16); }
__device__ __forceinline__ float hi2f(unsigned w) { return __uint_as_float(w & 0xffff0000u); }
__device__ __forceinline__ float fexp2(float x) { return __builtin_amdgcn_exp2f(x); }
__device__ __forceinline__ float frcp(float x) { return __builtin_amdgcn_rcpf(x); }
__device__ __forceinline__ float sigm(float x) { return frcp(1.0f + fexp2(-LOG2E * x)); }
template <int O> __device__ __forceinline__ float xshfl(float v) {
    if constexpr (O == 32) { const auto sw = __builtin_amdgcn_permlane32_swap(__float_as_uint(v), __float_as_uint(v), false, false); const float a = __uint_as_float(sw[0]), b = __uint_as_float(sw[1]); return (a == v) ? b : a; }
    else return __uint_as_float((unsigned)__builtin_amdgcn_ds_swizzle((int)__float_as_uint(v), (O << 10) | 0x1f));
}
__device__ __forceinline__ float wave_sum(float v) {
    v += xshfl<1>(v); v += xshfl<2>(v); v += xshfl<4>(v); v += xshfl<8>(v); v += xshfl<16>(v);
    { const auto sw = __builtin_amdgcn_permlane32_swap(__float_as_uint(v), __float_as_uint(v), false, false); v = __uint_as_float(sw[0]) + __uint_as_float(sw[1]); }
    return v;
}
__device__ __forceinline__ v4u pack8(f32x4 a, f32x4 b) { v4u w; w.x = pg8::cvt_pk_bf16(a[0], a[1]); w.y = pg8::cvt_pk_bf16(a[2], a[3]); w.z = pg8::cvt_pk_bf16(b[0], b[1]); w.w = pg8::cvt_pk_bf16(b[2], b[3]); return w; }
__device__ __forceinline__ v4u pack8c(f32x4 a, f32x4 b) { v4u w; w.x = pg8::cvt_pk_bf16_c(a[0], a[1]); w.y = pg8::cvt_pk_bf16_c(a[2], a[3]); w.z = pg8::cvt_pk_bf16_c(b[0], b[1]); w.w = pg8::cvt_pk_bf16_c(b[2], b[3]); return w; }
__device__ __forceinline__ int ridx(int p) { return ((p >> 2) & 1) * 16 + 4 * (p >> 3) + (p & 3); }
__device__ __forceinline__ int pos_slot(int row) { return row < PR ? (row & (SEQ - 1)) : SEQ + ((row - PR) & (DSEQ - 1)); }

typedef pg8::f32x4 A4;

template <int NN> struct Ord {
    static constexpr int NM = R / 256, WG = 12, NWG = NM * NN, NIG = WG * NN, Q = NWG / 8, RM = NWG % 8;
    static_assert(NM % WG == 0, "row panels per group");
    int G, c;
    __device__ __forceinline__ void init(int G_, int c_) { G = G_; c = c_; }
    __device__ __forceinline__ bool next(int i, pg8::Unit& u) const {
        const int Lx = i * G + c; if (Lx >= NWG) return false;
        const int xcd = Lx & 7, off = Lx >> 3; const int wgid = (xcd < RM ? xcd * (Q + 1) : RM * (Q + 1) + (xcd - RM) * Q) + off;
        const int gid = wgid / NIG, rem = wgid - gid * NIG; u.pm = gid * WG + rem % WG; u.pn = rem / WG; return true;
    }
    __device__ __forceinline__ void a_ready(const pg8::Unit&) const {}
    __device__ __forceinline__ void done(const pg8::Unit&) const {}
};
struct EpiIn {
    static constexpr bool PERM = true, AFTER_DRAIN = false;
    unsigned char* ws_; float* out_; int L; const float* gain; LAS float* xl;
    __device__ __forceinline__ void operator()(const A4 (&acc)[2][2][4][2], const pg8::Unit& u, int wr, int wc, int fr, int fq) const {
        unsigned char* ws = ws_; float* out = out_; asm volatile("" : "+s"(ws), "+s"(out));
        bf16* const QSB = (bf16*)(ws + WS_QSB); bf16* const KSB = (bf16*)(ws + WS_KSB); bf16* const VSB = (bf16*)(ws + WS_VSB); bf16* const QLAT = (bf16*)(ws + WS_QLAT); bf16* const QROPE = (bf16*)(ws + WS_QROPE);
        bf16* const CKVB = (bf16*)(ws + WS_CKVB); bf16* const KRB = (bf16*)(ws + WS_KRB); bf16* const GA = (bf16*)(ws + WS_GA); bf16* const GB = (bf16*)(ws + WS_GB); const float* const tab = (const float*)(ws + WS_ROPE);
        float* const sbk_p = out + O_SBK_P + (size_t)L * PR * SBW; float* const sbv_p = out + O_SBV_P + (size_t)L * PR * SBW; float* const ckv_p = out + O_CKV_P + (size_t)L * PR * LORA; float* const kr_p = out + O_KR_P + (size_t)L * PR * ROPE;
        float* const sbk_s = out + O_SBK_S + (size_t)L * SR * SBW; float* const sbv_s = out + O_SBV_S + (size_t)L * SR * SBW; float* const ckv_s = out + O_CKV_S + (size_t)L * SR * LORA; float* const kr_s = out + O_KR_S + (size_t)L * SR * ROPE;
        const int pn = u.pn; const bool samp = u.pm >= PR / 256;
        const int row0 = u.pm * 256 + wr * 64 + fr;
        if (pn < 2) {
#pragma unroll
            for (int ai = 0; ai < 2; ++ai)
#pragma unroll
                for (int m = 0; m < 4; ++m) { const int row = row0 + ai * 128 + m * 16;
#pragma unroll
                    for (int bj = 0; bj < 2; ++bj) { const int col = pn * 256 + bj * 128 + wc * 32 + 8 * fq;
                        *(v4u*)(QSB + (size_t)row * SBW + col) = pack8(acc[ai][bj][m][0] * QS_SB, acc[ai][bj][m][1] * QS_SB); } }
        } else if (pn < 6) {
            const int which = (pn - 2) >> 1; bf16* B = which ? VSB : KSB;
            float* O = samp ? (which ? sbv_s : sbk_s) : (which ? sbv_p : sbk_p);
#pragma unroll
            for (int ai = 0; ai < 2; ++ai)
#pragma unroll
                for (int m = 0; m < 4; ++m) { const int row = row0 + ai * 128 + m * 16, prow = samp ? row - PR : row;
#pragma unroll
                    for (int bj = 0; bj < 2; ++bj) { const int col = ((pn - 2) & 1) * 256 + bj * 128 + wc * 32 + 8 * fq;
                        const A4 v0 = acc[ai][bj][m][0], v1 = acc[ai][bj][m][1];
                        float* op = O + (size_t)prow * SBW + col; *(A4*)op = v0; *(A4*)(op + 4) = v1;
                        *(v4u*)(B + (size_t)row * SBW + col) = pack8(v0, v1); } }
        } else if (pn < 10) {
#pragma unroll
            for (int ai = 0; ai < 2; ++ai)
#pragma unroll
                for (int m = 0; m < 4; ++m) { const int row = row0 + ai * 128 + m * 16;
#pragma unroll
                    for (int bj = 0; bj < 2; ++bj) { const int col = (pn - 6) * 256 + bj * 128 + wc * 32 + 8 * fq;
                        *(v4u*)(QLAT + (size_t)row * QLW + col) = pack8(acc[ai][bj][m][0] * QS_MLA, acc[ai][bj][m][1] * QS_MLA); } }
        } else if (pn == 10) {
#pragma unroll
            for (int ai = 0; ai < 2; ++ai)
#pragma unroll
                for (int m = 0; m < 4; ++m) { const int row = row0 + ai * 128 + m * 16; const float* tp = tab + pos_slot(row) * 32 + 4 * fq;
                    const A4 cs = *(const A4*)tp, sn = *(const A4*)(tp + 16);
#pragma unroll
                    for (int bj = 0; bj < 2; ++bj) { const int head = bj * 4 + wc; const A4 x1 = acc[ai][bj][m][0], x2 = acc[ai][bj][m][1];
                        const A4 y1 = (x1 * cs - x2 * sn) * QS_MLA, y2 = (x1 * sn + x2 * cs) * QS_MLA;
                        *(v4u*)(QROPE + (size_t)row * QRW + head * 32 + 8 * fq) = pack8(y1, y2); } }
        } else if (pn == 11) {
#pragma unroll
            for (int ai = 0; ai < 2; ++ai)
#pragma unroll
                for (int m = 0; m < 4; ++m) { const A4 a = acc[ai][0][m][0], b = acc[ai][0][m][1];
                    float s = (a[0] * a[0] + a[1] * a[1]) + (a[2] * a[2] + a[3] * a[3]) + (b[0] * b[0] + b[1] * b[1]) + (b[2] * b[2] + b[3] * b[3]);
                    s += xshfl<16>(s); { const auto sw = __builtin_amdgcn_permlane32_swap(__float_as_uint(s), __float_as_uint(s), false, false); s = __uint_as_float(sw[0]) + __uint_as_float(sw[1]); }
                    if (fq == 0) xl[(ai * 128 + wr * 64 + m * 16 + fr) * 4 + wc] = s; }
            asm volatile("s_waitcnt lgkmcnt(0)" ::: "memory"); __builtin_amdgcn_s_barrier(); asm volatile("" ::: "memory");
            const int ccol = wc * 32 + 8 * fq; const A4 g0 = *(const A4*)(gain + ccol), g1 = *(const A4*)(gain + ccol + 4);
#pragma unroll
            for (int ai = 0; ai < 2; ++ai)
#pragma unroll
                for (int m = 0; m < 4; ++m) { const int row = row0 + ai * 128 + m * 16, prow = samp ? row - PR : row;
                    const A4 p = *(const LAS A4*)(xl + (ai * 128 + wr * 64 + m * 16 + fr) * 4);
                    const float rs = 1.0f / sqrtf(((p[0] + p[1]) + (p[2] + p[3])) * (1.0f / LORA) + EPS);
                    const A4 v0 = acc[ai][0][m][0] * rs * g0, v1 = acc[ai][0][m][1] * rs * g1;
                    float* op = (samp ? ckv_s : ckv_p) + (size_t)prow * LORA + ccol; *(A4*)op = v0; *(A4*)(op + 4) = v1;
                    *(v4u*)(CKVB + (size_t)row * LORA + ccol) = pack8(v0, v1);
                    if (wc == 0) {
                        const float* tp = tab + pos_slot(row) * 32 + 4 * fq; const A4 cs = *(const A4*)tp, sn = *(const A4*)(tp + 16);
                        const A4 x1 = acc[ai][1][m][0], x2 = acc[ai][1][m][1];
                        const A4 y1 = x1 * cs - x2 * sn, y2 = x1 * sn + x2 * cs;
                        float* kp = (samp ? kr_s : kr_p) + (size_t)prow * ROPE + 4 * fq; *(A4*)kp = y1; *(A4*)(kp + 16) = y2;
                        *(v4u*)(KRB + (size_t)row * ROPE + 8 * fq) = pack8(y1, y2); } }
        } else {
            bf16* G = pn < 16 ? GA : GB;
#pragma unroll
            for (int ai = 0; ai < 2; ++ai)
#pragma unroll
                for (int m = 0; m < 4; ++m) { const int row = row0 + ai * 128 + m * 16;
#pragma unroll
                    for (int bj = 0; bj < 2; ++bj) { const int col = ((pn - 12) & 3) * 256 + bj * 128 + wc * 32 + 8 * fq;
                        const A4 a = acc[ai][bj][m][0], b = acc[ai][bj][m][1];
                        const A4 sa = {sigm(a[0]), sigm(a[1]), sigm(a[2]), sigm(a[3])}, sb = {sigm(b[0]), sigm(b[1]), sigm(b[2]), sigm(b[3])};
                        *(v4u*)(G + (size_t)row * DM + col) = pack8c(sa, sb); } }
        }
    }
};
template <bool ADD> struct EpiGate {
    static constexpr bool PERM = true, AFTER_DRAIN = false;
    const bf16* G; bf16* MG;
    __device__ __forceinline__ void operator()(const A4 (&acc)[2][2][4][2], const pg8::Unit& u, int wr, int wc, int fr, int fq) const {
        const int row0 = u.pm * 256 + wr * 64 + fr;
#pragma unroll
        for (int ai = 0; ai < 2; ++ai)
#pragma unroll
            for (int m = 0; m < 4; ++m) { const int row = row0 + ai * 128 + m * 16;
#pragma unroll
                for (int bj = 0; bj < 2; ++bj) { const size_t off = (size_t)row * DM + u.pn * 256 + bj * 128 + wc * 32 + 8 * fq;
                    const v4u g = *(const v4u*)(G + off);
                    A4 a = acc[ai][bj][m][0] * (A4){lo2f(g.x), hi2f(g.x), lo2f(g.y), hi2f(g.y)}, b = acc[ai][bj][m][1] * (A4){lo2f(g.z), hi2f(g.z), lo2f(g.w), hi2f(g.w)};
                    if (ADD) { const v4u o = *(const v4u*)(MG + off); a += (A4){lo2f(o.x), hi2f(o.x), lo2f(o.y), hi2f(o.y)}; b += (A4){lo2f(o.z), hi2f(o.z), lo2f(o.w), hi2f(o.w)}; }
                    *(v4u*)(MG + off) = pack8(a, b); } }
    }
};
struct EpiF32 {
    static constexpr bool PERM = true, AFTER_DRAIN = false;
    float* O; int ldc;
    __device__ __forceinline__ void operator()(const A4 (&acc)[2][2][4][2], const pg8::Unit& u, int wr, int wc, int fr, int fq) const {
        const int row0 = u.pm * 256 + wr * 64 + fr;
#pragma unroll
        for (int ai = 0; ai < 2; ++ai)
#pragma unroll
            for (int m = 0; m < 4; ++m) { const int row = row0 + ai * 128 + m * 16;
#pragma unroll
                for (int bj = 0; bj < 2; ++bj) { float* op = O + (size_t)row * ldc + u.pn * 256 + bj * 128 + wc * 32 + 8 * fq;
                    *(A4*)op = acc[ai][bj][m][0]; *(A4*)(op + 4) = acc[ai][bj][m][1]; } }
    }
};
struct EpiBf {
    static constexpr bool PERM = true, AFTER_DRAIN = false;
    bf16* O; int ldc; float* conv_p; float* conv_s;
    __device__ __forceinline__ void operator()(const A4 (&acc)[2][2][4][2], const pg8::Unit& u, int wr, int wc, int fr, int fq) const {
        const int row0 = u.pm * 256 + wr * 64 + fr; const bool samp = u.pm >= PR / 256;
#pragma unroll
        for (int ai = 0; ai < 2; ++ai)
#pragma unroll
            for (int m = 0; m < 4; ++m) { const int row = row0 + ai * 128 + m * 16;
                int ci = -1;
                if (conv_p) { if (!samp) { const int t = row & (SEQ - 1); if (t >= SEQ - 2) ci = (row >> 11) * 2 + (t - (SEQ - 2)); }
                              else { const int t = (row - PR) & (DSEQ - 1); if (t >= DSEQ - 2) ci = ((row - PR) >> 5) * 2 + (t - (DSEQ - 2)); } }
#pragma unroll
                for (int bj = 0; bj < 2; ++bj) { const int col = u.pn * 256 + bj * 128 + wc * 32 + 8 * fq;
                    *(v4u*)(O + (size_t)row * ldc + col) = pack8(acc[ai][bj][m][0], acc[ai][bj][m][1]);
                    if (ci >= 0) { float* cp = (samp ? conv_s : conv_p) + (size_t)ci * UPW + col; *(A4*)cp = acc[ai][bj][m][0]; *(A4*)(cp + 4) = acc[ai][bj][m][1]; } } }
    }
};
struct EpiPle {
    static constexpr bool PERM = true, AFTER_DRAIN = false;
    float* X; const bf16* PP;
    __device__ __forceinline__ void operator()(const A4 (&acc)[2][2][4][2], const pg8::Unit& u, int wr, int wc, int fr, int fq) const {
        const int row0 = u.pm * 256 + wr * 64 + fr;
#pragma unroll
        for (int ai = 0; ai < 2; ++ai)
#pragma unroll
            for (int m = 0; m < 4; ++m) { const int row = row0 + ai * 128 + m * 16;
#pragma unroll
                for (int bj = 0; bj < 2; ++bj) { const size_t off = (size_t)row * DM + u.pn * 256 + bj * 128 + wc * 32 + 8 * fq;
                    const v4u p = *(const v4u*)(PP + off); float* xp = X + off; const A4 x0 = *(const A4*)xp, x1 = *(const A4*)(xp + 4);
                    const A4 a = acc[ai][bj][m][0], b = acc[ai][bj][m][1];
                    const A4 sa = {sigm(a[0]), sigm(a[1]), sigm(a[2]), sigm(a[3])}, sb = {sigm(b[0]), sigm(b[1]), sigm(b[2]), sigm(b[3])};
                    *(A4*)xp = x0 + sa * (A4){lo2f(p.x), hi2f(p.x), lo2f(p.y), hi2f(p.y)}; *(A4*)(xp + 4) = x1 + sb * (A4){lo2f(p.z), hi2f(p.z), lo2f(p.w), hi2f(p.w)}; } }
    }
};

struct Args { const float* in[26]; float* out; unsigned char* ws; int ph_lo, ph_hi; };
typedef const __attribute__((address_space(4))) Args* CArgs;

__device__ __forceinline__ void row_op(int lane, const float* xin, const float* addsrc, const float* g_add, float* xout, bf16* bout, const float* g_out) {
    const f32x4* xr = (const f32x4*)xin + lane; f32x4 v[4];
#pragma unroll
    for (int j = 0; j < 4; ++j) v[j] = xr[64 * j];
    if (addsrc) {
        const f32x4* ar = (const f32x4*)addsrc + lane; const f32x4* gr = (const f32x4*)g_add + lane; f32x4 a[4]; float s = 0.f;
#pragma unroll
        for (int j = 0; j < 4; ++j) { a[j] = ar[64 * j]; s += (a[j].x * a[j].x + a[j].y * a[j].y) + (a[j].z * a[j].z + a[j].w * a[j].w); }
        const float r = 1.0f / sqrtf(wave_sum(s) * (1.0f / DM) + EPS);
#pragma unroll
        for (int j = 0; j < 4; ++j) v[j] += a[j] * r * gr[64 * j];
    }
    if (xout) { f32x4* xo = (f32x4*)xout + lane;
#pragma unroll
        for (int j = 0; j < 4; ++j) xo[64 * j] = v[j]; }
    if (bout) {
        if (g_out) { float s = 0.f; const f32x4* gr = (const f32x4*)g_out + lane;
#pragma unroll
            for (int j = 0; j < 4; ++j) s += (v[j].x * v[j].x + v[j].y * v[j].y) + (v[j].z * v[j].z + v[j].w * v[j].w);
            const float r = 1.0f / sqrtf(wave_sum(s) * (1.0f / DM) + EPS);
#pragma unroll
            for (int j = 0; j < 4; ++j) v[j] = v[j] * r * gr[64 * j]; }
        unsigned long long* o8 = (unsigned long long*)bout + lane;
#pragma unroll
        for (int j = 0; j < 4; ++j) o8[64 * j] = (unsigned long long)pg8::cvt_pk_bf16(v[j].x, v[j].y) | ((unsigned long long)pg8::cvt_pk_bf16(v[j].z, v[j].w) << 32);
    }
}

__device__ __forceinline__ void tr_item(const float* W, int N, bf16* WT, int K, int k0, int n0, int s0, bool perm, bool zero, LAS float* scr, int lane) {
    if (!zero) {
#pragma unroll 8
        for (int i = 0; i < 32; ++i) { const int kk = 2 * i + (lane >> 5); scr[kk * 33 + (lane & 31)] = W[(size_t)(k0 + kk) * N + s0 + (lane & 31)]; }
    }
    LDS_WAIT(); asm volatile("" ::: "memory");
    const int c = lane & 7;
#pragma unroll
    for (int j = 0; j < 4; ++j) { const int n = (lane >> 3) + 8 * j; const int sc = perm ? ridx(n) : n; const LAS float* s = scr + (8 * c) * 33 + sc;
        v4u o; o.x = pk2(s[0 * 33], s[1 * 33]); o.y = pk2(s[2 * 33], s[3 * 33]); o.z = pk2(s[4 * 33], s[5 * 33]); o.w = pk2(s[6 * 33], s[7 * 33]);
        if (zero) o = (v4u){0u, 0u, 0u, 0u};
        *(GAS v4u*)(WT + (size_t)(n0 + n) * K + k0 + 8 * c) = o; }
    LDS_WAIT(); asm volatile("" ::: "memory");
}
struct Seg { const float* W; bf16* WT; int N, K, n0, s0, sstride, ng, perm, zero; };
__device__ __forceinline__ Seg get_seg(CArgs a, int L, int s) {
    unsigned char* wb = a->ws + WS_W + (size_t)L * WL; const float* win = a->in[9] + (size_t)L * DM * INC; bf16* wint = (bf16*)(wb + W_IN);
    Seg g{win, wint, INC, DM, 0, 0, 32, 0, 0, 0};
    switch (s) {
        case 0: g.n0 = 0; g.s0 = 0; g.ng = 48; break;
        case 1: g.n0 = 2560; g.s0 = 1536 + 64; g.sstride = 96; g.ng = 8; g.perm = 1; break;
        case 2: g.n0 = 2816; g.s0 = 2304; g.ng = 4; break;
        case 3: g.n0 = 2944; g.s0 = 2432; g.ng = 1; g.perm = 1; break;
        case 4: g.n0 = 2976; g.s0 = 0; g.sstride = 0; g.ng = 3; g.zero = 1; break;
        case 5: g.n0 = 3072; g.s0 = 2464; g.ng = 64; break;
        case 6: g.W = a->in[13] + (size_t)L * SBW * DM; g.WT = (bf16*)(wb + W_SB); g.N = DM; g.K = SBW; g.ng = 32; break;
        case 7: g.W = a->in[15] + (size_t)L * DM * DM; g.WT = (bf16*)(wb + W_OUT); g.N = DM; g.K = DM; g.ng = 32; break;
        case 8: g.W = a->in[20] + (size_t)L * DM * UPW; g.WT = (bf16*)(wb + W_UP); g.N = UPW; g.K = DM; g.ng = 176; break;
        case 9: g.W = a->in[23] + (size_t)L * DFF * DM; g.WT = (bf16*)(wb + W_DOWN); g.N = DM; g.K = DFF; g.ng = 32; break;
        case 10: g.W = a->in[24] + (size_t)L * DM * DM; g.WT = (bf16*)(wb + W_PG); g.N = DM; g.K = DM; g.ng = 32; break;
        default: g.W = a->in[25] + (size_t)L * DPLE * DM; g.WT = (bf16*)(wb + W_PP); g.N = DM; g.K = DPLE; g.ng = 32; break;
    }
    return g;
}
constexpr int NSEG = 12;

__device__ __forceinline__ void sincos_d(float ang, float& s, float& c) {
    const double x = (double)ang; const double q = rint(x * 0.63661977236758134308); const double r = x - q * 1.57079632679489661923; const double r2 = r * r;
    double sp = -2.5052108385441718775e-08; sp = sp * r2 + 2.7557319223985890653e-06; sp = sp * r2 - 1.9841269841269841270e-04; sp = sp * r2 + 8.3333333333333333333e-03; sp = sp * r2 - 1.6666666666666666667e-01; sp = r + r * r2 * sp;
    double cp = 2.0876756987868098979e-09; cp = cp * r2 - 2.7557319223985890653e-07; cp = cp * r2 + 2.4801587301587301587e-05; cp = cp * r2 - 1.3888888888888888889e-03; cp = cp * r2 + 4.1666666666666666667e-02; cp = cp * r2 - 0.5; cp = 1.0 + r2 * cp;
    const int qi = (int)((long long)q & 3);
    const double ss = (qi == 0) ? sp : (qi == 1) ? cp : (qi == 2) ? -sp : -cp;
    const double cc = (qi == 0) ? cp : (qi == 1) ? -sp : (qi == 2) ? -cp : sp;
    s = (float)ss; c = (float)cc;
}

__device__ __forceinline__ void p0_prologue(CArgs a, LAS unsigned char* lds, int vcu, int G, int wave, int lane) {
    const int gw = vcu * 8 + wave, NGW = G * 8, gt = gw * 64 + lane, NGT = NGW * 64;
    LAS float* scr = (LAS float*)(lds + wave * 16384);
    for (int L = 0; L < DEPTH; ++L)
        for (int s = 0; s < NSEG; ++s) { const Seg g = get_seg(a, L, s); const int nit = (g.K / 64) * g.ng;
            for (int it = gw; it < nit; it += NGW) { const int kb = it / g.ng, gi = it - kb * g.ng;
                tr_item(g.W, g.N, g.WT, g.K, 64 * kb, g.n0 + 32 * gi, g.s0 + g.sstride * gi, g.perm != 0, g.zero != 0, scr, lane); } }
    for (int L = 0; L < DEPTH; ++L) { const float* win = a->in[9] + (size_t)L * DM * INC; const float* wuk = a->in[11] + (size_t)L * LORA * NHEAD * 64;
        bf16* wint = (bf16*)(a->ws + WS_W + (size_t)L * WL + W_IN);
        for (int e = gt; e < QLW * DM; e += NGT) { const int k = e & (DM - 1), nr = e >> 10, h = nr >> 7, l = nr & 127;
            const f32x4* wp = (const f32x4*)(win + (size_t)k * INC + 1536 + 96 * h); const f32x4* up = (const f32x4*)(wuk + ((size_t)l * NHEAD + h) * 64); float s = 0.f;
#pragma unroll 4
            for (int j = 0; j < 16; ++j) { const f32x4 w = wp[j], u = up[j]; s += (w.x * u.x + w.y * u.y) + (w.z * u.z + w.w * u.w); }
            wint[(size_t)(1536 + nr) * DM + k] = (bf16)f2bf(s); } }
    for (int L = 0; L < DEPTH; ++L) { const float* wuv = a->in[12] + (size_t)L * LORA * NHEAD * 64; const float* wpm = a->in[14] + (size_t)L * SBW * DM;
        bf16* wyb = (bf16*)(a->ws + WS_W + (size_t)L * WL + W_YB);
        for (int e = gt; e < DM * QLW; e += NGT) { const int hl = e & (QLW - 1), n = e >> 10, h = hl >> 7, l = hl & 127;
            const f32x4* up = (const f32x4*)(wuv + ((size_t)l * NHEAD + h) * 64); const float* pp = wpm + (size_t)(h * 64) * DM + n; float s = 0.f;
#pragma unroll 4
            for (int j = 0; j < 16; ++j) { const f32x4 u = up[j]; s += (u.x * pp[(size_t)(4 * j) * DM] + u.y * pp[(size_t)(4 * j + 1) * DM]) + (u.z * pp[(size_t)(4 * j + 2) * DM] + u.w * pp[(size_t)(4 * j + 3) * DM]); }
            wyb[(size_t)n * QLW + hl] = (bf16)f2bf(s); } }
    { float* tab = (float*)(a->ws + WS_ROPE);
        for (int e = gt; e < NSLOT * 16; e += NGT) { const int slot = e >> 4, i = e & 15; const int pos = slot < SEQ ? slot : PAST + (slot - SEQ);
            const float freq = exp2f(-(float)i * (13.287712379549449f / 16.0f));
            float s, c; sincos_d((float)pos * freq, s, c); tab[slot * 32 + i] = c; tab[slot * 32 + 16 + i] = s; } }
    for (int m = gw; m < R; m += NGW) { const float* xin = m < PR ? a->in[0] + (size_t)m * DM : a->in[1] + (size_t)(m - PR) * DM;
        row_op(lane, xin, nullptr, nullptr, a->out + O_Y + (size_t)m * DM, (bf16*)(a->ws + WS_XN) + (size_t)m * DM, a->in[16]); }
    for (int e = gt; e < DEPTH * R * (DPLE / 8); e += NGT) { const int c8 = e & 31, rr = e >> 5, L = rr / R, row = rr - L * R;
        const float* src = row < PR ? a->in[2] + ((size_t)L * PR + row) * DPLE + 8 * c8 : a->in[3] + ((size_t)L * SR + (row - PR)) * DPLE + 8 * c8;
        const f32x4 x0 = *(const f32x4*)src, x1 = *(const f32x4*)(src + 4);
        *(v4u*)((bf16*)(a->ws + WS_PB) + ((size_t)L * R + row) * DPLE + 8 * c8) = pack8(x0, x1); }
}

__device__ __forceinline__ void conv_phase(CArgs a, int L, int vcu, int G, int wave, int lane) {
    const int gw = vcu * 8 + wave, NGW = G * 8; constexpr int NCG = (DFF / 8 + 63) / 64;
    const bf16* U = (const bf16*)(a->ws + WS_U); bf16* ACT = (bf16*)(a->ws + WS_ACT);
    const float* cw = a->in[21] + (size_t)L * 3 * UPW; const float* cb = a->in[22] + (size_t)L * UPW;
    for (int it = gw; it < (R / 32) * NCG; it += NGW) { const int strip = it / NCG, cg = it - strip * NCG; const int c8 = cg * 64 + lane; if (c8 >= DFF / 8) continue;
        const int col = 8 * c8, r0 = strip * 32; const bool samp = r0 >= PR;
        float w[2][3][8], bs[2][8], p2[2][8], p1[2][8];
#pragma unroll
        for (int gv = 0; gv < 2; ++gv) {
#pragma unroll
            for (int i = 0; i < 3; ++i) { const f32x4 x0 = *(const f32x4*)(cw + (size_t)i * UPW + gv * DFF + col), x1 = *(const f32x4*)(cw + (size_t)i * UPW + gv * DFF + col + 4);
                w[gv][i][0] = x0.x; w[gv][i][1] = x0.y; w[gv][i][2] = x0.z; w[gv][i][3] = x0.w; w[gv][i][4] = x1.x; w[gv][i][5] = x1.y; w[gv][i][6] = x1.z; w[gv][i][7] = x1.w; }
            const f32x4 b0 = *(const f32x4*)(cb + gv * DFF + col), b1 = *(const f32x4*)(cb + gv * DFF + col + 4);
            bs[gv][0] = b0.x; bs[gv][1] = b0.y; bs[gv][2] = b0.z; bs[gv][3] = b0.w; bs[gv][4] = b1.x; bs[gv][5] = b1.y; bs[gv][6] = b1.z; bs[gv][7] = b1.w;
            if (samp) { const float* st = a->in[8] + (((size_t)L * DBATCH + ((r0 - PR) >> 5)) * 2) * UPW + gv * DFF + col;
                const f32x4 a0 = *(const f32x4*)st, a1 = *(const f32x4*)(st + 4), c0 = *(const f32x4*)(st + UPW), c1 = *(const f32x4*)(st + UPW + 4);
                p2[gv][0] = a0.x; p2[gv][1] = a0.y; p2[gv][2] = a0.z; p2[gv][3] = a0.w; p2[gv][4] = a1.x; p2[gv][5] = a1.y; p2[gv][6] = a1.z; p2[gv][7] = a1.w;
                p1[gv][0] = c0.x; p1[gv][1] = c0.y; p1[gv][2] = c0.z; p1[gv][3] = c0.w; p1[gv][4] = c1.x; p1[gv][5] = c1.y; p1[gv][6] = c1.z; p1[gv][7] = c1.w;
            } else if ((r0 & (SEQ - 1)) == 0) {
#pragma unroll
                for (int e = 0; e < 8; ++e) { p2[gv][e] = 0.f; p1[gv][e] = 0.f; }
            } else { const v4u x2 = *(const v4u*)(U + (size_t)(r0 - 2) * UPW + gv * DFF + col), x1 = *(const v4u*)(U + (size_t)(r0 - 1) * UPW + gv * DFF + col);
                p2[gv][0] = lo2f(x2.x); p2[gv][1] = hi2f(x2.x); p2[gv][2] = lo2f(x2.y); p2[gv][3] = hi2f(x2.y); p2[gv][4] = lo2f(x2.z); p2[gv][5] = hi2f(x2.z); p2[gv][6] = lo2f(x2.w); p2[gv][7] = hi2f(x2.w);
                p1[gv][0] = lo2f(x1.x); p1[gv][1] = hi2f(x1.x); p1[gv][2] = lo2f(x1.y); p1[gv][3] = hi2f(x1.y); p1[gv][4] = lo2f(x1.z); p1[gv][5] = hi2f(x1.z); p1[gv][6] = lo2f(x1.w); p1[gv][7] = hi2f(x1.w); }
        }
        for (int t = 0; t < 32; ++t) { const int row = r0 + t; float cur[2][8], uc[2][8];
#pragma unroll
            for (int gv = 0; gv < 2; ++gv) { const v4u x = *(const v4u*)(U + (size_t)row * UPW + gv * DFF + col);
                cur[gv][0] = lo2f(x.x); cur[gv][1] = hi2f(x.x); cur[gv][2] = lo2f(x.y); cur[gv][3] = hi2f(x.y); cur[gv][4] = lo2f(x.z); cur[gv][5] = hi2f(x.z); cur[gv][6] = lo2f(x.w); cur[gv][7] = hi2f(x.w);
#pragma unroll
                for (int e = 0; e < 8; ++e) { uc[gv][e] = bs[gv][e] + p2[gv][e] * w[gv][0][e] + p1[gv][e] * w[gv][1][e] + cur[gv][e] * w[gv][2][e]; p2[gv][e] = p1[gv][e]; p1[gv][e] = cur[gv][e]; } }
            float o[8];
#pragma unroll
            for (int e = 0; e < 8; ++e) { const float x = uc[0][e]; const float y = 1.5957691216057308f * (x + 0.044715f * x * x * x); o[e] = x * frcp(1.0f + fexp2(-LOG2E * y)) * uc[1][e]; }
            *(v4u*)(ACT + (size_t)row * DFF + col) = pack8((f32x4){o[0], o[1], o[2], o[3]}, (f32x4){o[4], o[5], o[6], o[7]}); }
    }
}

__device__ __forceinline__ void naive_sb(CArgs a, int L, int vcu, int G, int wave, int lane) {
    const int gw = vcu * 8 + wave, NGW = G * 8;
    const bf16* QSB = (const bf16*)(a->ws + WS_QSB); const bf16* KSB = (const bf16*)(a->ws + WS_KSB); const bf16* VSB = (const bf16*)(a->ws + WS_VSB); bf16* OSB = (bf16*)(a->ws + WS_OSB);
    constexpr int NP = NB * NHEAD * (SEQ / 64), NS = DBATCH * NHEAD;
    for (int it = gw + (FAST_SB ? NP : 0); it < NP + (FAST_SSB ? 0 : NS); it += NGW) {
        const bool samp = it >= NP; int b, h, t, qrow, nown, rowbase;
        if (!samp) { b = it >> 8; h = (it >> 5) & 7; int tb = it & 31; if ((it / NGW) & 1) tb = 31 - tb; t = tb * 64 + lane; rowbase = b * SEQ; qrow = rowbase + t; nown = tb * 64 + 63; }
        else { const int bh = it - NP; b = bh >> 3; h = bh & 7; t = lane & 31; rowbase = PR + b * DSEQ; qrow = rowbase + t; nown = DSEQ - 1; }
        b = __builtin_amdgcn_readfirstlane(b); h = __builtin_amdgcn_readfirstlane(h); rowbase = __builtin_amdgcn_readfirstlane(rowbase); nown = __builtin_amdgcn_readfirstlane(nown);
        float q[64], o[64];
        { const v4u* qp = (const v4u*)(QSB + (size_t)qrow * SBW + h * 64);
#pragma unroll
            for (int c = 0; c < 8; ++c) { const v4u x = qp[c]; q[8 * c] = lo2f(x.x); q[8 * c + 1] = hi2f(x.x); q[8 * c + 2] = lo2f(x.y); q[8 * c + 3] = hi2f(x.y); q[8 * c + 4] = lo2f(x.z); q[8 * c + 5] = hi2f(x.z); q[8 * c + 6] = lo2f(x.w); q[8 * c + 7] = hi2f(x.w); } }
#pragma unroll
        for (int d = 0; d < 64; ++d) o[d] = 0.f;
        float carry = 1.0f; int vz = 0; asm volatile("" : "+v"(vz));
        for (int s = nown - 1; s >= 0; --s) {
            const v4u* kp = (const v4u*)(KSB + (size_t)(rowbase + s) * SBW + h * 64 + vz); const v4u* vp = (const v4u*)(VSB + (size_t)(rowbase + s) * SBW + h * 64 + vz);
            float z = 0.f;
#pragma unroll
            for (int c = 0; c < 8; ++c) { const v4u x = kp[c]; z += q[8 * c] * lo2f(x.x) + q[8 * c + 1] * hi2f(x.x) + q[8 * c + 2] * lo2f(x.y) + q[8 * c + 3] * hi2f(x.y) + q[8 * c + 4] * lo2f(x.z) + q[8 * c + 5] * hi2f(x.z) + q[8 * c + 6] * lo2f(x.w) + q[8 * c + 7] * hi2f(x.w); }
            const float e = fexp2(z), rr = frcp(1.0f + e), beta = 1.0f - rr; const bool vis = s < t;
            const float w = vis ? beta * carry : 0.f; carry = vis ? carry * rr : carry;
#pragma unroll
            for (int c = 0; c < 8; ++c) { const v4u x = vp[c]; o[8 * c] += w * lo2f(x.x); o[8 * c + 1] += w * hi2f(x.x); o[8 * c + 2] += w * lo2f(x.y); o[8 * c + 3] += w * hi2f(x.y); o[8 * c + 4] += w * lo2f(x.z); o[8 * c + 5] += w * hi2f(x.z); o[8 * c + 6] += w * lo2f(x.w); o[8 * c + 7] += w * hi2f(x.w); }
        }
        if (samp) {
            const float* ck = a->in[4] + ((((size_t)L * DBATCH + b) * PAST) * NHEAD + h) * 64; const float* cv = a->in[5] + ((((size_t)L * DBATCH + b) * PAST) * NHEAD + h) * 64;
            for (int s = PAST - 1; s >= 0; --s) { const f32x4* kp = (const f32x4*)(ck + (size_t)s * SBW + vz); const f32x4* vp = (const f32x4*)(cv + (size_t)s * SBW + vz);
                float z = 0.f;
#pragma unroll
                for (int c = 0; c < 16; ++c) { const f32x4 x = kp[c]; z += q[4 * c] * x.x + q[4 * c + 1] * x.y + q[4 * c + 2] * x.z + q[4 * c + 3] * x.w; }
                const float e = fexp2(z), rr = frcp(1.0f + e), beta = 1.0f - rr; const float w = beta * carry; carry *= rr;
#pragma unroll
                for (int c = 0; c < 16; ++c) { const f32x4 x = vp[c]; o[4 * c] += w * x.x; o[4 * c + 1] += w * x.y; o[4 * c + 2] += w * x.z; o[4 * c + 3] += w * x.w; }
            }
        }
        if (!samp || lane < 32) { v4u* op = (v4u*)(OSB + (size_t)qrow * SBW + h * 64);
#pragma unroll
            for (int c = 0; c < 8; ++c) op[c] = pack8((f32x4){o[8 * c], o[8 * c + 1], o[8 * c + 2], o[8 * c + 3]}, (f32x4){o[8 * c + 4], o[8 * c + 5], o[8 * c + 6], o[8 * c + 7]}); }
    }
}
__device__ __forceinline__ void naive_mla(CArgs a, int L, int vcu, int G, int wave, int lane) {
    const int gw = vcu * 8 + wave, NGW = G * 8;
    const bf16* QLAT = (const bf16*)(a->ws + WS_QLAT); const bf16* QROPE = (const bf16*)(a->ws + WS_QROPE); const bf16* CKVB = (const bf16*)(a->ws + WS_CKVB); const bf16* KRB = (const bf16*)(a->ws + WS_KRB);
    bf16* OLAT = (bf16*)(a->ws + WS_OLAT);
    for (int it = gw + (FAST_MLA ? PR * NHEAD : 0); it < (FAST_SMLA ? PR : R) * NHEAD; it += NGW) { const int row = it >> 3, h = it & 7; const bool samp = row >= PR;
        const unsigned qw = *(const unsigned*)(QLAT + (size_t)row * QLW + h * 128 + 2 * lane); const float q0 = lo2f(qw), q1 = hi2f(qw);
        const float qr = lane < 32 ? bf2f(QROPE[(size_t)row * QRW + h * 32 + lane]) : 0.f;
        int rowbase, nk; if (!samp) { rowbase = row & ~(SEQ - 1); nk = 64 * (((row & (SEQ - 1)) >> 6) + 1); } else { rowbase = PR + (((row - PR) >> 5) << 5); nk = DSEQ; }
        float m = -INFINITY, l = 0.f, o0 = 0.f, o1 = 0.f;
        for (int s = 0; s < nk; s += 4) { float sc[4], c0[4], c1[4];
#pragma unroll
            for (int j = 0; j < 4; ++j) { const size_t kr = (size_t)(rowbase + s + j); const unsigned cw = *(const unsigned*)(CKVB + kr * LORA + 2 * lane); c0[j] = lo2f(cw); c1[j] = hi2f(cw);
                const float r = lane < 32 ? bf2f(KRB[kr * ROPE + lane]) : 0.f; sc[j] = q0 * c0[j] + q1 * c1[j] + qr * r; }
#pragma unroll
            for (int off = 1; off < 64; off <<= 1) {
#pragma unroll
                for (int j = 0; j < 4; ++j) sc[j] += __shfl_xor(sc[j], off); }
#pragma unroll
            for (int j = 0; j < 4; ++j) { const float mn = fmaxf(m, sc[j]), al = fexp2(m - mn), p = fexp2(sc[j] - mn); l = l * al + p; o0 = o0 * al + p * c0[j]; o1 = o1 * al + p * c1[j]; m = mn; }
        }
        if (samp) { const int b = (row - PR) >> 5; const float* cc = a->in[6] + ((size_t)L * DBATCH + b) * PAST * LORA; const float* cr = a->in[7] + ((size_t)L * DBATCH + b) * PAST * ROPE; const int ri = ridx(lane & 31);
            for (int s = 0; s < PAST; s += 4) { float sc[4], c0[4], c1[4];
#pragma unroll
                for (int j = 0; j < 4; ++j) { const float2 cv = *(const float2*)(cc + (size_t)(s + j) * LORA + 2 * lane); c0[j] = cv.x; c1[j] = cv.y;
                    const float r = lane < 32 ? cr[(size_t)(s + j) * ROPE + ri] : 0.f; sc[j] = q0 * c0[j] + q1 * c1[j] + qr * r; }
#pragma unroll
                for (int off = 1; off < 64; off <<= 1) {
#pragma unroll
                    for (int j = 0; j < 4; ++j) sc[j] += __shfl_xor(sc[j], off); }
#pragma unroll
                for (int j = 0; j < 4; ++j) { const float mn = fmaxf(m, sc[j]), al = fexp2(m - mn), p = fexp2(sc[j] - mn); l = l * al + p; o0 = o0 * al + p * c0[j]; o1 = o1 * al + p * c1[j]; m = mn; }
            } }
        const float il = 1.0f / l;
        *(unsigned*)(OLAT + (size_t)row * QLW + h * 128 + 2 * lane) = pg8::cvt_pk_bf16(o0 * il, o1 * il);
    }
}


typedef float f32x16 __attribute__((ext_vector_type(16)));
typedef short s16x4 __attribute__((ext_vector_type(4)));
typedef short v4i16_t __attribute__((ext_vector_type(4)));
__device__ __forceinline__ int crow(int r, int hi) { return (r & 3) + 8 * (r >> 2) + 4 * hi; }
__device__ __forceinline__ s16x4 vtr(LAS unsigned char* p) { return __builtin_bit_cast(s16x4, __builtin_amdgcn_ds_read_tr16_b64_v4i16((LAS v4i16_t*)p)); }
__device__ __forceinline__ bf16x8 cat8(s16x4 lo, s16x4 hi) { return (bf16x8){lo[0], lo[1], lo[2], lo[3], hi[0], hi[1], hi[2], hi[3]}; }
__device__ __forceinline__ bf16x8 pk8(const f32x16& w, int b) { v4u u; u.x = pg8::cvt_pk_bf16_c(w[b], w[b + 1]); u.y = pg8::cvt_pk_bf16_c(w[b + 2], w[b + 3]); u.z = pg8::cvt_pk_bf16_c(w[b + 4], w[b + 5]); u.w = pg8::cvt_pk_bf16_c(w[b + 6], w[b + 7]); return __builtin_bit_cast(bf16x8, u); }
#define ATT_WAITBAR() do { asm volatile("s_waitcnt vmcnt(0) lgkmcnt(0)" ::: "memory"); __builtin_amdgcn_s_barrier(); asm volatile("" ::: "memory"); } while (0)

constexpr int SBA_K = 0, SBA_V = 16384, SBA_ST = 32768;
__device__ __forceinline__ void sb_unit(const bf16* QSB, const bf16* KSB, const bf16* VSB, bf16* OSB, int rowbase, int h, int qb, LAS unsigned char* lds, int wave, int lane) {
    const int r32 = lane & 31, hi = lane >> 5; const int q0 = qb * 256, rowmin = q0 + 32 * wave, NT = 4 * qb + 4;
    const bf16* ksrc = KSB + (size_t)(rowbase + lane) * SBW + h * 64 + wave * 8;
    const bf16* vsrc = VSB + (size_t)(rowbase + 16 * (wave & 3) + (lane >> 2)) * SBW + h * 64 + (wave >> 2) * 32 + (lane & 3) * 8;
#define SB_DMA(j, bsel) do { __builtin_amdgcn_global_load_lds((const unsigned*)(ksrc + (size_t)(j) * 64 * SBW), (LAS unsigned*)(lds + SBA_K + (bsel) * 8192 + wave * 1024), 16, 0, 0); \
                             __builtin_amdgcn_global_load_lds((const unsigned*)(vsrc + (size_t)(j) * 64 * SBW), (LAS unsigned*)(lds + SBA_V + (bsel) * 8192 + wave * 1024), 16, 0, 0); } while (0)
    SB_DMA(NT - 1, 0);
    bf16x8 qr[4]; { const bf16* qp = QSB + (size_t)(rowbase + rowmin + r32) * SBW + h * 64 + hi * 8;
#pragma unroll
        for (int d0 = 0; d0 < 4; ++d0) qr[d0] = *(const bf16x8*)(qp + d0 * 16); }
    f32x16 o0 = {}, o1 = {}; float carry = 1.0f;
    ATT_WAITBAR();
    for (int it = 0; it < NT; ++it) { const int jt = NT - 1 - it, cur = it & 1;
        if (jt > 0) SB_DMA(jt - 1, cur ^ 1);
        const int kmin = 64 * jt;
        if (kmin < rowmin + 32) {
            LAS unsigned char* Kb = lds + SBA_K + cur * 8192 + hi * 1024 + r32 * 16;
            f32x16 p0 = {}, p1 = {};
#pragma unroll
            for (int d0 = 0; d0 < 4; ++d0) { const bf16x8 b0 = *(LAS bf16x8*)(Kb + d0 * 2048), b1 = *(LAS bf16x8*)(Kb + d0 * 2048 + 512);
                p0 = __builtin_amdgcn_mfma_f32_32x32x16_bf16(b0, qr[d0], p0, 0, 0, 0); p1 = __builtin_amdgcn_mfma_f32_32x32x16_bf16(b1, qr[d0], p1, 0, 0, 0); }
            if (kmin + 64 > rowmin) {
                const int t = rowmin + r32, kb = kmin + 4 * hi;
#pragma unroll
                for (int r = 0; r < 16; ++r) { const int kv = kb + (r & 3) + 8 * (r >> 2); if (kv >= t) p0[r] = -INFINITY; if (kv + 32 >= t) p1[r] = -INFINITY; }
            }
#pragma unroll
            for (int r = 0; r < 16; ++r) { p0[r] = frcp(1.0f + fexp2(p0[r])); p1[r] = frcp(1.0f + fexp2(p1[r])); }
            float GA[8];
#pragma unroll
            for (int k = 0; k < 4; ++k) { GA[k] = (p0[4 * k] * p0[4 * k + 1]) * (p0[4 * k + 2] * p0[4 * k + 3]); GA[4 + k] = (p1[4 * k] * p1[4 * k + 1]) * (p1[4 * k + 2] * p1[4 * k + 3]); }
            float SG[8]; float T = carry;
#pragma unroll
            for (int kk = 7; kk >= 0; --kk) { const auto sw = __builtin_amdgcn_permlane32_swap(__float_as_uint(GA[kk]), __float_as_uint(GA[kk]), false, false);
                const float G0 = __uint_as_float(sw[0]), G1 = __uint_as_float(sw[1]);
                const float s1 = T; T *= G1; const float s0 = T; T *= G0; SG[kk] = hi ? s1 : s0; }
            carry = T;
            f32x16 w0, w1;
#pragma unroll
            for (int k = 0; k < 4; ++k) {
                { float t = SG[k]; w0[4 * k + 3] = t * (1.0f - p0[4 * k + 3]); t *= p0[4 * k + 3]; w0[4 * k + 2] = t * (1.0f - p0[4 * k + 2]); t *= p0[4 * k + 2];
                  w0[4 * k + 1] = t * (1.0f - p0[4 * k + 1]); t *= p0[4 * k + 1]; w0[4 * k] = t * (1.0f - p0[4 * k]); }
                { float t = SG[4 + k]; w1[4 * k + 3] = t * (1.0f - p1[4 * k + 3]); t *= p1[4 * k + 3]; w1[4 * k + 2] = t * (1.0f - p1[4 * k + 2]); t *= p1[4 * k + 2];
                  w1[4 * k + 1] = t * (1.0f - p1[4 * k + 1]); t *= p1[4 * k + 1]; w1[4 * k] = t * (1.0f - p1[4 * k]); } }
            const bf16x8 pa0 = pk8(w0, 0), pa1 = pk8(w0, 8), pa2 = pk8(w1, 0), pa3 = pk8(w1, 8);
            LAS unsigned char* vb = lds + SBA_V + cur * 8192 + ((lane >> 4) & 1) * 32 + (lane & 3) * 8 + (4 * hi + ((lane & 15) >> 2)) * 64;
#pragma unroll
            for (int ks = 0; ks < 4; ++ks) { const bf16x8 pa = ks == 0 ? pa0 : ks == 1 ? pa1 : ks == 2 ? pa2 : pa3;
                const bf16x8 v0 = cat8(vtr(vb + ks * 1024), vtr(vb + ks * 1024 + 512)), v1 = cat8(vtr(vb + 4096 + ks * 1024), vtr(vb + 4096 + ks * 1024 + 512));
                o0 = __builtin_amdgcn_mfma_f32_32x32x16_bf16(pa, v0, o0, 0, 0, 0); o1 = __builtin_amdgcn_mfma_f32_32x32x16_bf16(pa, v1, o1, 0, 0, 0); }
        }
        ATT_WAITBAR();
    }
#undef SB_DMA
    { LAS unsigned short* stg = (LAS unsigned short*)(lds + SBA_ST + wave * 4096);
#pragma unroll
        for (int r = 0; r < 16; ++r) { const int orow = crow(r, hi); stg[orow * 64 + r32] = (unsigned short)f2bf(o0[r]); stg[orow * 64 + 32 + r32] = (unsigned short)f2bf(o1[r]); }
        asm volatile("s_waitcnt lgkmcnt(0)" ::: "memory");
        bf16* op = OSB + (size_t)(rowbase + rowmin) * SBW + h * 64;
#pragma unroll
        for (int i = 0; i < 4; ++i) { const int row = i * 8 + (lane >> 3), ch = lane & 7; const v4u v = *(LAS v4u*)(stg + row * 64 + ch * 8); *(v4u*)(op + (size_t)row * SBW + ch * 8) = v; }
        asm volatile("s_waitcnt lgkmcnt(0)" ::: "memory");
    }
}
__device__ __forceinline__ void sb_prompt(CArgs a, LAS unsigned char* lds, int vcu, int G, int wave, int lane) {
    const bf16* QSB = (const bf16*)(a->ws + WS_QSB); const bf16* KSB = (const bf16*)(a->ws + WS_KSB); const bf16* VSB = (const bf16*)(a->ws + WS_VSB); bf16* OSB = (bf16*)(a->ws + WS_OSB);
    for (int u = vcu; u < NB * NHEAD * 8; u += G) { const int i = u >> 8, v = u & 255, bh = v >> 1, s = v & 1; const int qb = i == 0 ? s : i == 1 ? 7 - s : i == 2 ? 2 + s : 5 - s;
        sb_unit(QSB, KSB, VSB, OSB, (bh >> 3) * SEQ, bh & 7, qb, lds, wave, lane); }
}

constexpr int MLA_K = 0, MLA_V = 40960, MLA_WS = 73728, MLA_ST = 0;
__device__ __forceinline__ void mla_unit(const bf16* QLAT, const bf16* QROPE, const bf16* CKVB, const bf16* KRB, bf16* OLAT, int rowbase, int qb32, LAS unsigned char* lds, int wave, int lane) {
    const int r32 = lane & 31, hi = lane >> 5, h = wave; const int NT = (qb32 >> 1) + 1; const int qrow = rowbase + 32 * qb32;
    const bf16* kc0 = CKVB + (size_t)(rowbase + lane) * LORA + wave * 8;
    const bf16* kr0 = KRB + (size_t)(rowbase + lane) * ROPE + (wave & 3) * 8;
    const bf16* vs0 = CKVB + (size_t)(rowbase + 16 * (wave & 3) + (lane >> 2)) * LORA + (wave >> 2) * 32 + (lane & 3) * 8;
#define MLA_DMA(j, bsel) do { LAS unsigned char* kd = lds + MLA_K + (bsel) * 20480; LAS unsigned char* vd = lds + MLA_V + (bsel) * 16384; \
        __builtin_amdgcn_global_load_lds((const unsigned*)(kc0 + (size_t)(j) * 64 * LORA), (LAS unsigned*)(kd + wave * 1024), 16, 0, 0); \
        __builtin_amdgcn_global_load_lds((const unsigned*)(kc0 + (size_t)(j) * 64 * LORA + 64), (LAS unsigned*)(kd + (wave + 8) * 1024), 16, 0, 0); \
        if (wave < 4) __builtin_amdgcn_global_load_lds((const unsigned*)(kr0 + (size_t)(j) * 64 * ROPE), (LAS unsigned*)(kd + (16 + wave) * 1024), 16, 0, 0); \
        __builtin_amdgcn_global_load_lds((const unsigned*)(vs0 + (size_t)(j) * 64 * LORA), (LAS unsigned*)(vd + wave * 1024), 16, 0, 0); \
        __builtin_amdgcn_global_load_lds((const unsigned*)(vs0 + (size_t)(j) * 64 * LORA + 64), (LAS unsigned*)(vd + (wave + 8) * 1024), 16, 0, 0); } while (0)
    MLA_DMA(0, 0);
    bf16x8 qr[10]; { const bf16* qp = QLAT + (size_t)(qrow + r32) * QLW + h * 128 + hi * 8; const bf16* rp = QROPE + (size_t)(qrow + r32) * QRW + h * 32 + hi * 8;
#pragma unroll
        for (int d0 = 0; d0 < 8; ++d0) qr[d0] = *(const bf16x8*)(qp + d0 * 16);
        qr[8] = *(const bf16x8*)rp; qr[9] = *(const bf16x8*)(rp + 16); }
    f32x16 o[4]; o[0] = f32x16{}; o[1] = f32x16{}; o[2] = f32x16{}; o[3] = f32x16{};
    float m = -INFINITY, l = 0.f; LAS float* wsf = (LAS float*)(lds + MLA_WS) + wave * 64;
    ATT_WAITBAR();
    for (int jt = 0; jt < NT; ++jt) { const int cur = jt & 1;
        if (jt + 1 < NT) MLA_DMA(jt + 1, cur ^ 1);
        LAS unsigned char* Kb = lds + MLA_K + cur * 20480 + hi * 1024 + r32 * 16;
        f32x16 p0 = {}, p1 = {};
#pragma unroll
        for (int d0 = 0; d0 < 10; ++d0) { const bf16x8 b0 = *(LAS bf16x8*)(Kb + d0 * 2048), b1 = *(LAS bf16x8*)(Kb + d0 * 2048 + 512);
            p0 = __builtin_amdgcn_mfma_f32_32x32x16_bf16(b0, qr[d0], p0, 0, 0, 0); p1 = __builtin_amdgcn_mfma_f32_32x32x16_bf16(b1, qr[d0], p1, 0, 0, 0); }
        float mx = fmaxf(p0[0], p1[0]);
#pragma unroll
        for (int r = 1; r < 16; ++r) mx = fmaxf(mx, fmaxf(p0[r], p1[r]));
        { const auto sw = __builtin_amdgcn_permlane32_swap(__float_as_uint(mx), __float_as_uint(mx), false, false); mx = fmaxf(__uint_as_float(sw[0]), __uint_as_float(sw[1])); }
        const float mn = fmaxf(m, mx), al = fexp2(m - mn); m = mn;
        float ps = 0.f;
#pragma unroll
        for (int r = 0; r < 16; ++r) { p0[r] = fexp2(p0[r] - mn); p1[r] = fexp2(p1[r] - mn); ps += p0[r] + p1[r]; }
        l = l * al + ps;
        if (__any(al != 1.0f)) {
            if (hi == 0) wsf[r32] = al;
            asm volatile("s_waitcnt lgkmcnt(0)" ::: "memory");
#pragma unroll
            for (int r = 0; r < 16; ++r) { const float f = wsf[crow(r, hi)]; o[0][r] *= f; o[1][r] *= f; o[2][r] *= f; o[3][r] *= f; }
        }
        const bf16x8 pa0 = pk8(p0, 0), pa1 = pk8(p0, 8), pa2 = pk8(p1, 0), pa3 = pk8(p1, 8);
        LAS unsigned char* vb = lds + MLA_V + cur * 16384 + ((lane >> 4) & 1) * 32 + (lane & 3) * 8 + (4 * hi + ((lane & 15) >> 2)) * 64;
#pragma unroll
        for (int ks = 0; ks < 4; ++ks) { const bf16x8 pa = ks == 0 ? pa0 : ks == 1 ? pa1 : ks == 2 ? pa2 : pa3;
#pragma unroll
            for (int d0 = 0; d0 < 4; ++d0) { const bf16x8 vf = cat8(vtr(vb + d0 * 4096 + ks * 1024), vtr(vb + d0 * 4096 + ks * 1024 + 512)); o[d0] = __builtin_amdgcn_mfma_f32_32x32x16_bf16(pa, vf, o[d0], 0, 0, 0); } }
        ATT_WAITBAR();
    }
#undef MLA_DMA
    { const auto sw = __builtin_amdgcn_permlane32_swap(__float_as_uint(l), __float_as_uint(l), false, false); l = __uint_as_float(sw[0]) + __uint_as_float(sw[1]); }
    if (hi == 0) wsf[r32] = 1.0f / l;
    asm volatile("s_waitcnt lgkmcnt(0)" ::: "memory");
    { LAS unsigned short* stg = (LAS unsigned short*)(lds + MLA_ST + wave * 8192);
#pragma unroll
        for (int r = 0; r < 16; ++r) { const int orow = crow(r, hi); const float f = wsf[orow];
#pragma unroll
            for (int d0 = 0; d0 < 4; ++d0) stg[orow * 128 + d0 * 32 + r32] = (unsigned short)f2bf(o[d0][r] * f); }
        asm volatile("s_waitcnt lgkmcnt(0)" ::: "memory");
        bf16* op = OLAT + (size_t)qrow * QLW + h * 128;
#pragma unroll
        for (int i = 0; i < 8; ++i) { const int row = i * 4 + (lane >> 4), ch = lane & 15; const v4u v = *(LAS v4u*)(stg + row * 128 + ch * 8); *(v4u*)(op + (size_t)row * QLW + ch * 8) = v; }
    }
    ATT_WAITBAR();
}
__device__ __forceinline__ void mla_prompt(CArgs a, LAS unsigned char* lds, int vcu, int G, int wave, int lane) {
    const bf16* QLAT = (const bf16*)(a->ws + WS_QLAT); const bf16* QROPE = (const bf16*)(a->ws + WS_QROPE); const bf16* CKVB = (const bf16*)(a->ws + WS_CKVB); const bf16* KRB = (const bf16*)(a->ws + WS_KRB); bf16* OLAT = (bf16*)(a->ws + WS_OLAT);
    for (int u = vcu; u < NB * 64; u += G) { const int i = u >> 8, v = u & 255, b = v >> 4, s = v & 15; const int qb32 = i == 0 ? s : i == 1 ? 63 - s : i == 2 ? 16 + s : 47 - s;
        mla_unit(QLAT, QROPE, CKVB, KRB, OLAT, b * SEQ, qb32, lds, wave, lane); }
}


#ifndef SB_EARLY
#define SB_EARLY 1
#endif
constexpr float SB_TINY = 7.8886090522101181e-31f;
constexpr int SSB_V = 0, SSB_T = 65536, SSB_F = 65536 + 2048;
__device__ __forceinline__ bf16x8 cvt8(f32x4 a, f32x4 b) { return __builtin_bit_cast(bf16x8, pack8c(a, b)); }
__device__ __forceinline__ void ssb_unit(CArgs a, int L, int b, int h, LAS unsigned char* lds, int wave, int lane) {
    const int r32 = lane & 31, hi = lane >> 5; const int rowbase = PR + b * DSEQ;
    const bf16* QSB = (const bf16*)(a->ws + WS_QSB); const bf16* KSB = (const bf16*)(a->ws + WS_KSB); const bf16* VSB = (const bf16*)(a->ws + WS_VSB); bf16* OSB = (bf16*)(a->ws + WS_OSB);
    const float* ck = a->in[4] + ((((size_t)L * DBATCH + b) * PAST) * NHEAD + h) * 64; const float* cv = a->in[5] + ((((size_t)L * DBATCH + b) * PAST) * NHEAD + h) * 64;
    bf16x8 qr[4]; { const bf16* qp = QSB + (size_t)(rowbase + r32) * SBW + h * 64 + hi * 8;
#pragma unroll
        for (int d0 = 0; d0 < 4; ++d0) qr[d0] = *(const bf16x8*)(qp + d0 * 16); }
    f32x16 o0 = {}, o1 = {}; float cacc = 1.0f;
    LAS unsigned char* vreg = lds + SSB_V + wave * 8192; LAS float* Tx = (LAS float*)(lds + SSB_T);
    for (int rd = 0; rd < 9; ++rd) { const int ut = 57 - 8 * rd + wave;
        f32x16 w0 = {}, w1 = {}; float T = 1.0f;
        if (ut >= 0) {
            bf16x8 kf[8];
            if (ut == 64) {
#pragma unroll
                for (int d0 = 0; d0 < 4; ++d0) { kf[2 * d0] = *(const bf16x8*)(KSB + (size_t)(rowbase + r32) * SBW + h * 64 + d0 * 16 + hi * 8); kf[2 * d0 + 1] = (bf16x8){0, 0, 0, 0, 0, 0, 0, 0}; }
                const v4u z4 = {0u, 0u, 0u, 0u};
#pragma unroll
                for (int pc = 0; pc < 8; ++pc) { v4u x = z4; if (lane < 32) x = *(const v4u*)(VSB + (size_t)(rowbase + lane) * SBW + h * 64 + pc * 8);
                    *(LAS v4u*)(vreg + (pc >> 2) * 4096 + lane * 64 + (pc & 3) * 16) = x; }
            } else {
                const float* kp = ck + (size_t)(64 * ut + r32) * SBW + hi * 8; const float* vp = cv + (size_t)(64 * ut + lane) * SBW;
                f32x4 kx[16], vx[16];
#pragma unroll
                for (int d0 = 0; d0 < 4; ++d0) { kx[4 * d0] = *(const f32x4*)(kp + d0 * 16); kx[4 * d0 + 1] = *(const f32x4*)(kp + d0 * 16 + 4);
                    kx[4 * d0 + 2] = *(const f32x4*)(kp + (size_t)32 * SBW + d0 * 16); kx[4 * d0 + 3] = *(const f32x4*)(kp + (size_t)32 * SBW + d0 * 16 + 4); }
#pragma unroll
                for (int i = 0; i < 16; ++i) vx[i] = *(const f32x4*)(vp + 4 * i);
#pragma unroll
                for (int d0 = 0; d0 < 4; ++d0) { kf[2 * d0] = cvt8(kx[4 * d0], kx[4 * d0 + 1]); kf[2 * d0 + 1] = cvt8(kx[4 * d0 + 2], kx[4 * d0 + 3]); }
#pragma unroll
                for (int pc = 0; pc < 8; ++pc) *(LAS v4u*)(vreg + (pc >> 2) * 4096 + lane * 64 + (pc & 3) * 16) = pack8c(vx[2 * pc], vx[2 * pc + 1]);
            }
            f32x16 p0 = {}, p1 = {};
#pragma unroll
            for (int d0 = 0; d0 < 4; ++d0) { p0 = __builtin_amdgcn_mfma_f32_32x32x16_bf16(kf[2 * d0], qr[d0], p0, 0, 0, 0); p1 = __builtin_amdgcn_mfma_f32_32x32x16_bf16(kf[2 * d0 + 1], qr[d0], p1, 0, 0, 0); }
            if (ut == 64) {
#pragma unroll
                for (int r = 0; r < 16; ++r) { const int kv = 4 * hi + (r & 3) + 8 * (r >> 2); if (kv >= r32) p0[r] = -INFINITY; p1[r] = -INFINITY; }
            }
#pragma unroll
            for (int r = 0; r < 16; ++r) { p0[r] = frcp(1.0f + fexp2(p0[r])); p1[r] = frcp(1.0f + fexp2(p1[r])); }
            float GA[8];
#pragma unroll
            for (int k = 0; k < 4; ++k) { GA[k] = (p0[4 * k] * p0[4 * k + 1]) * (p0[4 * k + 2] * p0[4 * k + 3]); GA[4 + k] = (p1[4 * k] * p1[4 * k + 1]) * (p1[4 * k + 2] * p1[4 * k + 3]); }
            float SG[8];
#pragma unroll
            for (int kk = 7; kk >= 0; --kk) { const auto sw = __builtin_amdgcn_permlane32_swap(__float_as_uint(GA[kk]), __float_as_uint(GA[kk]), false, false);
                const float G0 = __uint_as_float(sw[0]), G1 = __uint_as_float(sw[1]); const float s1 = T; T *= G1; const float s0 = T; T *= G0; SG[kk] = hi ? s1 : s0; }
#pragma unroll
            for (int k = 0; k < 4; ++k) {
                { float t = SG[k]; w0[4 * k + 3] = t * (1.0f - p0[4 * k + 3]); t *= p0[4 * k + 3]; w0[4 * k + 2] = t * (1.0f - p0[4 * k + 2]); t *= p0[4 * k + 2];
                  w0[4 * k + 1] = t * (1.0f - p0[4 * k + 1]); t *= p0[4 * k + 1]; w0[4 * k] = t * (1.0f - p0[4 * k]); }
                { float t = SG[4 + k]; w1[4 * k + 3] = t * (1.0f - p1[4 * k + 3]); t *= p1[4 * k + 3]; w1[4 * k + 2] = t * (1.0f - p1[4 * k + 2]); t *= p1[4 * k + 2];
                  w1[4 * k + 1] = t * (1.0f - p1[4 * k + 1]); t *= p1[4 * k + 1]; w1[4 * k] = t * (1.0f - p1[4 * k]); } }
        }
        LAS float* Tr = Tx + (rd & 1) * 256;
        if (hi == 0) Tr[wave * 32 + r32] = T;
        asm volatile("s_waitcnt lgkmcnt(0)" ::: "memory"); __builtin_amdgcn_s_barrier(); asm volatile("" ::: "memory");
        float F = cacc, all = cacc;
#pragma unroll
        for (int w2 = 7; w2 >= 0; --w2) { const float tv = Tr[w2 * 32 + r32]; all *= tv; if (w2 > wave) F *= tv; }
        cacc = all;
        if (ut >= 0) {
#pragma unroll
            for (int r = 0; r < 16; ++r) { w0[r] *= F; w1[r] *= F; }
            const bf16x8 pa0 = pk8(w0, 0), pa1 = pk8(w0, 8), pa2 = pk8(w1, 0), pa3 = pk8(w1, 8);
            LAS unsigned char* vb = vreg + ((lane >> 4) & 1) * 32 + (lane & 3) * 8 + (4 * hi + ((lane & 15) >> 2)) * 64;
#pragma unroll
            for (int ks = 0; ks < 4; ++ks) { const bf16x8 pa = ks == 0 ? pa0 : ks == 1 ? pa1 : ks == 2 ? pa2 : pa3;
                const bf16x8 v0 = cat8(vtr(vb + ks * 1024), vtr(vb + ks * 1024 + 512)), v1 = cat8(vtr(vb + 4096 + ks * 1024), vtr(vb + 4096 + ks * 1024 + 512));
                o0 = __builtin_amdgcn_mfma_f32_32x32x16_bf16(pa, v0, o0, 0, 0, 0); o1 = __builtin_amdgcn_mfma_f32_32x32x16_bf16(pa, v1, o1, 0, 0, 0); }
            asm volatile("s_waitcnt lgkmcnt(0)" ::: "memory");
        }
#if SB_EARLY
        if (__all(cacc < SB_TINY)) break;
#endif
    }
    __builtin_amdgcn_s_barrier(); asm volatile("" ::: "memory");
    { LAS float* po = (LAS float*)(lds + SSB_V + wave * 8192);
#pragma unroll
        for (int r = 0; r < 16; ++r) { const int q = crow(r, hi); po[q * 64 + r32] = o0[r]; po[q * 64 + 32 + r32] = o1[r]; } }
    asm volatile("s_waitcnt lgkmcnt(0)" ::: "memory"); __builtin_amdgcn_s_barrier(); asm volatile("" ::: "memory");
    { const int t = wave * 64 + lane, q = t >> 4, d4 = (t & 15) * 4; f32x4 s = {0.f, 0.f, 0.f, 0.f};
#pragma unroll
        for (int w2 = 0; w2 < 8; ++w2) s += *(LAS f32x4*)(lds + SSB_V + w2 * 8192 + (q * 64 + d4) * 4);
        unsigned long long pk = (unsigned long long)pg8::cvt_pk_bf16_c(s[0], s[1]) | ((unsigned long long)pg8::cvt_pk_bf16_c(s[2], s[3]) << 32);
        *(unsigned long long*)(OSB + (size_t)(rowbase + q) * SBW + h * 64 + d4) = pk; }
    asm volatile("s_waitcnt lgkmcnt(0)" ::: "memory"); __builtin_amdgcn_s_barrier(); asm volatile("" ::: "memory");
}
__device__ __forceinline__ void sb_sample(CArgs a, int L, LAS unsigned char* lds, int vcu, int G, int wave, int lane) {
    for (int u = vcu; u < DBATCH * NHEAD; u += G) ssb_unit(a, L, u >> 3, u & 7, lds, wave, lane);
}


constexpr size_t WS_PO = 1546 * MiB, WS_PML = 1580 * MiB, WS_END2 = 1581 * MiB;
static_assert(WS_PO >= WS_END && WS_PO + (size_t)DBATCH * 8 * NHEAD * DSEQ * LORA * 4 <= WS_PML && WS_PML + (size_t)DBATCH * 8 * NHEAD * DSEQ * 2 * 4 <= WS_END2, "partials map");
__device__ __forceinline__ void smla_unit(CArgs a, int L, int b, int sp, LAS unsigned char* lds, int wave, int lane) {
    const int r32 = lane & 31, hi = lane >> 5, h = wave; const int NT = sp == 7 ? 9 : 8; const int qrow = PR + b * DSEQ;
    const bf16* QLAT = (const bf16*)(a->ws + WS_QLAT); const bf16* QROPE = (const bf16*)(a->ws + WS_QROPE); const bf16* CKVB = (const bf16*)(a->ws + WS_CKVB); const bf16* KRB = (const bf16*)(a->ws + WS_KRB);
    const float* cc = a->in[6] + ((size_t)L * DBATCH + b) * PAST * LORA + (size_t)sp * 512 * LORA; const float* cr = a->in[7] + ((size_t)L * DBATCH + b) * PAST * ROPE + (size_t)sp * 512 * ROPE;
    f32x4 st[6]; v4u sb3[3];
#define SM_LOAD(j) do { if ((j) < 8) { const float* p = cc + (size_t)((j) * 64 + lane) * LORA + wave * 8; st[0] = *(const f32x4*)p; st[1] = *(const f32x4*)(p + 4); st[2] = *(const f32x4*)(p + 64); st[3] = *(const f32x4*)(p + 68); \
            if (wave < 4) { const float* q = cr + (size_t)((j) * 64 + lane) * ROPE + 4 * wave; st[4] = *(const f32x4*)q; st[5] = *(const f32x4*)(q + 16); } } \
        else { sb3[0] = sb3[1] = sb3[2] = (v4u){0u, 0u, 0u, 0u}; if (lane < 32) { const bf16* p = CKVB + (size_t)(qrow + lane) * LORA + wave * 8; sb3[0] = *(const v4u*)p; sb3[1] = *(const v4u*)(p + 64); \
            if (wave < 4) sb3[2] = *(const v4u*)(KRB + (size_t)(qrow + lane) * ROPE + wave * 8); } } } while (0)
#define SM_STORE(j, bsel) do { LAS unsigned char* kd = lds + MLA_K + (bsel) * 20480; LAS unsigned char* vd = lds + MLA_V + (bsel) * 16384; v4u x0, x1, x2; \
        if ((j) < 8) { x0 = pack8c(st[0], st[1]); x1 = pack8c(st[2], st[3]); x2 = pack8c(st[4], st[5]); } else { x0 = sb3[0]; x1 = sb3[1]; x2 = sb3[2]; } \
        *(LAS v4u*)(kd + wave * 1024 + lane * 16) = x0; *(LAS v4u*)(kd + (wave + 8) * 1024 + lane * 16) = x1; if (wave < 4) *(LAS v4u*)(kd + (16 + wave) * 1024 + lane * 16) = x2; \
        *(LAS v4u*)(vd + (wave >> 2) * 4096 + lane * 64 + (wave & 3) * 16) = x0; *(LAS v4u*)(vd + ((wave + 8) >> 2) * 4096 + lane * 64 + (wave & 3) * 16) = x1; } while (0)
    SM_LOAD(0);
    bf16x8 qr[10]; { const bf16* qp = QLAT + (size_t)(qrow + r32) * QLW + h * 128 + hi * 8; const bf16* rp = QROPE + (size_t)(qrow + r32) * QRW + h * 32 + hi * 8;
#pragma unroll
        for (int d0 = 0; d0 < 8; ++d0) qr[d0] = *(const bf16x8*)(qp + d0 * 16);
        qr[8] = *(const bf16x8*)rp; qr[9] = *(const bf16x8*)(rp + 16); }
    SM_STORE(0, 0);
    f32x16 o[4]; o[0] = f32x16{}; o[1] = f32x16{}; o[2] = f32x16{}; o[3] = f32x16{};
    float m = -INFINITY, l = 0.f; LAS float* wsf = (LAS float*)(lds + MLA_WS) + wave * 64;
    ATT_WAITBAR();
    for (int jt = 0; jt < NT; ++jt) { const int cur = jt & 1;
        if (jt + 1 < NT) SM_LOAD(jt + 1);
        LAS unsigned char* Kb = lds + MLA_K + cur * 20480 + hi * 1024 + r32 * 16;
        f32x16 p0 = {}, p1 = {};
#pragma unroll
        for (int d0 = 0; d0 < 10; ++d0) { const bf16x8 b0 = *(LAS bf16x8*)(Kb + d0 * 2048), b1 = *(LAS bf16x8*)(Kb + d0 * 2048 + 512);
            p0 = __builtin_amdgcn_mfma_f32_32x32x16_bf16(b0, qr[d0], p0, 0, 0, 0); p1 = __builtin_amdgcn_mfma_f32_32x32x16_bf16(b1, qr[d0], p1, 0, 0, 0); }
        if (jt == 8) {
#pragma unroll
            for (int r = 0; r < 16; ++r) p1[r] = -INFINITY; }
        float mx = fmaxf(p0[0], p1[0]);
#pragma unroll
        for (int r = 1; r < 16; ++r) mx = fmaxf(mx, fmaxf(p0[r], p1[r]));
        { const auto sw = __builtin_amdgcn_permlane32_swap(__float_as_uint(mx), __float_as_uint(mx), false, false); mx = fmaxf(__uint_as_float(sw[0]), __uint_as_float(sw[1])); }
        const float mn = fmaxf(m, mx), al = fexp2(m - mn); m = mn;
        float ps = 0.f;
#pragma unroll
        for (int r = 0; r < 16; ++r) { p0[r] = fexp2(p0[r] - mn); p1[r] = fexp2(p1[r] - mn); ps += p0[r] + p1[r]; }
        l = l * al + ps;
        if (__any(al != 1.0f)) {
            if (hi == 0) wsf[r32] = al;
            asm volatile("s_waitcnt lgkmcnt(0)" ::: "memory");
#pragma unroll
            for (int r = 0; r < 16; ++r) { const float f = wsf[crow(r, hi)]; o[0][r] *= f; o[1][r] *= f; o[2][r] *= f; o[3][r] *= f; }
        }
        const bf16x8 pa0 = pk8(p0, 0), pa1 = pk8(p0, 8), pa2 = pk8(p1, 0), pa3 = pk8(p1, 8);
        LAS unsigned char* vb = lds + MLA_V + cur * 16384 + ((lane >> 4) & 1) * 32 + (lane & 3) * 8 + (4 * hi + ((lane & 15) >> 2)) * 64;
#pragma unroll
        for (int ks = 0; ks < 4; ++ks) { const bf16x8 pa = ks == 0 ? pa0 : ks == 1 ? pa1 : ks == 2 ? pa2 : pa3;
#pragma unroll
            for (int d0 = 0; d0 < 4; ++d0) { const bf16x8 vf = cat8(vtr(vb + d0 * 4096 + ks * 1024), vtr(vb + d0 * 4096 + ks * 1024 + 512)); o[d0] = __builtin_amdgcn_mfma_f32_32x32x16_bf16(pa, vf, o[d0], 0, 0, 0); } }
        if (jt + 1 < NT) SM_STORE(jt + 1, cur ^ 1);
        ATT_WAITBAR();
    }
#undef SM_LOAD
#undef SM_STORE
    { const auto sw = __builtin_amdgcn_permlane32_swap(__float_as_uint(l), __float_as_uint(l), false, false); l = __uint_as_float(sw[0]) + __uint_as_float(sw[1]); }
    const size_t ub = ((size_t)(b * 8 + sp) * NHEAD + h) * DSEQ;
    float* PO = (float*)(a->ws + WS_PO) + ub * LORA; float* PML = (float*)(a->ws + WS_PML) + ub * 2;
    if (hi == 0) { PML[r32 * 2] = m; PML[r32 * 2 + 1] = l; }
#pragma unroll
    for (int r = 0; r < 16; ++r) { const int q = crow(r, hi);
#pragma unroll
        for (int d0 = 0; d0 < 4; ++d0) PO[(size_t)q * LORA + d0 * 32 + r32] = o[d0][r]; }
}
__device__ __forceinline__ void mla_sample(CArgs a, int L, LAS unsigned char* lds, int vcu, int G, int wave, int lane) {
    for (int u = vcu; u < DBATCH * 8; u += G) smla_unit(a, L, u >> 3, u & 7, lds, wave, lane);
}
__device__ __forceinline__ void smla_combine(CArgs a, int vcu, int G, int wave, int lane) {
    const int gw = vcu * 8 + wave, NGW = G * 8; bf16* OLAT = (bf16*)(a->ws + WS_OLAT); const float* PO = (const float*)(a->ws + WS_PO); const float* PML = (const float*)(a->ws + WS_PML);
    for (int it = gw; it < SR * NHEAD; it += NGW) { const int row = it >> 3, h = it & 7, b = row >> 5, q = row & 31;
        float ms[8], ls[8], M = -INFINITY;
#pragma unroll
        for (int s = 0; s < 8; ++s) { const size_t ub = (((size_t)(b * 8 + s) * NHEAD + h) * DSEQ + q); ms[s] = PML[ub * 2]; ls[s] = PML[ub * 2 + 1]; M = fmaxf(M, ms[s]); }
        float den = 0.f, o0 = 0.f, o1 = 0.f;
#pragma unroll
        for (int s = 0; s < 8; ++s) { const float w = fexp2(ms[s] - M); den += w * ls[s]; const size_t ub = (((size_t)(b * 8 + s) * NHEAD + h) * DSEQ + q);
            const float2 v = *(const float2*)(PO + ub * LORA + 2 * lane); o0 += w * v.x; o1 += w * v.y; }
        const float id = 1.0f / den;
        *(unsigned*)(OLAT + (size_t)(PR + row) * QLW + h * 128 + 2 * lane) = pg8::cvt_pk_bf16(o0 * id, o1 * id);
    }
}

__device__ __forceinline__ int lane_now() { int l; asm volatile("v_mbcnt_lo_u32_b32 %0, -1, 0\n\tv_mbcnt_hi_u32_b32 %0, -1, %0" : "=v"(l)); return l; }
__device__ __forceinline__ CArgs fresh_args() { CArgs p = (CArgs)__builtin_amdgcn_kernarg_segment_ptr(); asm volatile("" : "+s"(p)); return p; }
__global__ void __launch_bounds__(512, 2) fwd(Args args_byval) {
    extern __shared__ __attribute__((aligned(16))) unsigned char lds_raw[];
    LAS unsigned char* lds = (LAS unsigned char*)lds_raw;
    volatile LAS unsigned* MISC = (volatile LAS unsigned*)(lds + MISC_OFF);
    const int wave = __builtin_amdgcn_readfirstlane((int)threadIdx.x >> 6);
    const int G = gridDim.x; const int bx = blockIdx.x; const int vcu = (G % 8 == 0) ? (bx % 8) * (G / 8) + bx / 8 : bx;
    if (threadIdx.x < 32) MISC[threadIdx.x] = 0u;
    __syncthreads();
    XcdBarrier bar = xcd_barrier_post((unsigned*)(fresh_args()->ws + WS_CTL) + CW_BAR, MISC + 8);
    const int lo = fresh_args()->ph_lo, hi = fresh_args()->ph_hi;
#define IN(k) (lo <= (k) && (k) < hi)
#define SEAM(k) do { if (IN(k) && IN((k) + 1)) xcd_barrier(bar); } while (0)
    const int gw = vcu * 8 + wave, NGW = G * 8;

    if (IN(0)) p0_prologue(fresh_args(), lds, vcu, G, wave, lane_now());
    SEAM(0);
    if (IN(1)) {
#pragma unroll 1
        for (int L = 0; L < DEPTH; ++L) { unsigned char* ws = fresh_args()->ws;
            pg8::Gemm g{(const bf16*)(ws + WS_PB) + (size_t)L * R * DPLE, (const bf16*)(ws + WS_W + (size_t)L * WL + W_PP), R, DM, DPLE}; Ord<DM / 256> S; S.init(G, bx);
            EpiBf E{(bf16*)(ws + WS_PP) + (size_t)L * R * DM, DM, nullptr, nullptr};
            pg8::gemm_phase<EpiBf, decltype(S), true, true>(lds, g, S, E, wave); }
    }
    SEAM(1);
#pragma unroll 1
    for (int L = 0; L < DEPTH; ++L) {
        const int pb = 2 + 12 * L;
        if (IN(pb + 0)) {
            CArgs a = fresh_args(); unsigned char* ws = a->ws;
            pg8::Gemm g{(const bf16*)(ws + WS_XN), (const bf16*)(ws + WS_W + (size_t)L * WL + W_IN), R, NIN, DM}; Ord<NIN / 256> S; S.init(G, bx);
            EpiIn E{ws, a->out, L, a->in[10] + (size_t)L * LORA, (LAS float*)(lds + XL_OFF)};
            pg8::gemm_phase<EpiIn, decltype(S), true, true>(lds, g, S, E, wave);
        }
        SEAM(pb + 0);
        if (IN(pb + 1)) {
#if FAST_SB
            sb_prompt(fresh_args(), lds, vcu, G, wave, lane_now());
#endif
#if FAST_MLA
            mla_prompt(fresh_args(), lds, vcu, G, wave, lane_now());
#endif
#if FAST_SSB
            sb_sample(fresh_args(), L, lds, vcu, G, wave, lane_now());
#endif
#if FAST_SMLA
            mla_sample(fresh_args(), L, lds, vcu, G, wave, lane_now());
#endif
#if !(FAST_SB && FAST_SSB)
            naive_sb(fresh_args(), L, vcu, G, wave, lane_now());
#endif
#if !(FAST_MLA && FAST_SMLA)
            naive_mla(fresh_args(), L, vcu, G, wave, lane_now());
#endif
        }
        SEAM(pb + 1);
        if (IN(pb + 2)) {
#if FAST_SMLA
            smla_combine(fresh_args(), vcu, G, wave, lane_now());
#endif
            unsigned char* ws = fresh_args()->ws;
            pg8::Gemm g{(const bf16*)(ws + WS_OSB), (const bf16*)(ws + WS_W + (size_t)L * WL + W_SB), R, DM, SBW}; Ord<DM / 256> S; S.init(G, bx);
            EpiGate<false> E{(const bf16*)(ws + WS_GA), (bf16*)(ws + WS_MG)};
            pg8::gemm_phase<EpiGate<false>, decltype(S), true, true>(lds, g, S, E, wave);
        }
        SEAM(pb + 2);
        if (IN(pb + 3)) {
            unsigned char* ws = fresh_args()->ws;
            pg8::Gemm g{(const bf16*)(ws + WS_OLAT), (const bf16*)(ws + WS_W + (size_t)L * WL + W_YB), R, DM, QLW}; Ord<DM / 256> S; S.init(G, bx);
            EpiGate<true> E{(const bf16*)(ws + WS_GB), (bf16*)(ws + WS_MG)};
            pg8::gemm_phase<EpiGate<true>, decltype(S), true, true>(lds, g, S, E, wave);
        }
        SEAM(pb + 3);
        if (IN(pb + 4)) {
            unsigned char* ws = fresh_args()->ws;
            pg8::Gemm g{(const bf16*)(ws + WS_MG), (const bf16*)(ws + WS_W + (size_t)L * WL + W_OUT), R, DM, DM}; Ord<DM / 256> S; S.init(G, bx);
            EpiF32 E{(float*)(ws + WS_MIX), DM};
            pg8::gemm_phase<EpiF32, decltype(S), true, true>(lds, g, S, E, wave);
        }
        SEAM(pb + 4);
        if (IN(pb + 5)) {
            CArgs a = fresh_args(); float* X = a->out + O_Y; const float* MIX = (const float*)(a->ws + WS_MIX); bf16* XN = (bf16*)(a->ws + WS_XN);
            const float* g1 = a->in[17] + (size_t)L * DM; const float* g2 = a->in[18] + (size_t)L * DM;
            const int lane = lane_now();
            for (int m = gw; m < R; m += NGW) row_op(lane, X + (size_t)m * DM, MIX + (size_t)m * DM, g1, X + (size_t)m * DM, XN + (size_t)m * DM, g2);
        }
        SEAM(pb + 5);
        if (IN(pb + 6)) {
            CArgs a = fresh_args(); unsigned char* ws = a->ws;
            pg8::Gemm g{(const bf16*)(ws + WS_XN), (const bf16*)(ws + WS_W + (size_t)L * WL + W_UP), R, UPW, DM}; Ord<UPW / 256> S; S.init(G, bx);
            EpiBf E{(bf16*)(ws + WS_U), UPW, a->out + O_CONV_P + (size_t)L * NB * 2 * UPW, a->out + O_CONV_S + (size_t)L * DBATCH * 2 * UPW};
            pg8::gemm_phase<EpiBf, decltype(S), true, true>(lds, g, S, E, wave);
        }
        SEAM(pb + 6);
#ifndef NO_CONV
        if (IN(pb + 7)) conv_phase(fresh_args(), L, vcu, G, wave, lane_now());
#endif
        SEAM(pb + 7);
        if (IN(pb + 8)) {
            unsigned char* ws = fresh_args()->ws;
            pg8::Gemm g{(const bf16*)(ws + WS_ACT), (const bf16*)(ws + WS_W + (size_t)L * WL + W_DOWN), R, DM, DFF}; Ord<DM / 256> S; S.init(G, bx);
            EpiF32 E{(float*)(ws + WS_MIX), DM};
            pg8::gemm_phase<EpiF32, decltype(S), true, true>(lds, g, S, E, wave);
        }
        SEAM(pb + 8);
        if (IN(pb + 9)) {
            CArgs a = fresh_args(); float* X = a->out + O_Y; const float* MIX = (const float*)(a->ws + WS_MIX); bf16* XB = (bf16*)(a->ws + WS_XB);
            const float* g1 = a->in[19] + (size_t)L * DM;
            const int lane = lane_now();
            for (int m = gw; m < R; m += NGW) row_op(lane, X + (size_t)m * DM, MIX + (size_t)m * DM, g1, X + (size_t)m * DM, XB + (size_t)m * DM, nullptr);
        }
        SEAM(pb + 9);
        if (IN(pb + 10)) {
            CArgs a = fresh_args(); unsigned char* ws = a->ws;
            pg8::Gemm g{(const bf16*)(ws + WS_XB), (const bf16*)(ws + WS_W + (size_t)L * WL + W_PG), R, DM, DM}; Ord<DM / 256> S; S.init(G, bx);
            EpiPle E{a->out + O_Y, (const bf16*)(ws + WS_PP) + (size_t)L * R * DM};
            pg8::gemm_phase<EpiPle, decltype(S), true, true>(lds, g, S, E, wave);
        }
        SEAM(pb + 10);
        if (IN(pb + 11) && L + 1 < DEPTH) {
            CArgs a = fresh_args(); const float* X = a->out + O_Y; bf16* XN = (bf16*)(a->ws + WS_XN); const float* g2 = a->in[16] + (size_t)(L + 1) * DM;
            const int lane = lane_now();
            for (int m = gw; m < R; m += NGW) row_op(lane, X + (size_t)m * DM, nullptr, nullptr, nullptr, XN + (size_t)m * DM, g2);
        }
        SEAM(pb + 11);
    }

#ifdef MK_DUMP
    {
        __syncthreads(); const int lane = lane_now(); unsigned char* ws = fresh_args()->ws; float* X = fresh_args()->out + O_Y;
        if (fresh_args()->ph_lo == NPHASE)
        for (int m = gw; m < R; m += NGW) for (int j = 0; j < 16; ++j) { const int c = j * 64 + lane; float v = 0.f;
            if (MK_DUMP & 1) v += bf2f(((const bf16*)(ws + WS_OSB))[(size_t)m * SBW + (c & 511)]);
            if (MK_DUMP & 2) v += bf2f(((const bf16*)(ws + WS_OLAT))[(size_t)m * QLW + c]);
            if (MK_DUMP & 4) v += bf2f(((const bf16*)(ws + WS_GA))[(size_t)m * DM + c]) + bf2f(((const bf16*)(ws + WS_GB))[(size_t)m * DM + c]);
            if (MK_DUMP & 8) v += bf2f(((const bf16*)(ws + WS_QLAT))[(size_t)m * QLW + c]) + bf2f(((const bf16*)(ws + WS_QSB))[(size_t)m * SBW + (c & 511)]) + bf2f(((const bf16*)(ws + WS_QROPE))[(size_t)m * QRW + (c & 255)]);
            if (MK_DUMP & 16) v += bf2f(((const bf16*)(ws + WS_PP))[(size_t)m * DM + c]) + bf2f(((const bf16*)(ws + WS_PP))[((size_t)R + m) * DM + c]);
            if (MK_DUMP & 32) v += bf2f(((const bf16*)(ws + WS_MG))[(size_t)m * DM + c]);
            if (MK_DUMP & 64) v += ((const float*)(ws + WS_MIX))[(size_t)m * DM + c];
            X[(size_t)m * DM + c] = v; }
    }
#endif
#undef IN
#undef SEAM
}

extern "C" void kernel_launch(void* const* d_in, const int* in_sizes, int n_in, void* d_out, int out_size, void* d_ws, size_t ws_size, hipStream_t stream) {
    static int grid = 0;
    if (grid == 0) {
        if (n_in != 26 || (size_t)out_size != O_END || ws_size < WS_END2) { fprintf(stderr, "kernel_launch: unexpected shapes (n_in %d, out %d, ws %zu); nothing launched\n", n_in, out_size, ws_size); grid = -1; return; }
        int dev = 0, cus = 0, per_cu = 0;
        if (hipGetDevice(&dev) != hipSuccess || hipDeviceGetAttribute(&cus, hipDeviceAttributeMultiprocessorCount, dev) != hipSuccess) { grid = -1; return; }
        if (hipFuncSetAttribute((const void*)fwd, hipFuncAttributeMaxDynamicSharedMemorySize, LDS_BYTES) != hipSuccess) { fprintf(stderr, "kernel_launch: hipFuncSetAttribute failed\n"); grid = -1; return; }
        if (hipOccupancyMaxActiveBlocksPerMultiprocessor(&per_cu, (const void*)fwd, 512, LDS_BYTES) != hipSuccess || per_cu < 1) fprintf(stderr, "kernel_launch: occupancy query reports %d\n", per_cu);
        (void)hipGetLastError();
        grid = cus;
    }
    if (grid < 0) return;
    if (hipMemsetAsync((char*)d_ws + WS_CTL, 0, CTL_ZERO_BYTES, stream) != hipSuccess) return;
    Args a{};
    for (int i = 0; i < 26; ++i) a.in[i] = (const float*)d_in[i];
    a.out = (float*)d_out; a.ws = (unsigned char*)d_ws;
#if MK_PER_PHASE
    for (int ph = 0; ph < NPHASE; ++ph) { a.ph_lo = ph; a.ph_hi = ph + 1; hipLaunchKernelGGL(fwd, dim3(grid), dim3(512), LDS_BYTES, stream, a); }
#ifdef MK_DUMP
    a.ph_lo = NPHASE; a.ph_hi = NPHASE + 1; hipLaunchKernelGGL(fwd, dim3(grid), dim3(512), LDS_BYTES, stream, a);
#endif
#else
    a.ph_lo = 0; a.ph_hi = NPHASE; hipLaunchKernelGGL(fwd, dim3(grid), dim3(512), LDS_BYTES, stream, a);
#endif
}
```

```cpp
#include <hip/hip_runtime.h>
#include <cstdio>
#include <cstdint>
#include <cmath>
#define MK_PER_PHASE 0
namespace pg8 {
#define PG8_LAS __attribute__((address_space(3)))
typedef unsigned short bf16_t;
typedef short bf16x8 __attribute__((ext_vector_type(8)));
typedef float f32x4 __attribute__((ext_vector_type(4)));
typedef unsigned u32x4 __attribute__((ext_vector_type(4)));
constexpr int BM = 256, BK = 64, HALF = 128, HTB = HALF * BK * 2  , STAGE_BYTES = 8 * HTB, NXCD = 8, WGM = 8;

__host__ __device__ __forceinline__ int lds_byte(int r, int c) { const int st = (r >> 4) * 2 + (c >> 5), rr = r & 15, cc = c & 31, ob = rr * 64 + cc * 2; return st * 1024 + (ob ^ (((ob >> 9) & 1) << 5)); }
__host__ __device__ __forceinline__ void stage_rc(int b, int& R, int& C) { const int st = b / 1024, sb = b % 1024, swz = sb ^ (((sb >> 9) & 1) << 5); R = (st >> 1) * 16 + swz / 64; C = (st & 1) * 32 + (swz % 64) / 2; }
__host__ __device__ __forceinline__ int perm32(int rho) { const int n = rho >> 4, i = rho & 15; return 8 * (i >> 2) + 4 * n + (i & 3); }

struct Unit { int pm, pn, pk; };
struct Gemm { const bf16_t* A; const bf16_t* Bt; int M, N, K, ld; };

struct StaticOrder {
    int nM, nN, nwg, G, c;
    __host__ __device__ void init(int M, int N, int G_, int c_) { nM = M / BM; nN = N / BM; nwg = nM * nN; G = G_; c = c_; }
    __host__ __device__ bool next(int i, Unit& u) const {
        const long L = (long)i * G + c; if (L >= nwg) return false;
        int wgid = (int)L; { const int q = nwg / NXCD, r = nwg % NXCD, xcd = wgid % NXCD, off = wgid / NXCD; wgid = (xcd < r ? xcd * (q + 1) : r * (q + 1) + (xcd - r) * q) + off; }
        const int nig = WGM * nN, gid = wgid / nig, fm = gid * WGM, gsz = (nM - fm) < WGM ? (nM - fm) : WGM;
        u.pm = fm + ((wgid % nig) % gsz); u.pn = (wgid % nig) / gsz; return true;
    }
    __device__ __forceinline__ void a_ready(const Unit&) const {}
    __device__ __forceinline__ void done(const Unit&) const {}
};

typedef float f32x2_cv __attribute__((ext_vector_type(2))); typedef __bf16 bf16x2_cv __attribute__((ext_vector_type(2)));
__device__ __forceinline__ unsigned cvt_pk_bf16(float lo, float hi) { unsigned r; asm volatile("v_cvt_pk_bf16_f32 %0, %1, %2" : "=v"(r) : "v"(lo), "v"(hi)); return r; }
__device__ __forceinline__ unsigned cvt_pk_bf16_c(float lo, float hi) { f32x2_cv v = {lo, hi}; bf16x2_cv b = __builtin_convertvector(v, bf16x2_cv); return __builtin_bit_cast(unsigned, b); }
typedef float f32x2 __attribute__((ext_vector_type(2)));
template <class Epi, class Sched, bool ALIGN_EPI = false, bool SP2 = false>
__device__ __forceinline__ void gemm_phase(PG8_LAS unsigned char* lds, const Gemm g, const Sched& S, const Epi& E, const int wave_id) {
    int tid_; asm volatile("v_mbcnt_lo_u32_b32 %0, -1, 0\n\tv_mbcnt_hi_u32_b32 %0, -1, %0" : "=v"(tid_)); tid_ += wave_id * 64;
    const int tid = tid_, wid = __builtin_amdgcn_readfirstlane(tid >> 6), lane = tid & 63, wr = wid >> 2, wc = wid & 3, fr = lane & 15, fq = lane >> 4;
    const int K = g.K, nt = K / BK, LD = g.ld;
    unsigned voffA[2], voffB[2];
#pragma unroll
    for (int i = 0; i < 2; ++i) { int R, C; stage_rc(tid * 16 + i * 8192, R, C); const int Rb = Epi::PERM ? ((R & ~31) + perm32(R & 31)) : R;
        voffA[i] = (unsigned)(R * LD + C) * 2u; voffB[i] = (unsigned)(Rb * LD + C) * 2u; }
    const size_t kstep = (size_t)(BK * 2);
    const size_t hstep = (size_t)HALF * LD * 2;
    const size_t tstep = 2 * hstep;
    const unsigned ldsw = (unsigned)wid * 1024u;
    const int aoff = lds_byte(wr * 64 + fr, fq * 8), boff = lds_byte(wc * 32 + fr, fq * 8);
#define PG8_SA(b, h) (((b) * 2 + (h)) * HTB)
#define PG8_SB(b, h) ((4 + (b) * 2 + (h)) * HTB)
#define PG8_STAGE(bufoff, gbase, voff) do { _Pragma("unroll") for (int _i = 0; _i < 2; ++_i) \
        __builtin_amdgcn_global_load_lds((const unsigned*)((const char*)(gbase) + (voff)[_i]), (PG8_LAS unsigned*)(lds + (bufoff) + ldsw + _i * 8192), 16, 0, 0); } while (0)
#define PG8_LDA(dst, b, h) do { _Pragma("unroll") for (int m = 0; m < 4; ++m) _Pragma("unroll") for (int k = 0; k < 2; ++k) dst[m][k] = *(const PG8_LAS bf16x8*)(lds + PG8_SA(b, h) + aoff + m * 2048 + k * 1024); } while (0)
#define PG8_LDB(dst, b, h) do { _Pragma("unroll") for (int n = 0; n < 2; ++n) _Pragma("unroll") for (int k = 0; k < 2; ++k) dst[n][k] = *(const PG8_LAS bf16x8*)(lds + PG8_SB(b, h) + boff + n * 2048 + k * 1024); } while (0)
#define PG8_MMA(ai, bj, At, Bt) do { __builtin_amdgcn_s_setprio(1); _Pragma("unroll") for (int m = 0; m < 4; ++m) _Pragma("unroll") for (int n = 0; n < 2; ++n) _Pragma("unroll") for (int k = 0; k < 2; ++k) \
        acc[ai][bj][m][n] = __builtin_amdgcn_mfma_f32_16x16x32_bf16(Bt[n][k], At[m][k], acc[ai][bj][m][n], 0, 0, 0); __builtin_amdgcn_s_setprio(0); } while (0)
#define PG8_WAIT_V(n) asm volatile("s_waitcnt vmcnt(" #n ")" ::: "memory")
#define PG8_WAIT_L(n) asm volatile("s_waitcnt lgkmcnt(" #n ")" ::: "memory")
#define PG8_BAR __builtin_amdgcn_s_barrier()
#define PG8_SCHED __builtin_amdgcn_sched_barrier(0)
    Unit cur, nxt; int ui = 0;
    if (!S.next(0, cur)) return;
    f32x4 acc[2][2][4][2];
#pragma unroll
    for (int a = 0; a < 2; ++a)
#pragma unroll
        for (int b = 0; b < 2; ++b)
#pragma unroll
            for (int m = 0; m < 4; ++m)
#pragma unroll
                for (int n = 0; n < 2; ++n) acc[a][b][m][n] = (f32x4){0.f, 0.f, 0.f, 0.f};
    bf16x8 At[4][2], B0[2][2], B1[2][2];
    const char* cA = (const char*)g.A + (size_t)cur.pm * tstep + (size_t)cur.pk * K * 2; const char* cB = (const char*)g.Bt + (size_t)cur.pn * tstep + (size_t)cur.pk * K * 2;
    S.a_ready(cur);
    if constexpr (SP2) {
        PG8_STAGE(PG8_SB(0, 0), cB, voffB); PG8_STAGE(PG8_SB(0, 1), cB + hstep, voffB); PG8_STAGE(PG8_SA(0, 0), cA, voffA); PG8_STAGE(PG8_SA(0, 1), cA + hstep, voffA);
        if (wr == 1) PG8_BAR;
        PG8_WAIT_V(2); PG8_BAR;
        PG8_STAGE(PG8_SB(1, 0), cB + kstep, voffB); PG8_STAGE(PG8_SA(1, 0), cA + kstep, voffA); PG8_STAGE(PG8_SB(1, 1), cB + hstep + kstep, voffB);
        PG8_WAIT_V(6); PG8_BAR;
    } else {
        PG8_STAGE(PG8_SB(0, 0), cB, voffB); PG8_STAGE(PG8_SA(0, 0), cA, voffA); PG8_STAGE(PG8_SB(0, 1), cB + hstep, voffB); PG8_STAGE(PG8_SA(0, 1), cA + hstep, voffA);
        if (wr == 1) PG8_BAR;
        PG8_WAIT_V(4); PG8_BAR;
        PG8_STAGE(PG8_SB(1, 0), cB + kstep, voffB); PG8_STAGE(PG8_SA(1, 0), cA + kstep, voffA); PG8_STAGE(PG8_SB(1, 1), cB + hstep + kstep, voffB);
        PG8_WAIT_V(6); PG8_BAR;
    }
    for (;;) {
        const bool has_next = S.next(ui + 1, nxt);
        const char* nA = has_next ? (const char*)g.A + (size_t)nxt.pm * tstep + (size_t)nxt.pk * K * 2 : cA; const char* nB = has_next ? (const char*)g.Bt + (size_t)nxt.pn * tstep + (size_t)nxt.pk * K * 2 : cB;
        for (int t = 0; t < nt; t += 2) {
            const bool last = (t == nt - 2);
            const char* a1 = cA + (size_t)(t + 1) * kstep;
            const char* a2 = last ? nA : cA + (size_t)(t + 2) * kstep; const char* b2 = last ? nB : cB + (size_t)(t + 2) * kstep;
            const char* a3 = a2 + kstep; const char* b3 = b2 + kstep;
            if (last && has_next) S.a_ready(nxt);
            if constexpr (SP2) {
            PG8_LDB(B0, 0, 0); PG8_LDB(B1, 0, 1); PG8_SCHED; PG8_LDA(At, 0, 0); PG8_STAGE(PG8_SA(1, 1), a1 + hstep, voffA);
            PG8_WAIT_V(8); PG8_WAIT_L(0); PG8_BAR; PG8_MMA(0, 0, At, B0); PG8_MMA(0, 1, At, B1); PG8_BAR; PG8_SCHED;
            PG8_LDA(At, 0, 1); PG8_STAGE(PG8_SB(0, 0), b2, voffB); PG8_STAGE(PG8_SB(0, 1), b2 + hstep, voffB); PG8_STAGE(PG8_SA(0, 0), a2, voffA);
            PG8_WAIT_V(8); PG8_WAIT_L(0); PG8_BAR; PG8_MMA(1, 0, At, B0); PG8_MMA(1, 1, At, B1); PG8_BAR; PG8_SCHED;
            PG8_LDB(B0, 1, 0); PG8_LDB(B1, 1, 1); PG8_SCHED; PG8_LDA(At, 1, 0); PG8_STAGE(PG8_SA(0, 1), a2 + hstep, voffA);
            PG8_WAIT_V(8); PG8_WAIT_L(0); PG8_BAR; PG8_MMA(0, 0, At, B0); PG8_MMA(0, 1, At, B1); PG8_BAR; PG8_SCHED;
            PG8_LDA(At, 1, 1); PG8_STAGE(PG8_SB(1, 0), b3, voffB); PG8_STAGE(PG8_SB(1, 1), b3 + hstep, voffB); PG8_STAGE(PG8_SA(1, 0), a3, voffA);
            PG8_WAIT_V(8); PG8_WAIT_L(0); PG8_BAR; PG8_MMA(1, 0, At, B0); PG8_MMA(1, 1, At, B1); PG8_BAR; PG8_SCHED;
            } else {
            PG8_LDB(B0, 0, 0); PG8_SCHED; PG8_LDA(At, 0, 0); PG8_STAGE(PG8_SA(1, 1), a1 + hstep, voffA);
            PG8_WAIT_L(8); PG8_BAR; PG8_WAIT_L(0); PG8_MMA(0, 0, At, B0); PG8_BAR; PG8_SCHED;
            PG8_LDB(B1, 0, 1); PG8_STAGE(PG8_SB(0, 0), b2, voffB);
            PG8_BAR; PG8_WAIT_L(0); PG8_MMA(0, 1, At, B1); PG8_BAR;
            PG8_LDA(At, 0, 1); PG8_STAGE(PG8_SA(0, 0), a2, voffA);
            PG8_BAR; PG8_WAIT_L(0); PG8_MMA(1, 0, At, B0); PG8_BAR; PG8_SCHED;
            PG8_STAGE(PG8_SB(0, 1), b2 + hstep, voffB);
            PG8_WAIT_V(6); PG8_BAR; PG8_MMA(1, 1, At, B1); PG8_BAR;
            PG8_LDB(B0, 1, 0); PG8_SCHED; PG8_LDA(At, 1, 0); PG8_STAGE(PG8_SA(0, 1), a2 + hstep, voffA);
            PG8_WAIT_L(8); PG8_BAR; PG8_WAIT_L(0); PG8_MMA(0, 0, At, B0); PG8_BAR; PG8_SCHED;
            PG8_LDB(B1, 1, 1); PG8_STAGE(PG8_SB(1, 0), b3, voffB);
            PG8_BAR; PG8_WAIT_L(0); PG8_MMA(0, 1, At, B1); PG8_BAR;
            PG8_LDA(At, 1, 1); PG8_STAGE(PG8_SA(1, 0), a3, voffA);
            PG8_BAR; PG8_WAIT_L(0); PG8_MMA(1, 0, At, B0); PG8_BAR; PG8_SCHED;
            PG8_STAGE(PG8_SB(1, 1), b3 + hstep, voffB);
            PG8_WAIT_V(6); PG8_BAR; PG8_MMA(1, 1, At, B1); PG8_BAR;
            }
        }
        if constexpr (ALIGN_EPI) { if (wr == 0) PG8_BAR; }
        if constexpr (!Epi::AFTER_DRAIN) { E(acc, cur, wr, wc, fr, fq); S.done(cur); }
        if (!has_next) break;
#pragma unroll
        for (int a = 0; a < 2; ++a)
#pragma unroll
            for (int b = 0; b < 2; ++b)
#pragma unroll
                for (int m = 0; m < 4; ++m)
#pragma unroll
                    for (int n = 0; n < 2; ++n) acc[a][b][m][n] = (f32x4){0.f, 0.f, 0.f, 0.f};
        cur = nxt; cA = nA; cB = nB; ++ui;
        if constexpr (ALIGN_EPI) { if (wr == 1) PG8_BAR; }
    }
    PG8_WAIT_V(0);
    if constexpr (!ALIGN_EPI) { if (wr == 0) PG8_BAR; }
    PG8_BAR;
    if constexpr (Epi::AFTER_DRAIN) { E.fused(acc, cur, wr, wc, fr, fq, lds, wid, lane); S.done(cur); }
#undef PG8_SA
#undef PG8_SB
#undef PG8_STAGE
#undef PG8_LDA
#undef PG8_LDB
#undef PG8_MMA
#undef PG8_WAIT_V
#undef PG8_WAIT_L
#undef PG8_BAR
#undef PG8_SCHED
}
}
#define GAS __attribute__((address_space(1)))
#define LAS __attribute__((address_space(3)))
typedef unsigned short bf16;
typedef unsigned v4u __attribute__((ext_vector_type(4)));
typedef float f32x4 __attribute__((ext_vector_type(4)));
typedef short bf16x8 __attribute__((ext_vector_type(8)));
typedef GAS unsigned gu32;
typedef GAS unsigned long long gu64;
#define RLX_AGENT __ATOMIC_RELAXED, __HIP_MEMORY_SCOPE_AGENT
#define LDS_WAIT() asm volatile("s_waitcnt lgkmcnt(0)" ::: "memory")
#define VM_WAIT() asm volatile("s_waitcnt vmcnt(0)" ::: "memory")
__device__ __forceinline__ unsigned long long rt() { return __builtin_amdgcn_s_memrealtime(); }
__device__ __forceinline__ unsigned f2bf(float f) { unsigned u = __builtin_bit_cast(unsigned, f); return (u + 0x7fffu + ((u >> 16) & 1u)) >> 16; }
__device__ __forceinline__ unsigned pk2(float lo, float hi) { return f2bf(lo) | (f2bf(hi) << 16); }

#define XB_TMO      128
#define XB_XCNT(j)  (256  + 64 * (j))
#define XB_XSUB(j)  (1280 + 64 * (j))
#define XB_XGEN(j)  (2304 + 64 * (j))
#define XB_TOP      3328
#define XB_TOPGEN   3392
#define XCD_BAR_WORDS 3456
#define XB_SPIN_CAP (1u << 18)

__device__ __forceinline__ unsigned xb_ld(unsigned* p)              { return __hip_atomic_load(p, __ATOMIC_RELAXED, __HIP_MEMORY_SCOPE_AGENT); }
__device__ __forceinline__ unsigned xb_add(unsigned* p, unsigned v) { return __hip_atomic_fetch_add(p, v, __ATOMIC_RELAXED, __HIP_MEMORY_SCOPE_AGENT); }
__device__ __forceinline__ unsigned xb_xcc_id() { return (unsigned)__builtin_amdgcn_s_getreg((3 << 11) | 20) & 0xFu; }
#define XB_SPIN(cond, bar) do { unsigned _sp = 0; while (cond) { __builtin_amdgcn_s_sleep(1); \
    if ((++_sp & 255u) == 0u) { if (xb_ld(&(bar)[XB_TMO])) break; if (_sp > XB_SPIN_CAP) { atomicAdd(&(bar)[XB_TMO], 1u); break; } } } } while (0)

struct XcdBarrier {
    unsigned* bar; unsigned x; unsigned w;
    volatile LAS unsigned* st;
};

__device__ __forceinline__ XcdBarrier xcd_barrier_post(unsigned* bar, volatile LAS unsigned* st) {
    XcdBarrier b; b.bar = bar; b.x = xb_xcc_id(); b.st = st; b.w = (unsigned)__builtin_amdgcn_readfirstlane((int)threadIdx.x >> 6);
    if (threadIdx.x == 0) (void)xb_add(&bar[XB_XCNT(b.x)], 1u);
    return b;
}
__device__ __forceinline__ void xcd_barrier_complete(unsigned* bar, unsigned x, unsigned& nloc, unsigned& nx) {
    const unsigned G = gridDim.x * gridDim.y * gridDim.z;
    unsigned sum, cnt, mine, sp = 0u;
    for (;;) {
        sum = 0u; cnt = 0u; mine = 0u;
#pragma unroll
        for (unsigned j = 0; j < 16; ++j) { const unsigned c = xb_ld(&bar[XB_XCNT(j)]); sum += c; cnt += (c > 0u) ? 1u : 0u; mine = (j == x) ? c : mine; }
        if (sum == G) break;
        __builtin_amdgcn_s_sleep(1);
        if ((++sp & 255u) == 0u) { if (xb_ld(&bar[XB_TMO])) break; if (sp > XB_SPIN_CAP) { atomicAdd(&bar[XB_TMO], 1u); break; } }
    }
    nloc = mine > 0u ? mine : 1u; nx = cnt > 0u ? cnt : 1u;
}

__device__ __forceinline__ void xcd_barrier(const XcdBarrier& b) {
    asm volatile("s_waitcnt vmcnt(0)" ::: "memory");
    __syncthreads();
    int l0_; asm volatile("v_mbcnt_lo_u32_b32 %0, -1, 0\n\tv_mbcnt_hi_u32_b32 %0, -1, %0" : "=v"(l0_));
    if (b.w == 0u && l0_ == 0) {
        unsigned* bar = b.bar; unsigned bx_ = b.x; asm volatile("" : "+s"(bar), "+s"(bx_));
        __builtin_amdgcn_s_waitcnt(0);
        unsigned nloc = b.st[0], nx = b.st[1];
        if (nloc == 0u) { xcd_barrier_complete(bar, bx_, nloc, nx); b.st[0] = nloc; b.st[1] = nx; }
        const unsigned old = xb_add(&bar[XB_XSUB(bx_)], 1u);
        const unsigned gen = old / nloc;
        if (old + 1u == (gen + 1u) * nloc) {
            __builtin_amdgcn_fence(__ATOMIC_RELEASE, "agent");
            asm volatile("s_waitcnt vmcnt(0)" ::: "memory");
            const unsigned og = xb_add(&bar[XB_TOP], 1u);
            const unsigned tg = og / nx;
            if (og + 1u == (tg + 1u) * nx) xb_add(&bar[XB_TOPGEN], 1u);
            else XB_SPIN(xb_ld(&bar[XB_TOPGEN]) == tg, bar);
            __builtin_amdgcn_fence(__ATOMIC_ACQUIRE, "agent");
            xb_add(&bar[XB_XGEN(bx_)], 1u);
            asm volatile("s_waitcnt vmcnt(0)" ::: "memory");
        } else {
            XB_SPIN(xb_ld(&bar[XB_XGEN(bx_)]) == gen, bar);
            __builtin_amdgcn_fence(__ATOMIC_ACQUIRE, "agent");
            asm volatile("s_waitcnt vmcnt(0)" ::: "memory");
        }
    }
    __syncthreads();
}

constexpr int DM = 1024, NB = 16, SEQ = 2048, DEPTH = 2, DBATCH = 32, DSEQ = 32, PAST = 4096;
constexpr int PR = NB * SEQ, SR = DBATCH * DSEQ, R = PR + SR;
constexpr int SBW = 512, LORA = 128, ROPE = 32, QLW = 1024, QRW = 256, DFF = 2816, UPW = 5632, DPLE = 256, NHEAD = 8;
constexpr int INC = 4512, NIN = 5120;
constexpr float EPS = 1e-6f, LOG2E = 1.4426950408889634f;
constexpr float QS_SB = 0.125f * LOG2E;
constexpr float QS_MLA = 0.10206207261596575f * LOG2E;
constexpr int NSLOT = 2048 + 32;

constexpr size_t O_Y = 0;
constexpr size_t O_SBK_P = (size_t)R * DM;
constexpr size_t O_SBV_P = O_SBK_P + (size_t)DEPTH * PR * SBW;
constexpr size_t O_CKV_P = O_SBV_P + (size_t)DEPTH * PR * SBW;
constexpr size_t O_KR_P = O_CKV_P + (size_t)DEPTH * PR * LORA;
constexpr size_t O_CONV_P = O_KR_P + (size_t)DEPTH * PR * ROPE;
constexpr size_t O_SBK_S = O_CONV_P + (size_t)DEPTH * NB * 2 * UPW;
constexpr size_t O_SBV_S = O_SBK_S + (size_t)DEPTH * SR * SBW;
constexpr size_t O_CKV_S = O_SBV_S + (size_t)DEPTH * SR * SBW;
constexpr size_t O_KR_S = O_CKV_S + (size_t)DEPTH * SR * LORA;
constexpr size_t O_CONV_S = O_KR_S + (size_t)DEPTH * SR * ROPE;
constexpr size_t O_END = O_CONV_S + (size_t)DEPTH * DBATCH * 2 * UPW;
static_assert(O_END == 115703808ull, "output map");

constexpr size_t MiB = 1u << 20;
constexpr size_t WS_CTL = 0, CTL_ZERO_BYTES = 1 * MiB;
constexpr size_t WS_ROPE = 1 * MiB;
constexpr size_t WS_W = 4 * MiB, WL = 36 * MiB;
constexpr size_t W_IN = 0, W_SB = 10 * MiB, W_YB = 11 * MiB, W_OUT = 13 * MiB, W_UP = 15 * MiB, W_DOWN = 26 * MiB, W_PG = 32 * MiB, W_PP = 34 * MiB;
constexpr size_t WS_XN = 80 * MiB, WS_QSB = 146 * MiB, WS_KSB = 179 * MiB, WS_VSB = 212 * MiB, WS_QLAT = 245 * MiB, WS_QROPE = 311 * MiB,
                 WS_CKVB = 328 * MiB, WS_KRB = 337 * MiB, WS_GA = 340 * MiB, WS_GB = 406 * MiB, WS_OSB = 472 * MiB, WS_OLAT = 505 * MiB,
                 WS_MG = 571 * MiB, WS_MIX = 637 * MiB, WS_XB = 769 * MiB, WS_PP = 835 * MiB, WS_PB = 967 * MiB, WS_U = 1000 * MiB,
                 WS_ACT = 1363 * MiB, WS_END = 1546 * MiB;
static_assert(W_PP + (size_t)DM * DPLE * 2 <= WL && WS_W + 2 * WL <= WS_XN, "weights map");
static_assert(WS_ACT + (size_t)R * DFF * 2 <= WS_END && WS_U + (size_t)R * UPW * 2 <= WS_ACT && WS_PB + 2 * (size_t)R * DPLE * 2 <= WS_U, "ws map");
constexpr int CW_BAR = 4096;

constexpr int RING_BYTES = 131072, XL_OFF = RING_BYTES, MISC_OFF = RING_BYTES + 8192, LDS_BYTES = 147456;

#ifndef MK_PER_PHASE
#define MK_PER_PHASE 0
#endif
#ifndef MK_PH_END
#define MK_PH_END (2 + 12 * DEPTH)
#endif
constexpr int NPHASE = MK_PH_END;
#ifndef MK_DBL
#define MK_DBL 0
#endif
#define REP(bit) for (int rep_ = 0; rep_ < ((MK_DBL >> (bit)) & 1) + 1; ++rep_)
#ifndef SPLITK
#define SPLITK 1
#endif
#ifndef FAST_SB
#define FAST_SB 1
#endif
#ifndef FAST_MLA
#define FAST_MLA 1
#endif
#ifndef FAST_SSB
#define FAST_SSB 1
#endif
#ifndef FAST_SMLA
#define FAST_SMLA 1
#endif

__device__ __forceinline__ float bf2f(unsigned short b) { return __uint_as_float((unsigned)b << 16); }
__device__ __forceinline__ float lo2f(unsigned w) { return __uint_as_float(w << 16); }
__device__ __forceinline__ float hi2f(unsigned w) { return __uint_as_float(w & 0xffff0000u); }
__device__ __forceinline__ float fexp2(float x) { return __builtin_amdgcn_exp2f(x); }
__device__ __forceinline__ float frcp(float x) { return __builtin_amdgcn_rcpf(x); }
__device__ __forceinline__ float sigm(float x) { return frcp(1.0f + fexp2(-LOG2E * x)); }
template <int O> __device__ __forceinline__ float xshfl(float v) {
    if constexpr (O == 32) { const auto sw = __builtin_amdgcn_permlane32_swap(__float_as_uint(v), __float_as_uint(v), false, false); const float a = __uint_as_float(sw[0]), b = __uint_as_float(sw[1]); return (a == v) ? b : a; }
    else return __uint_as_float((unsigned)__builtin_amdgcn_ds_swizzle((int)__float_as_uint(v), (O << 10) | 0x1f));
}
__device__ __forceinline__ float wave_sum(float v) {
    v += xshfl<1>(v); v += xshfl<2>(v); v += xshfl<4>(v); v += xshfl<8>(v); v += xshfl<16>(v);
    { const auto sw = __builtin_amdgcn_permlane32_swap(__float_as_uint(v), __float_as_uint(v), false, false); v = __uint_as_float(sw[0]) + __uint_as_float(sw[1]); }
    return v;
}
__device__ __forceinline__ v4u pack8(f32x4 a, f32x4 b) { v4u w; w.x = pg8::cvt_pk_bf16(a[0], a[1]); w.y = pg8::cvt_pk_bf16(a[2], a[3]); w.z = pg8::cvt_pk_bf16(b[0], b[1]); w.w = pg8::cvt_pk_bf16(b[2], b[3]); return w; }
__device__ __forceinline__ v4u pack8c(f32x4 a, f32x4 b) { v4u w; w.x = pg8::cvt_pk_bf16_c(a[0], a[1]); w.y = pg8::cvt_pk_bf16_c(a[2], a[3]); w.z = pg8::cvt_pk_bf16_c(b[0], b[1]); w.w = pg8::cvt_pk_bf16_c(b[2], b[3]); return w; }
__device__ __forceinline__ int ridx(int p) { return ((p >> 2) & 1) * 16 + 4 * (p >> 3) + (p & 3); }
__device__ __forceinline__ int pos_slot(int row) { return row < PR ? (row & (SEQ - 1)) : SEQ + ((row - PR) & (DSEQ - 1)); }

typedef pg8::f32x4 A4;

template <int NN, int NM = R / 256, int WG = 12> struct Ord {
    static constexpr int NWG = NM * NN, NIG = WG * NN, Q = NWG / 8, RM = NWG % 8;
    static_assert(NM % WG == 0, "row panels per group");
    int G, c;
    __device__ __forceinline__ void init(int G_, int c_) { G = G_; c = c_; }
    __device__ __forceinline__ bool next(int i, pg8::Unit& u) const {
        const int Lx = i * G + c; if (Lx >= NWG) return false;
        const int xcd = Lx & 7, off = Lx >> 3; const int wgid = (xcd < RM ? xcd * (Q + 1) : RM * (Q + 1) + (xcd - RM) * Q) + off;
        const int gid = wgid / NIG, rem = wgid - gid * NIG; u.pm = gid * WG + rem % WG; u.pn = rem / WG; u.pk = 0; return true;
    }
    __device__ __forceinline__ void a_ready(const pg8::Unit&) const {}
    __device__ __forceinline__ void done(const pg8::Unit&) const {}
};
template <int KS> struct OrdSplit {
    int G, c;
    __device__ __forceinline__ void init(int G_, int c_) { G = G_; c = c_; }
    __device__ __forceinline__ bool next(int i, pg8::Unit& u) const { const int Lx = i * G + c; if (Lx >= 16 * KS) return false; u.pk = Lx >> 4; u.pm = PR / 256 + (Lx & 3); u.pn = (Lx >> 2) & 3; return true; }
    __device__ __forceinline__ void a_ready(const pg8::Unit&) const {}
    __device__ __forceinline__ void done(const pg8::Unit&) const {}
};
struct EpiIn {
    static constexpr bool PERM = true, AFTER_DRAIN = false;
    unsigned char* ws_; float* out_; int L; const float* gain; LAS float* xl;
    __device__ __forceinline__ void operator()(const A4 (&acc)[2][2][4][2], const pg8::Unit& u, int wr, int wc, int fr, int fq) const {
        unsigned char* ws = ws_; float* out = out_; asm volatile("" : "+s"(ws), "+s"(out));
        const int pn = u.pn; const bool samp = u.pm >= PR / 256;
        const int row0 = u.pm * 256 + wr * 64 + fr;
        if (pn < 2) { bf16* const QSB = (bf16*)(ws + WS_QSB);
#pragma unroll
            for (int ai = 0; ai < 2; ++ai)
#pragma unroll
                for (int m = 0; m < 4; ++m) { const int row = row0 + ai * 128 + m * 16;
#pragma unroll
                    for (int bj = 0; bj < 2; ++bj) { const int col = pn * 256 + bj * 128 + wc * 32 + 8 * fq;
                        *(v4u*)(QSB + (size_t)row * SBW + col) = pack8(acc[ai][bj][m][0] * QS_SB, acc[ai][bj][m][1] * QS_SB); } }
        } else if (pn < 6) {
            const int which = (pn - 2) >> 1; bf16* B = (bf16*)(ws + (which ? WS_VSB : WS_KSB));
            float* O = out + (samp ? (which ? O_SBV_S : O_SBK_S) + (size_t)L * SR * SBW : (which ? O_SBV_P : O_SBK_P) + (size_t)L * PR * SBW);
#pragma unroll
            for (int ai = 0; ai < 2; ++ai)
#pragma unroll
                for (int m = 0; m < 4; ++m) { const int row = row0 + ai * 128 + m * 16, prow = samp ? row - PR : row;
#pragma unroll
                    for (int bj = 0; bj < 2; ++bj) { const int col = ((pn - 2) & 1) * 256 + bj * 128 + wc * 32 + 8 * fq;
                        const A4 v0 = acc[ai][bj][m][0], v1 = acc[ai][bj][m][1];
                        float* op = O + (size_t)prow * SBW + col; *(A4*)op = v0; *(A4*)(op + 4) = v1;
                        *(v4u*)(B + (size_t)row * SBW + col) = pack8(v0, v1); } }
        } else if (pn < 10) { bf16* const QLAT = (bf16*)(ws + WS_QLAT);
#pragma unroll
            for (int ai = 0; ai < 2; ++ai)
#pragma unroll
                for (int m = 0; m < 4; ++m) { const int row = row0 + ai * 128 + m * 16;
#pragma unroll
                    for (int bj = 0; bj < 2; ++bj) { const int col = (pn - 6) * 256 + bj * 128 + wc * 32 + 8 * fq;
                        *(v4u*)(QLAT + (size_t)row * QLW + col) = pack8(acc[ai][bj][m][0] * QS_MLA, acc[ai][bj][m][1] * QS_MLA); } }
        } else if (pn == 10) { bf16* const QROPE = (bf16*)(ws + WS_QROPE); const float* const tab = (const float*)(ws + WS_ROPE);
#pragma unroll
            for (int ai = 0; ai < 2; ++ai)
#pragma unroll
                for (int m = 0; m < 4; ++m) { const int row = row0 + ai * 128 + m * 16; const float* tp = tab + pos_slot(row) * 32 + 4 * fq;
                    const A4 cs = *(const A4*)tp, sn = *(const A4*)(tp + 16);
#pragma unroll
                    for (int bj = 0; bj < 2; ++bj) { const int head = bj * 4 + wc; const A4 x1 = acc[ai][bj][m][0], x2 = acc[ai][bj][m][1];
                        const A4 y1 = (x1 * cs - x2 * sn) * QS_MLA, y2 = (x1 * sn + x2 * cs) * QS_MLA;
                        *(v4u*)(QROPE + (size_t)row * QRW + head * 32 + 8 * fq) = pack8(y1, y2); } }
        } else if (pn == 11) { bf16* const CKVB = (bf16*)(ws + WS_CKVB); bf16* const KRB = (bf16*)(ws + WS_KRB); const float* const tab = (const float*)(ws + WS_ROPE);
            float* const ckv_o = out + (samp ? O_CKV_S + (size_t)L * SR * LORA : O_CKV_P + (size_t)L * PR * LORA); float* const kr_o = out + (samp ? O_KR_S + (size_t)L * SR * ROPE : O_KR_P + (size_t)L * PR * ROPE);
#pragma unroll
            for (int ai = 0; ai < 2; ++ai)
#pragma unroll
                for (int m = 0; m < 4; ++m) { const A4 a = acc[ai][0][m][0], b = acc[ai][0][m][1];
                    float s = (a[0] * a[0] + a[1] * a[1]) + (a[2] * a[2] + a[3] * a[3]) + (b[0] * b[0] + b[1] * b[1]) + (b[2] * b[2] + b[3] * b[3]);
                    s += xshfl<16>(s); { const auto sw = __builtin_amdgcn_permlane32_swap(__float_as_uint(s), __float_as_uint(s), false, false); s = __uint_as_float(sw[0]) + __uint_as_float(sw[1]); }
                    if (fq == 0) xl[(ai * 128 + wr * 64 + m * 16 + fr) * 4 + wc] = s; }
            asm volatile("s_waitcnt lgkmcnt(0)" ::: "memory"); __builtin_amdgcn_s_barrier(); asm volatile("" ::: "memory");
            const int ccol = wc * 32 + 8 * fq; const A4 g0 = *(const A4*)(gain + ccol), g1 = *(const A4*)(gain + ccol + 4);
#pragma unroll
            for (int ai = 0; ai < 2; ++ai)
#pragma unroll
                for (int m = 0; m < 4; ++m) { const int row = row0 + ai * 128 + m * 16, prow = samp ? row - PR : row;
                    const A4 p = *(const LAS A4*)(xl + (ai * 128 + wr * 64 + m * 16 + fr) * 4);
                    const float rs = 1.0f / sqrtf(((p[0] + p[1]) + (p[2] + p[3])) * (1.0f / LORA) + EPS);
                    const A4 v0 = acc[ai][0][m][0] * rs * g0, v1 = acc[ai][0][m][1] * rs * g1;
                    float* op = ckv_o + (size_t)prow * LORA + ccol; *(A4*)op = v0; *(A4*)(op + 4) = v1;
                    *(v4u*)(CKVB + (size_t)row * LORA + ccol) = pack8(v0, v1);
                    if (wc == 0) {
                        const float* tp = tab + pos_slot(row) * 32 + 4 * fq; const A4 cs = *(const A4*)tp, sn = *(const A4*)(tp + 16);
                        const A4 x1 = acc[ai][1][m][0], x2 = acc[ai][1][m][1];
                        const A4 y1 = x1 * cs - x2 * sn, y2 = x1 * sn + x2 * cs;
                        float* kp = kr_o + (size_t)prow * ROPE + 4 * fq; *(A4*)kp = y1; *(A4*)(kp + 16) = y2;
                        *(v4u*)(KRB + (size_t)row * ROPE + 8 * fq) = pack8(y1, y2); } }
        } else {
            bf16* G = (bf16*)(ws + (pn < 16 ? WS_GA : WS_GB));
#pragma unroll
            for (int ai = 0; ai < 2; ++ai)
#pragma unroll
                for (int m = 0; m < 4; ++m) { const int row = row0 + ai * 128 + m * 16;
#pragma unroll
                    for (int bj = 0; bj < 2; ++bj) { const int col = ((pn - 12) & 3) * 256 + bj * 128 + wc * 32 + 8 * fq;
                        const A4 a = acc[ai][bj][m][0], b = acc[ai][bj][m][1];
                        const A4 sa = {sigm(a[0]), sigm(a[1]), sigm(a[2]), sigm(a[3])}, sb = {sigm(b[0]), sigm(b[1]), sigm(b[2]), sigm(b[3])};
                        *(v4u*)(G + (size_t)row * DM + col) = pack8c(sa, sb); } }
        }
    }
};
template <bool ADD> struct EpiGate {
    static constexpr bool PERM = true, AFTER_DRAIN = false;
    const bf16* G; bf16* MG;
    __device__ __forceinline__ void operator()(const A4 (&acc)[2][2][4][2], const pg8::Unit& u, int wr, int wc, int fr, int fq) const {
        const int row0 = u.pm * 256 + wr * 64 + fr;
#pragma unroll
        for (int ai = 0; ai < 2; ++ai)
#pragma unroll
            for (int m = 0; m < 4; ++m) { const int row = row0 + ai * 128 + m * 16;
#pragma unroll
                for (int bj = 0; bj < 2; ++bj) { const size_t off = (size_t)row * DM + u.pn * 256 + bj * 128 + wc * 32 + 8 * fq;
                    const v4u g = *(const v4u*)(G + off);
                    A4 a = acc[ai][bj][m][0] * (A4){lo2f(g.x), hi2f(g.x), lo2f(g.y), hi2f(g.y)}, b = acc[ai][bj][m][1] * (A4){lo2f(g.z), hi2f(g.z), lo2f(g.w), hi2f(g.w)};
                    if (ADD) { const v4u o = *(const v4u*)(MG + off); a += (A4){lo2f(o.x), hi2f(o.x), lo2f(o.y), hi2f(o.y)}; b += (A4){lo2f(o.z), hi2f(o.z), lo2f(o.w), hi2f(o.w)}; }
                    *(v4u*)(MG + off) = pack8(a, b); } }
    }
};
struct EpiF32 {
    static constexpr bool PERM = true, AFTER_DRAIN = false;
    float* O; int ldc;
    __device__ __forceinline__ void operator()(const A4 (&acc)[2][2][4][2], const pg8::Unit& u, int wr, int wc, int fr, int fq) const {
        const int row0 = u.pm * 256 + wr * 64 + fr;
#pragma unroll
        for (int ai = 0; ai < 2; ++ai)
#pragma unroll
            for (int m = 0; m < 4; ++m) { const int row = row0 + ai * 128 + m * 16;
#pragma unroll
                for (int bj = 0; bj < 2; ++bj) { float* op = O + (size_t)row * ldc + u.pn * 256 + bj * 128 + wc * 32 + 8 * fq;
                    *(A4*)op = acc[ai][bj][m][0]; *(A4*)(op + 4) = acc[ai][bj][m][1]; } }
    }
};
struct EpiSlab {
    static constexpr bool PERM = true, AFTER_DRAIN = false;
    float* O; int ldc;
    __device__ __forceinline__ void operator()(const A4 (&acc)[2][2][4][2], const pg8::Unit& u, int wr, int wc, int fr, int fq) const {
        const int row0 = (u.pm - PR / 256) * 256 + wr * 64 + fr; float* Ob = O + (size_t)u.pk * SR * ldc;
#pragma unroll
        for (int ai = 0; ai < 2; ++ai)
#pragma unroll
            for (int m = 0; m < 4; ++m) { const int row = row0 + ai * 128 + m * 16;
#pragma unroll
                for (int bj = 0; bj < 2; ++bj) { float* op = Ob + (size_t)row * ldc + u.pn * 256 + bj * 128 + wc * 32 + 8 * fq;
                    *(A4*)op = acc[ai][bj][m][0]; *(A4*)(op + 4) = acc[ai][bj][m][1]; } }
    }
};
struct EpiBf {
    static constexpr bool PERM = true, AFTER_DRAIN = false;
    bf16* O; int ldc; float* conv_p; float* conv_s;
    __device__ __forceinline__ void operator()(const A4 (&acc)[2][2][4][2], const pg8::Unit& u, int wr, int wc, int fr, int fq) const {
        const int row0 = u.pm * 256 + wr * 64 + fr; const bool samp = u.pm >= PR / 256;
#pragma unroll
        for (int ai = 0; ai < 2; ++ai)
#pragma unroll
            for (int m = 0; m < 4; ++m) { const int row = row0 + ai * 128 + m * 16;
                int ci = -1;
                if (conv_p) { if (!samp) { const int t = row & (SEQ - 1); if (t >= SEQ - 2) ci = (row >> 11) * 2 + (t - (SEQ - 2)); }
                              else { const int t = (row - PR) & (DSEQ - 1); if (t >= DSEQ - 2) ci = ((row - PR) >> 5) * 2 + (t - (DSEQ - 2)); } }
#pragma unroll
                for (int bj = 0; bj < 2; ++bj) { const int col = u.pn * 256 + bj * 128 + wc * 32 + 8 * fq;
                    *(v4u*)(O + (size_t)row * ldc + col) = pack8(acc[ai][bj][m][0], acc[ai][bj][m][1]);
                    if (ci >= 0) { float* cp = (samp ? conv_s : conv_p) + (size_t)ci * UPW + col; *(A4*)cp = acc[ai][bj][m][0]; *(A4*)(cp + 4) = acc[ai][bj][m][1]; } } }
    }
};
struct EpiPle {
    static constexpr bool PERM = true, AFTER_DRAIN = false;
    float* X; const bf16* PP;
    __device__ __forceinline__ void operator()(const A4 (&acc)[2][2][4][2], const pg8::Unit& u, int wr, int wc, int fr, int fq) const {
        const int row0 = u.pm * 256 + wr * 64 + fr;
#pragma unroll
        for (int ai = 0; ai < 2; ++ai)
#pragma unroll
            for (int m = 0; m < 4; ++m) { const int row = row0 + ai * 128 + m * 16;
#pragma unroll
                for (int bj = 0; bj < 2; ++bj) { const size_t off = (size_t)row * DM + u.pn * 256 + bj * 128 + wc * 32 + 8 * fq;
                    const v4u p = *(const v4u*)(PP + off); float* xp = X + off; const A4 x0 = *(const A4*)xp, x1 = *(const A4*)(xp + 4);
                    const A4 a = acc[ai][bj][m][0], b = acc[ai][bj][m][1];
                    const A4 sa = {sigm(a[0]), sigm(a[1]), sigm(a[2]), sigm(a[3])}, sb = {sigm(b[0]), sigm(b[1]), sigm(b[2]), sigm(b[3])};
                    *(A4*)xp = x0 + sa * (A4){lo2f(p.x), hi2f(p.x), lo2f(p.y), hi2f(p.y)}; *(A4*)(xp + 4) = x1 + sb * (A4){lo2f(p.z), hi2f(p.z), lo2f(p.w), hi2f(p.w)}; } }
    }
};

struct Args { const float* in[26]; float* out; unsigned char* ws; int ph_lo, ph_hi; };
typedef const __attribute__((address_space(4))) Args* CArgs;

__device__ __forceinline__ void row_op(int lane, const float* xin, const float* addsrc, const float* g_add, float* xout, bf16* bout, const float* g_out, int nadd = 1, size_t addstride = 0) {
    const f32x4* xr = (const f32x4*)xin + lane; f32x4 v[4];
#pragma unroll
    for (int j = 0; j < 4; ++j) v[j] = xr[64 * j];
    if (addsrc) {
        const f32x4* ar = (const f32x4*)addsrc + lane; const f32x4* gr = (const f32x4*)g_add + lane; f32x4 a[4]; float s = 0.f;
#pragma unroll
        for (int j = 0; j < 4; ++j) { a[j] = ar[64 * j]; for (int sl = 1; sl < nadd; ++sl) a[j] += *(const f32x4*)(addsrc + (size_t)sl * addstride + 4 * (lane + 64 * j));
            s += (a[j].x * a[j].x + a[j].y * a[j].y) + (a[j].z * a[j].z + a[j].w * a[j].w); }
        const float r = 1.0f / sqrtf(wave_sum(s) * (1.0f / DM) + EPS);
#pragma unroll
        for (int j = 0; j < 4; ++j) v[j] += a[j] * r * gr[64 * j];
    }
    if (xout) { f32x4* xo = (f32x4*)xout + lane;
#pragma unroll
        for (int j = 0; j < 4; ++j) xo[64 * j] = v[j]; }
    if (bout) {
        if (g_out) { float s = 0.f; const f32x4* gr = (const f32x4*)g_out + lane;
#pragma unroll
            for (int j = 0; j < 4; ++j) s += (v[j].x * v[j].x + v[j].y * v[j].y) + (v[j].z * v[j].z + v[j].w * v[j].w);
            const float r = 1.0f / sqrtf(wave_sum(s) * (1.0f / DM) + EPS);
#pragma unroll
            for (int j = 0; j < 4; ++j) v[j] = v[j] * r * gr[64 * j]; }
        unsigned long long* o8 = (unsigned long long*)bout + lane;
#pragma unroll
        for (int j = 0; j < 4; ++j) o8[64 * j] = (unsigned long long)pg8::cvt_pk_bf16(v[j].x, v[j].y) | ((unsigned long long)pg8::cvt_pk_bf16(v[j].z, v[j].w) << 32);
    }
}

__device__ __forceinline__ void tr_item(const float* W, int N, bf16* WT, int K, int k0, int n0, int s0, bool perm, bool zero, LAS float* scr, int lane) {
    if (!zero) {
#pragma unroll 8
        for (int i = 0; i < 32; ++i) { const int kk = 2 * i + (lane >> 5); scr[kk * 33 + (lane & 31)] = W[(size_t)(k0 + kk) * N + s0 + (lane & 31)]; }
    }
    LDS_WAIT(); asm volatile("" ::: "memory");
    const int c = lane & 7;
#pragma unroll
    for (int j = 0; j < 4; ++j) { const int n = (lane >> 3) + 8 * j; const int sc = perm ? ridx(n) : n; const LAS float* s = scr + (8 * c) * 33 + sc;
        v4u o; o.x = pk2(s[0 * 33], s[1 * 33]); o.y = pk2(s[2 * 33], s[3 * 33]); o.z = pk2(s[4 * 33], s[5 * 33]); o.w = pk2(s[6 * 33], s[7 * 33]);
        if (zero) o = (v4u){0u, 0u, 0u, 0u};
        *(GAS v4u*)(WT + (size_t)(n0 + n) * K + k0 + 8 * c) = o; }
    LDS_WAIT(); asm volatile("" ::: "memory");
}
__device__ __forceinline__ void absorb_tile(const float* A, int lda, const float* B, int ldb, bool bjmajor, bf16* dst, int ldd, LAS float* As, LAS float* Bs, int t) {
#pragma unroll
    for (int i = 0; i < 2; ++i) { const int idx = t + 512 * i, row = idx >> 4, c4 = idx & 15; const f32x4 v = *(const f32x4*)(A + (size_t)row * lda + 4 * c4);
        As[(4 * c4) * 68 + row] = v.x; As[(4 * c4 + 1) * 68 + row] = v.y; As[(4 * c4 + 2) * 68 + row] = v.z; As[(4 * c4 + 3) * 68 + row] = v.w; }
    if (!bjmajor) {
#pragma unroll
        for (int i = 0; i < 4; ++i) { const int idx = t + 512 * i, row = idx >> 4, c4 = idx & 15; const f32x4 v = *(const f32x4*)(B + (size_t)row * ldb + 4 * c4);
            Bs[(4 * c4) * 132 + row] = v.x; Bs[(4 * c4 + 1) * 132 + row] = v.y; Bs[(4 * c4 + 2) * 132 + row] = v.z; Bs[(4 * c4 + 3) * 132 + row] = v.w; }
    } else {
#pragma unroll
        for (int i = 0; i < 4; ++i) { const int idx = t + 512 * i, j = idx >> 5, c4 = idx & 31; *(LAS f32x4*)(Bs + j * 132 + 4 * c4) = *(const f32x4*)(B + (size_t)j * ldb + 4 * c4); }
    }
    __syncthreads();
    const int tm = t & 15, tn = t >> 4; f32x4 acc[4];
#pragma unroll
    for (int ni = 0; ni < 4; ++ni) acc[ni] = (f32x4){0.f, 0.f, 0.f, 0.f};
#pragma unroll 8
    for (int j = 0; j < 64; ++j) { const f32x4 a4 = *(LAS f32x4*)(As + j * 68 + 4 * tm), b4 = *(LAS f32x4*)(Bs + j * 132 + 4 * tn);
        acc[0] += a4 * b4.x; acc[1] += a4 * b4.y; acc[2] += a4 * b4.z; acc[3] += a4 * b4.w; }
#pragma unroll
    for (int ni = 0; ni < 4; ++ni) *(unsigned long long*)(dst + (size_t)(4 * tn + ni) * ldd + 4 * tm) = (unsigned long long)pk2(acc[ni].x, acc[ni].y) | ((unsigned long long)pk2(acc[ni].z, acc[ni].w) << 32);
    __syncthreads();
}
struct Seg { const float* W; bf16* WT; int N, K, n0, s0, sstride, ng, perm, zero; };
__device__ __forceinline__ Seg get_seg(CArgs a, int L, int s) {
    unsigned char* wb = a->ws + WS_W + (size_t)L * WL; const float* win = a->in[9] + (size_t)L * DM * INC; bf16* wint = (bf16*)(wb + W_IN);
    Seg g{win, wint, INC, DM, 0, 0, 32, 0, 0, 0};
    switch (s) {
        case 0: g.n0 = 0; g.s0 = 0; g.ng = 48; break;
        case 1: g.n0 = 2560; g.s0 = 1536 + 64; g.sstride = 96; g.ng = 8; g.perm = 1; break;
        case 2: g.n0 = 2816; g.s0 = 2304; g.ng = 4; break;
        case 3: g.n0 = 2944; g.s0 = 2432; g.ng = 1; g.perm = 1; break;
        case 4: g.n0 = 2976; g.s0 = 0; g.sstride = 0; g.ng = 3; g.zero = 1; break;
        case 5: g.n0 = 3072; g.s0 = 2464; g.ng = 64; break;
        case 6: g.W = a->in[13] + (size_t)L * SBW * DM; g.WT = (bf16*)(wb + W_SB); g.N = DM; g.K = SBW; g.ng = 32; break;
        case 7: g.W = a->in[15] + (size_t)L * DM * DM; g.WT = (bf16*)(wb + W_OUT); g.N = DM; g.K = DM; g.ng = 32; break;
        case 8: g.W = a->in[20] + (size_t)L * DM * UPW; g.WT = (bf16*)(wb + W_UP); g.N = UPW; g.K = DM; g.ng = 176; break;
        case 9: g.W = a->in[23] + (size_t)L * DFF * DM; g.WT = (bf16*)(wb + W_DOWN); g.N = DM; g.K = DFF; g.ng = 32; break;
        case 10: g.W = a->in[24] + (size_t)L * DM * DM; g.WT = (bf16*)(wb + W_PG); g.N = DM; g.K = DM; g.ng = 32; break;
        default: g.W = a->in[25] + (size_t)L * DPLE * DM; g.WT = (bf16*)(wb + W_PP); g.N = DM; g.K = DPLE; g.ng = 32; break;
    }
    return g;
}
constexpr int NSEG = 12;

__device__ __forceinline__ void sincos_d(float ang, float& s, float& c) {
    const double x = (double)ang; const double q = rint(x * 0.63661977236758134308); const double r = x - q * 1.57079632679489661923; const double r2 = r * r;
    double sp = -2.5052108385441718775e-08; sp = sp * r2 + 2.7557319223985890653e-06; sp = sp * r2 - 1.9841269841269841270e-04; sp = sp * r2 + 8.3333333333333333333e-03; sp = sp * r2 - 1.6666666666666666667e-01; sp = r + r * r2 * sp;
    double cp = 2.0876756987868098979e-09; cp = cp * r2 - 2.7557319223985890653e-07; cp = cp * r2 + 2.4801587301587301587e-05; cp = cp * r2 - 1.3888888888888888889e-03; cp = cp * r2 + 4.1666666666666666667e-02; cp = cp * r2 - 0.5; cp = 1.0 + r2 * cp;
    const int qi = (int)((long long)q & 3);
    const double ss = (qi == 0) ? sp : (qi == 1) ? cp : (qi == 2) ? -sp : -cp;
    const double cc = (qi == 0) ? cp : (qi == 1) ? -sp : (qi == 2) ? -cp : sp;
    s = (float)ss; c = (float)cc;
}

__device__ __forceinline__ void p0_prologue(CArgs a, LAS unsigned char* lds, int vcu, int G, int wave, int lane) {
    const int gw = vcu * 8 + wave, NGW = G * 8, gt = gw * 64 + lane, NGT = NGW * 64;
    LAS float* scr = (LAS float*)(lds + wave * 16384);
    for (int L = 0; L < DEPTH; ++L)
        for (int s = 0; s < NSEG; ++s) { const Seg g = get_seg(a, L, s); const int nit = (g.K / 64) * g.ng;
            for (int it = gw; it < nit; it += NGW) { const int kb = it / g.ng, gi = it - kb * g.ng;
                tr_item(g.W, g.N, g.WT, g.K, 64 * kb, g.n0 + 32 * gi, g.s0 + g.sstride * gi, g.perm != 0, g.zero != 0, scr, lane); } }
    __syncthreads();
    for (int tix = vcu; tix < DEPTH * 256; tix += G) { const int L = tix >> 8, r = tix & 255;
        unsigned char* wb = a->ws + WS_W + (size_t)L * WL;
        if (r < 128) { const int h = r >> 4, kt = r & 15;
            absorb_tile(a->in[9] + (size_t)L * DM * INC + (size_t)(kt * 64) * INC + 1536 + 96 * h, INC, a->in[11] + (size_t)L * LORA * NHEAD * 64 + h * 64, NHEAD * 64, false,
                        (bf16*)(wb + W_IN) + (size_t)(1536 + h * 128) * DM + kt * 64, DM, (LAS float*)lds, (LAS float*)(lds + 32768), wave * 64 + lane);
        } else { const int r2 = r - 128, h = r2 >> 4, lt = (r2 >> 3) & 1, nt = r2 & 7;
            absorb_tile(a->in[12] + (size_t)L * LORA * NHEAD * 64 + ((size_t)(lt * 64) * NHEAD + h) * 64, NHEAD * 64, a->in[14] + (size_t)L * SBW * DM + (size_t)(h * 64) * DM + nt * 128, DM, true,
                        (bf16*)(wb + W_YB) + (size_t)(nt * 128) * QLW + h * 128 + lt * 64, QLW, (LAS float*)lds, (LAS float*)(lds + 32768), wave * 64 + lane);
        }
    }
    { float* tab = (float*)(a->ws + WS_ROPE);
        for (int e = gt; e < NSLOT * 16; e += NGT) { const int slot = e >> 4, i = e & 15; const int pos = slot < SEQ ? slot : PAST + (slot - SEQ);
            const float freq = exp2f(-(float)i * (13.287712379549449f / 16.0f));
            float s, c; sincos_d((float)pos * freq, s, c); tab[slot * 32 + i] = c; tab[slot * 32 + 16 + i] = s; } }
    for (int m = gw; m < R; m += NGW) { const float* xin = m < PR ? a->in[0] + (size_t)m * DM : a->in[1] + (size_t)(m - PR) * DM;
        row_op(lane, xin, nullptr, nullptr, nullptr, (bf16*)(a->ws + WS_XN) + (size_t)m * DM, a->in[16]); }
    for (int e = gt; e < DEPTH * R * (DPLE / 8); e += NGT) { const int c8 = e & 31, rr = e >> 5, L = rr / R, row = rr - L * R;
        const float* src = row < PR ? a->in[2] + ((size_t)L * PR + row) * DPLE + 8 * c8 : a->in[3] + ((size_t)L * SR + (row - PR)) * DPLE + 8 * c8;
        const f32x4 x0 = *(const f32x4*)src, x1 = *(const f32x4*)(src + 4);
        *(v4u*)((bf16*)(a->ws + WS_PB) + ((size_t)L * R + row) * DPLE + 8 * c8) = pack8(x0, x1); }
}

__device__ __forceinline__ void conv_phase(CArgs a, int L, int vcu, int G, int wave, int lane) {
    const int gw = vcu * 8 + wave, NGW = G * 8; constexpr int NCG = (DFF / 8 + 63) / 64;
    const bf16* U = (const bf16*)(a->ws + WS_U); bf16* ACT = (bf16*)(a->ws + WS_ACT);
    const float* cw = a->in[21] + (size_t)L * 3 * UPW; const float* cb = a->in[22] + (size_t)L * UPW;
    for (int it = gw; it < (R / 16) * NCG; it += NGW) { const int strip = it / NCG, cg = it - strip * NCG; const int c8 = cg * 64 + lane; if (c8 >= DFF / 8) continue;
        const int col = 8 * c8, r0 = strip * 16; const bool samp = r0 >= PR; const bool first = samp ? (((r0 - PR) & (DSEQ - 1)) == 0) : ((r0 & (SEQ - 1)) == 0);
        float w[2][3][8], bs[2][8], p2[2][8], p1[2][8];
#pragma unroll
        for (int gv = 0; gv < 2; ++gv) {
#pragma unroll
            for (int i = 0; i < 3; ++i) { const f32x4 x0 = *(const f32x4*)(cw + (size_t)i * UPW + gv * DFF + col), x1 = *(const f32x4*)(cw + (size_t)i * UPW + gv * DFF + col + 4);
                w[gv][i][0] = x0.x; w[gv][i][1] = x0.y; w[gv][i][2] = x0.z; w[gv][i][3] = x0.w; w[gv][i][4] = x1.x; w[gv][i][5] = x1.y; w[gv][i][6] = x1.z; w[gv][i][7] = x1.w; }
            const f32x4 b0 = *(const f32x4*)(cb + gv * DFF + col), b1 = *(const f32x4*)(cb + gv * DFF + col + 4);
            bs[gv][0] = b0.x; bs[gv][1] = b0.y; bs[gv][2] = b0.z; bs[gv][3] = b0.w; bs[gv][4] = b1.x; bs[gv][5] = b1.y; bs[gv][6] = b1.z; bs[gv][7] = b1.w;
            if (samp && first) { const float* st = a->in[8] + (((size_t)L * DBATCH + ((r0 - PR) >> 5)) * 2) * UPW + gv * DFF + col;
                const f32x4 a0 = *(const f32x4*)st, a1 = *(const f32x4*)(st + 4), c0 = *(const f32x4*)(st + UPW), c1 = *(const f32x4*)(st + UPW + 4);
                p2[gv][0] = a0.x; p2[gv][1] = a0.y; p2[gv][2] = a0.z; p2[gv][3] = a0.w; p2[gv][4] = a1.x; p2[gv][5] = a1.y; p2[gv][6] = a1.z; p2[gv][7] = a1.w;
                p1[gv][0] = c0.x; p1[gv][1] = c0.y; p1[gv][2] = c0.z; p1[gv][3] = c0.w; p1[gv][4] = c1.x; p1[gv][5] = c1.y; p1[gv][6] = c1.z; p1[gv][7] = c1.w;
            } else if (first) {
#pragma unroll
                for (int e = 0; e < 8; ++e) { p2[gv][e] = 0.f; p1[gv][e] = 0.f; }
            } else { const v4u x2 = *(const v4u*)(U + (size_t)(r0 - 2) * UPW + gv * DFF + col), x1 = *(const v4u*)(U + (size_t)(r0 - 1) * UPW + gv * DFF + col);
                p2[gv][0] = lo2f(x2.x); p2[gv][1] = hi2f(x2.x); p2[gv][2] = lo2f(x2.y); p2[gv][3] = hi2f(x2.y); p2[gv][4] = lo2f(x2.z); p2[gv][5] = hi2f(x2.z); p2[gv][6] = lo2f(x2.w); p2[gv][7] = hi2f(x2.w);
                p1[gv][0] = lo2f(x1.x); p1[gv][1] = hi2f(x1.x); p1[gv][2] = lo2f(x1.y); p1[gv][3] = hi2f(x1.y); p1[gv][4] = lo2f(x1.z); p1[gv][5] = hi2f(x1.z); p1[gv][6] = lo2f(x1.w); p1[gv][7] = hi2f(x1.w); }
        }
#pragma unroll 4
        for (int t = 0; t < 16; ++t) { const int row = r0 + t; float cur[2][8], uc[2][8];
#pragma unroll
            for (int gv = 0; gv < 2; ++gv) { const v4u x = *(const v4u*)(U + (size_t)row * UPW + gv * DFF + col);
                cur[gv][0] = lo2f(x.x); cur[gv][1] = hi2f(x.x); cur[gv][2] = lo2f(x.y); cur[gv][3] = hi2f(x.y); cur[gv][4] = lo2f(x.z); cur[gv][5] = hi2f(x.z); cur[gv][6] = lo2f(x.w); cur[gv][7] = hi2f(x.w);
#pragma unroll
                for (int e = 0; e < 8; ++e) { uc[gv][e] = bs[gv][e] + p2[gv][e] * w[gv][0][e] + p1[gv][e] * w[gv][1][e] + cur[gv][e] * w[gv][2][e]; p2[gv][e] = p1[gv][e]; p1[gv][e] = cur[gv][e]; } }
            float o[8];
#pragma unroll
            for (int e = 0; e < 8; ++e) { const float x = uc[0][e]; const float y = 1.5957691216057308f * (x + 0.044715f * x * x * x); o[e] = x * frcp(1.0f + fexp2(-LOG2E * y)) * uc[1][e]; }
            *(v4u*)(ACT + (size_t)row * DFF + col) = pack8((f32x4){o[0], o[1], o[2], o[3]}, (f32x4){o[4], o[5], o[6], o[7]}); }
    }
}

__device__ __forceinline__ void naive_sb(CArgs a, int L, int vcu, int G, int wave, int lane) {
    const int gw = vcu * 8 + wave, NGW = G * 8;
    const bf16* QSB = (const bf16*)(a->ws + WS_QSB); const bf16* KSB = (const bf16*)(a->ws + WS_KSB); const bf16* VSB = (const bf16*)(a->ws + WS_VSB); bf16* OSB = (bf16*)(a->ws + WS_OSB);
    constexpr int NP = NB * NHEAD * (SEQ / 64), NS = DBATCH * NHEAD;
    for (int it = gw + (FAST_SB ? NP : 0); it < NP + (FAST_SSB ? 0 : NS); it += NGW) {
        const bool samp = it >= NP; int b, h, t, qrow, nown, rowbase;
        if (!samp) { b = it >> 8; h = (it >> 5) & 7; int tb = it & 31; if ((it / NGW) & 1) tb = 31 - tb; t = tb * 64 + lane; rowbase = b * SEQ; qrow = rowbase + t; nown = tb * 64 + 63; }
        else { const int bh = it - NP; b = bh >> 3; h = bh & 7; t = lane & 31; rowbase = PR + b * DSEQ; qrow = rowbase + t; nown = DSEQ - 1; }
        b = __builtin_amdgcn_readfirstlane(b); h = __builtin_amdgcn_readfirstlane(h); rowbase = __builtin_amdgcn_readfirstlane(rowbase); nown = __builtin_amdgcn_readfirstlane(nown);
        float q[64], o[64];
        { const v4u* qp = (const v4u*)(QSB + (size_t)qrow * SBW + h * 64);
#pragma unroll
            for (int c = 0; c < 8; ++c) { const v4u x = qp[c]; q[8 * c] = lo2f(x.x); q[8 * c + 1] = hi2f(x.x); q[8 * c + 2] = lo2f(x.y); q[8 * c + 3] = hi2f(x.y); q[8 * c + 4] = lo2f(x.z); q[8 * c + 5] = hi2f(x.z); q[8 * c + 6] = lo2f(x.w); q[8 * c + 7] = hi2f(x.w); } }
#pragma unroll
        for (int d = 0; d < 64; ++d) o[d] = 0.f;
        float carry = 1.0f; int vz = 0; asm volatile("" : "+v"(vz));
        for (int s = nown - 1; s >= 0; --s) {
            const v4u* kp = (const v4u*)(KSB + (size_t)(rowbase + s) * SBW + h * 64 + vz); const v4u* vp = (const v4u*)(VSB + (size_t)(rowbase + s) * SBW + h * 64 + vz);
            float z = 0.f;
#pragma unroll
            for (int c = 0; c < 8; ++c) { const v4u x = kp[c]; z += q[8 * c] * lo2f(x.x) + q[8 * c + 1] * hi2f(x.x) + q[8 * c + 2] * lo2f(x.y) + q[8 * c + 3] * hi2f(x.y) + q[8 * c + 4] * lo2f(x.z) + q[8 * c + 5] * hi2f(x.z) + q[8 * c + 6] * lo2f(x.w) + q[8 * c + 7] * hi2f(x.w); }
            const float e = fexp2(z), rr = frcp(1.0f + e), beta = 1.0f - rr; const bool vis = s < t;
            const float w = vis ? beta * carry : 0.f; carry = vis ? carry * rr : carry;
#pragma unroll
            for (int c = 0; c < 8; ++c) { const v4u x = vp[c]; o[8 * c] += w * lo2f(x.x); o[8 * c + 1] += w * hi2f(x.x); o[8 * c + 2] += w * lo2f(x.y); o[8 * c + 3] += w * hi2f(x.y); o[8 * c + 4] += w * lo2f(x.z); o[8 * c + 5] += w * hi2f(x.z); o[8 * c + 6] += w * lo2f(x.w); o[8 * c + 7] += w * hi2f(x.w); }
        }
        if (samp) {
            const float* ck = a->in[4] + ((((size_t)L * DBATCH + b) * PAST) * NHEAD + h) * 64; const float* cv = a->in[5] + ((((size_t)L * DBATCH + b) * PAST) * NHEAD + h) * 64;
            for (int s = PAST - 1; s >= 0; --s) { const f32x4* kp = (const f32x4*)(ck + (size_t)s * SBW + vz); const f32x4* vp = (const f32x4*)(cv + (size_t)s * SBW + vz);
                float z = 0.f;
#pragma unroll
                for (int c = 0; c < 16; ++c) { const f32x4 x = kp[c]; z += q[4 * c] * x.x + q[4 * c + 1] * x.y + q[4 * c + 2] * x.z + q[4 * c + 3] * x.w; }
                const float e = fexp2(z), rr = frcp(1.0f + e), beta = 1.0f - rr; const float w = beta * carry; carry *= rr;
#pragma unroll
                for (int c = 0; c < 16; ++c) { const f32x4 x = vp[c]; o[4 * c] += w * x.x; o[4 * c + 1] += w * x.y; o[4 * c + 2] += w * x.z; o[4 * c + 3] += w * x.w; }
            }
        }
        if (!samp || lane < 32) { v4u* op = (v4u*)(OSB + (size_t)qrow * SBW + h * 64);
#pragma unroll
            for (int c = 0; c < 8; ++c) op[c] = pack8((f32x4){o[8 * c], o[8 * c + 1], o[8 * c + 2], o[8 * c + 3]}, (f32x4){o[8 * c + 4], o[8 * c + 5], o[8 * c + 6], o[8 * c + 7]}); }
    }
}
__device__ __forceinline__ void naive_mla(CArgs a, int L, int vcu, int G, int wave, int lane) {
    const int gw = vcu * 8 + wave, NGW = G * 8;
    const bf16* QLAT = (const bf16*)(a->ws + WS_QLAT); const bf16* QROPE = (const bf16*)(a->ws + WS_QROPE); const bf16* CKVB = (const bf16*)(a->ws + WS_CKVB); const bf16* KRB = (const bf16*)(a->ws + WS_KRB);
    bf16* OLAT = (bf16*)(a->ws + WS_OLAT);
    for (int it = gw + (FAST_MLA ? PR * NHEAD : 0); it < (FAST_SMLA ? PR : R) * NHEAD; it += NGW) { const int row = it >> 3, h = it & 7; const bool samp = row >= PR;
        const unsigned qw = *(const unsigned*)(QLAT + (size_t)row * QLW + h * 128 + 2 * lane); const float q0 = lo2f(qw), q1 = hi2f(qw);
        const float qr = lane < 32 ? bf2f(QROPE[(size_t)row * QRW + h * 32 + lane]) : 0.f;
        int rowbase, nk; if (!samp) { rowbase = row & ~(SEQ - 1); nk = 64 * (((row & (SEQ - 1)) >> 6) + 1); } else { rowbase = PR + (((row - PR) >> 5) << 5); nk = DSEQ; }
        float m = -INFINITY, l = 0.f, o0 = 0.f, o1 = 0.f;
        for (int s = 0; s < nk; s += 4) { float sc[4], c0[4], c1[4];
#pragma unroll
            for (int j = 0; j < 4; ++j) { const size_t kr = (size_t)(rowbase + s + j); const unsigned cw = *(const unsigned*)(CKVB + kr * LORA + 2 * lane); c0[j] = lo2f(cw); c1[j] = hi2f(cw);
                const float r = lane < 32 ? bf2f(KRB[kr * ROPE + lane]) : 0.f; sc[j] = q0 * c0[j] + q1 * c1[j] + qr * r; }
#pragma unroll
            for (int off = 1; off < 64; off <<= 1) {
#pragma unroll
                for (int j = 0; j < 4; ++j) sc[j] += __shfl_xor(sc[j], off); }
#pragma unroll
            for (int j = 0; j < 4; ++j) { const float mn = fmaxf(m, sc[j]), al = fexp2(m - mn), p = fexp2(sc[j] - mn); l = l * al + p; o0 = o0 * al + p * c0[j]; o1 = o1 * al + p * c1[j]; m = mn; }
        }
        if (samp) { const int b = (row - PR) >> 5; const float* cc = a->in[6] + ((size_t)L * DBATCH + b) * PAST * LORA; const float* cr = a->in[7] + ((size_t)L * DBATCH + b) * PAST * ROPE; const int ri = ridx(lane & 31);
            for (int s = 0; s < PAST; s += 4) { float sc[4], c0[4], c1[4];
#pragma unroll
                for (int j = 0; j < 4; ++j) { const float2 cv = *(const float2*)(cc + (size_t)(s + j) * LORA + 2 * lane); c0[j] = cv.x; c1[j] = cv.y;
                    const float r = lane < 32 ? cr[(size_t)(s + j) * ROPE + ri] : 0.f; sc[j] = q0 * c0[j] + q1 * c1[j] + qr * r; }
#pragma unroll
                for (int off = 1; off < 64; off <<= 1) {
#pragma unroll
                    for (int j = 0; j < 4; ++j) sc[j] += __shfl_xor(sc[j], off); }
#pragma unroll
                for (int j = 0; j < 4; ++j) { const float mn = fmaxf(m, sc[j]), al = fexp2(m - mn), p = fexp2(sc[j] - mn); l = l * al + p; o0 = o0 * al + p * c0[j]; o1 = o1 * al + p * c1[j]; m = mn; }
            } }
        const float il = 1.0f / l;
        *(unsigned*)(OLAT + (size_t)row * QLW + h * 128 + 2 * lane) = pg8::cvt_pk_bf16(o0 * il, o1 * il);
    }
}


typedef float f32x16 __attribute__((ext_vector_type(16)));
typedef short s16x4 __attribute__((ext_vector_type(4)));
typedef short v4i16_t __attribute__((ext_vector_type(4)));
__device__ __forceinline__ int crow(int r, int hi) { return (r & 3) + 8 * (r >> 2) + 4 * hi; }
__device__ __forceinline__ s16x4 vtr(LAS unsigned char* p) { return __builtin_bit_cast(s16x4, __builtin_amdgcn_ds_read_tr16_b64_v4i16((LAS v4i16_t*)p)); }
__device__ __forceinline__ bf16x8 cat8(s16x4 lo, s16x4 hi) { return (bf16x8){lo[0], lo[1], lo[2], lo[3], hi[0], hi[1], hi[2], hi[3]}; }
__device__ __forceinline__ bf16x8 pk8(const f32x16& w, int b) { v4u u; u.x = pg8::cvt_pk_bf16_c(w[b], w[b + 1]); u.y = pg8::cvt_pk_bf16_c(w[b + 2], w[b + 3]); u.z = pg8::cvt_pk_bf16_c(w[b + 4], w[b + 5]); u.w = pg8::cvt_pk_bf16_c(w[b + 6], w[b + 7]); return __builtin_bit_cast(bf16x8, u); }
#define ATT_WAITBAR() do { asm volatile("s_waitcnt vmcnt(0) lgkmcnt(0)" ::: "memory"); __builtin_amdgcn_s_barrier(); asm volatile("" ::: "memory"); } while (0)

#ifndef SB_EARLY
#define SB_EARLY 1
#endif
constexpr float SB_TINY = 7.8886090522101181e-31f;
constexpr int SBA_K = 0, SBA_V = 16384, SBA_ST = 32768, SBA_FL = 65536;
__device__ __forceinline__ void sb_unit(const bf16* QSB, const bf16* KSB, const bf16* VSB, bf16* OSB, int rowbase, int h, int qb, LAS unsigned char* lds, int wave, int lane) {
    const int r32 = lane & 31, hi = lane >> 5; const int q0 = qb * 256, rowmin = q0 + 32 * wave, NT = 4 * qb + 4;
    const bf16* ksrc = KSB + (size_t)(rowbase + lane) * SBW + h * 64 + wave * 8;
    const bf16* vsrc = VSB + (size_t)(rowbase + 16 * (wave & 3) + (lane >> 2)) * SBW + h * 64 + (wave >> 2) * 32 + (lane & 3) * 8;
#define SB_DMA(j, bsel) do { __builtin_amdgcn_global_load_lds((const unsigned*)(ksrc + (size_t)(j) * 64 * SBW), (LAS unsigned*)(lds + SBA_K + (bsel) * 8192 + wave * 1024), 16, 0, 0); \
                             __builtin_amdgcn_global_load_lds((const unsigned*)(vsrc + (size_t)(j) * 64 * SBW), (LAS unsigned*)(lds + SBA_V + (bsel) * 8192 + wave * 1024), 16, 0, 0); } while (0)
    SB_DMA(NT - 1, 0);
    bf16x8 qr[4]; { const bf16* qp = QSB + (size_t)(rowbase + rowmin + r32) * SBW + h * 64 + hi * 8;
#pragma unroll
        for (int d0 = 0; d0 < 4; ++d0) qr[d0] = *(const bf16x8*)(qp + d0 * 16); }
    f32x16 o0 = {}, o1 = {}; float carry = 1.0f; bool wdone = false;
    ATT_WAITBAR();
    for (int it = 0; it < NT; ++it) { const int jt = NT - 1 - it, cur = it & 1;
        if (jt > 0) SB_DMA(jt - 1, cur ^ 1);
        const int kmin = 64 * jt;
        if (kmin < rowmin + 32 && !(SB_EARLY && wdone)) {
            LAS unsigned char* Kb = lds + SBA_K + cur * 8192 + hi * 1024 + r32 * 16;
            f32x16 p0 = {}, p1 = {};
#pragma unroll
            for (int d0 = 0; d0 < 4; ++d0) { const bf16x8 b0 = *(LAS bf16x8*)(Kb + d0 * 2048), b1 = *(LAS bf16x8*)(Kb + d0 * 2048 + 512);
                p0 = __builtin_amdgcn_mfma_f32_32x32x16_bf16(b0, qr[d0], p0, 0, 0, 0); p1 = __builtin_amdgcn_mfma_f32_32x32x16_bf16(b1, qr[d0], p1, 0, 0, 0); }
            if (kmin + 64 > rowmin) {
                const int t = rowmin + r32, kb = kmin + 4 * hi;
#pragma unroll
                for (int r = 0; r < 16; ++r) { const int kv = kb + (r & 3) + 8 * (r >> 2); if (kv >= t) p0[r] = -INFINITY; if (kv + 32 >= t) p1[r] = -INFINITY; }
            }
#pragma unroll
            for (int r = 0; r < 16; ++r) { p0[r] = frcp(1.0f + fexp2(p0[r])); p1[r] = frcp(1.0f + fexp2(p1[r])); }
            float GA[8];
#pragma unroll
            for (int k = 0; k < 4; ++k) { GA[k] = (p0[4 * k] * p0[4 * k + 1]) * (p0[4 * k + 2] * p0[4 * k + 3]); GA[4 + k] = (p1[4 * k] * p1[4 * k + 1]) * (p1[4 * k + 2] * p1[4 * k + 3]); }
            float SG[8]; float T = carry;
#pragma unroll
            for (int kk = 7; kk >= 0; --kk) { const auto sw = __builtin_amdgcn_permlane32_swap(__float_as_uint(GA[kk]), __float_as_uint(GA[kk]), false, false);
                const float G0 = __uint_as_float(sw[0]), G1 = __uint_as_float(sw[1]);
                const float s1 = T; T *= G1; const float s0 = T; T *= G0; SG[kk] = hi ? s1 : s0; }
            carry = T;
            f32x16 w0, w1;
#pragma unroll
            for (int k = 0; k < 4; ++k) {
                { float t = SG[k]; w0[4 * k + 3] = t * (1.0f - p0[4 * k + 3]); t *= p0[4 * k + 3]; w0[4 * k + 2] = t * (1.0f - p0[4 * k + 2]); t *= p0[4 * k + 2];
                  w0[4 * k + 1] = t * (1.0f - p0[4 * k + 1]); t *= p0[4 * k + 1]; w0[4 * k] = t * (1.0f - p0[4 * k]); }
                { float t = SG[4 + k]; w1[4 * k + 3] = t * (1.0f - p1[4 * k + 3]); t *= p1[4 * k + 3]; w1[4 * k + 2] = t * (1.0f - p1[4 * k + 2]); t *= p1[4 * k + 2];
                  w1[4 * k + 1] = t * (1.0f - p1[4 * k + 1]); t *= p1[4 * k + 1]; w1[4 * k] = t * (1.0f - p1[4 * k]); } }
            const bf16x8 pa0 = pk8(w0, 0), pa1 = pk8(w0, 8), pa2 = pk8(w1, 0), pa3 = pk8(w1, 8);
            LAS unsigned char* vb = lds + SBA_V + cur * 8192 + ((lane >> 4) & 1) * 32 + (lane & 3) * 8 + (4 * hi + ((lane & 15) >> 2)) * 64;
#pragma unroll
            for (int ks = 0; ks < 4; ++ks) { const bf16x8 pa = ks == 0 ? pa0 : ks == 1 ? pa1 : ks == 2 ? pa2 : pa3;
                const bf16x8 v0 = cat8(vtr(vb + ks * 1024), vtr(vb + ks * 1024 + 512)), v1 = cat8(vtr(vb + 4096 + ks * 1024), vtr(vb + 4096 + ks * 1024 + 512));
                o0 = __builtin_amdgcn_mfma_f32_32x32x16_bf16(pa, v0, o0, 0, 0, 0); o1 = __builtin_amdgcn_mfma_f32_32x32x16_bf16(pa, v1, o1, 0, 0, 0); }
        }
#if SB_EARLY
        wdone = __all(carry < SB_TINY);
        { LAS unsigned* fl = (LAS unsigned*)(lds + SBA_FL) + (it & 1) * 8; if (lane == 0) fl[wave] = wdone ? 1u : 0u;
          ATT_WAITBAR();
          const unsigned f = (fl[0] & fl[1]) & (fl[2] & fl[3]) & (fl[4] & fl[5]) & (fl[6] & fl[7]);
          if (f) break; }
#else
        ATT_WAITBAR();
#endif
    }
#undef SB_DMA
    { LAS unsigned short* stg = (LAS unsigned short*)(lds + SBA_ST + wave * 4096);
#pragma unroll
        for (int r = 0; r < 16; ++r) { const int orow = crow(r, hi); stg[orow * 64 + r32] = (unsigned short)f2bf(o0[r]); stg[orow * 64 + 32 + r32] = (unsigned short)f2bf(o1[r]); }
        asm volatile("s_waitcnt lgkmcnt(0)" ::: "memory");
        bf16* op = OSB + (size_t)(rowbase + rowmin) * SBW + h * 64;
#pragma unroll
        for (int i = 0; i < 4; ++i) { const int row = i * 8 + (lane >> 3), ch = lane & 7; const v4u v = *(LAS v4u*)(stg + row * 64 + ch * 8); *(v4u*)(op + (size_t)row * SBW + ch * 8) = v; }
        asm volatile("s_waitcnt lgkmcnt(0)" ::: "memory");
    }
}
__device__ __forceinline__ void sb_prompt(CArgs a, LAS unsigned char* lds, int vcu, int G, int wave, int lane) {
    const bf16* QSB = (const bf16*)(a->ws + WS_QSB); const bf16* KSB = (const bf16*)(a->ws + WS_KSB); const bf16* VSB = (const bf16*)(a->ws + WS_VSB); bf16* OSB = (bf16*)(a->ws + WS_OSB);
    for (int u = vcu; u < NB * NHEAD * 8; u += G) { const int i = u >> 8, v = u & 255, bh = v >> 1, s = v & 1; const int qb = i == 0 ? s : i == 1 ? 7 - s : i == 2 ? 2 + s : 5 - s;
        sb_unit(QSB, KSB, VSB, OSB, (bh >> 3) * SEQ, bh & 7, qb, lds, wave, lane); }
}

constexpr int MLA_K = 0, MLA_V = 40960, MLA_WS = 73728, MLA_ST = 0;
__device__ __forceinline__ void mla_unit(const bf16* QLAT, const bf16* QROPE, const bf16* CKVB, const bf16* KRB, bf16* OLAT, int rowbase, int qb32, LAS unsigned char* lds, int wave, int lane) {
    const int r32 = lane & 31, hi = lane >> 5, h = wave; const int NT = (qb32 >> 1) + 1; const int qrow = rowbase + 32 * qb32;
    const bf16* kc0 = CKVB + (size_t)(rowbase + lane) * LORA + wave * 8;
    const bf16* kr0 = KRB + (size_t)(rowbase + lane) * ROPE + (wave & 3) * 8;
    const bf16* vs0 = CKVB + (size_t)(rowbase + 16 * (wave & 3) + (lane >> 2)) * LORA + (wave >> 2) * 32 + (lane & 3) * 8;
#define MLA_DMA(j, bsel) do { LAS unsigned char* kd = lds + MLA_K + (bsel) * 20480; LAS unsigned char* vd = lds + MLA_V + (bsel) * 16384; \
        __builtin_amdgcn_global_load_lds((const unsigned*)(kc0 + (size_t)(j) * 64 * LORA), (LAS unsigned*)(kd + wave * 1024), 16, 0, 0); \
        __builtin_amdgcn_global_load_lds((const unsigned*)(kc0 + (size_t)(j) * 64 * LORA + 64), (LAS unsigned*)(kd + (wave + 8) * 1024), 16, 0, 0); \
        if (wave < 4) __builtin_amdgcn_global_load_lds((const unsigned*)(kr0 + (size_t)(j) * 64 * ROPE), (LAS unsigned*)(kd + (16 + wave) * 1024), 16, 0, 0); \
        __builtin_amdgcn_global_load_lds((const unsigned*)(vs0 + (size_t)(j) * 64 * LORA), (LAS unsigned*)(vd + wave * 1024), 16, 0, 0); \
        __builtin_amdgcn_global_load_lds((const unsigned*)(vs0 + (size_t)(j) * 64 * LORA + 64), (LAS unsigned*)(vd + (wave + 8) * 1024), 16, 0, 0); } while (0)
    MLA_DMA(0, 0);
    bf16x8 qr[10]; { const bf16* qp = QLAT + (size_t)(qrow + r32) * QLW + h * 128 + hi * 8; const bf16* rp = QROPE + (size_t)(qrow + r32) * QRW + h * 32 + hi * 8;
#pragma unroll
        for (int d0 = 0; d0 < 8; ++d0) qr[d0] = *(const bf16x8*)(qp + d0 * 16);
        qr[8] = *(const bf16x8*)rp; qr[9] = *(const bf16x8*)(rp + 16); }
    f32x16 o[4]; o[0] = f32x16{}; o[1] = f32x16{}; o[2] = f32x16{}; o[3] = f32x16{};
    float m = -INFINITY, l = 0.f; LAS float* wsf = (LAS float*)(lds + MLA_WS) + wave * 64;
    ATT_WAITBAR();
    for (int jt = 0; jt < NT; ++jt) { const int cur = jt & 1;
        if (jt + 1 < NT) MLA_DMA(jt + 1, cur ^ 1);
        LAS unsigned char* Kb = lds + MLA_K + cur * 20480 + hi * 1024 + r32 * 16;
        f32x16 p0 = {}, p1 = {};
#pragma unroll
        for (int d0 = 0; d0 < 10; ++d0) { const bf16x8 b0 = *(LAS bf16x8*)(Kb + d0 * 2048), b1 = *(LAS bf16x8*)(Kb + d0 * 2048 + 512);
            p0 = __builtin_amdgcn_mfma_f32_32x32x16_bf16(b0, qr[d0], p0, 0, 0, 0); p1 = __builtin_amdgcn_mfma_f32_32x32x16_bf16(b1, qr[d0], p1, 0, 0, 0); }
        float mx = fmaxf(p0[0], p1[0]);
#pragma unroll
        for (int r = 1; r < 16; ++r) mx = fmaxf(mx, fmaxf(p0[r], p1[r]));
        { const auto sw = __builtin_amdgcn_permlane32_swap(__float_as_uint(mx), __float_as_uint(mx), false, false); mx = fmaxf(__uint_as_float(sw[0]), __uint_as_float(sw[1])); }
        const float mn = fmaxf(m, mx), al = fexp2(m - mn); m = mn;
        float ps = 0.f;
#pragma unroll
        for (int r = 0; r < 16; ++r) { p0[r] = fexp2(p0[r] - mn); p1[r] = fexp2(p1[r] - mn); ps += p0[r] + p1[r]; }
        l = l * al + ps;
        if (__any(al != 1.0f)) {
            if (hi == 0) wsf[r32] = al;
            asm volatile("s_waitcnt lgkmcnt(0)" ::: "memory");
#pragma unroll
            for (int r = 0; r < 16; ++r) { const float f = wsf[crow(r, hi)]; o[0][r] *= f; o[1][r] *= f; o[2][r] *= f; o[3][r] *= f; }
        }
        const bf16x8 pa0 = pk8(p0, 0), pa1 = pk8(p0, 8), pa2 = pk8(p1, 0), pa3 = pk8(p1, 8);
        LAS unsigned char* vb = lds + MLA_V + cur * 16384 + ((lane >> 4) & 1) * 32 + (lane & 3) * 8 + (4 * hi + ((lane & 15) >> 2)) * 64;
#pragma unroll
        for (int ks = 0; ks < 4; ++ks) { const bf16x8 pa = ks == 0 ? pa0 : ks == 1 ? pa1 : ks == 2 ? pa2 : pa3;
#pragma unroll
            for (int d0 = 0; d0 < 4; ++d0) { const bf16x8 vf = cat8(vtr(vb + d0 * 4096 + ks * 1024), vtr(vb + d0 * 4096 + ks * 1024 + 512)); o[d0] = __builtin_amdgcn_mfma_f32_32x32x16_bf16(pa, vf, o[d0], 0, 0, 0); } }
        ATT_WAITBAR();
    }
#undef MLA_DMA
    { const auto sw = __builtin_amdgcn_permlane32_swap(__float_as_uint(l), __float_as_uint(l), false, false); l = __uint_as_float(sw[0]) + __uint_as_float(sw[1]); }
    if (hi == 0) wsf[r32] = 1.0f / l;
    asm volatile("s_waitcnt lgkmcnt(0)" ::: "memory");
    { LAS unsigned short* stg = (LAS unsigned short*)(lds + MLA_ST + wave * 8192);
#pragma unroll
        for (int r = 0; r < 16; ++r) { const int orow = crow(r, hi); const float f = wsf[orow];
#pragma unroll
            for (int d0 = 0; d0 < 4; ++d0) stg[orow * 128 + d0 * 32 + r32] = (unsigned short)f2bf(o[d0][r] * f); }
        asm volatile("s_waitcnt lgkmcnt(0)" ::: "memory");
        bf16* op = OLAT + (size_t)qrow * QLW + h * 128;
#pragma unroll
        for (int i = 0; i < 8; ++i) { const int row = i * 4 + (lane >> 4), ch = lane & 15; const v4u v = *(LAS v4u*)(stg + row * 128 + ch * 8); *(v4u*)(op + (size_t)row * QLW + ch * 8) = v; }
    }
    ATT_WAITBAR();
}
__device__ __forceinline__ void mla_prompt(CArgs a, LAS unsigned char* lds, int vcu, int G, int wave, int lane) {
    const bf16* QLAT = (const bf16*)(a->ws + WS_QLAT); const bf16* QROPE = (const bf16*)(a->ws + WS_QROPE); const bf16* CKVB = (const bf16*)(a->ws + WS_CKVB); const bf16* KRB = (const bf16*)(a->ws + WS_KRB); bf16* OLAT = (bf16*)(a->ws + WS_OLAT);
    for (int u = vcu; u < NB * 64; u += G) { const int i = u >> 8, v = u & 255, b = v >> 4, s = v & 15; const int qb32 = i == 0 ? s : i == 1 ? 63 - s : i == 2 ? 16 + s : 47 - s;
        mla_unit(QLAT, QROPE, CKVB, KRB, OLAT, b * SEQ, qb32, lds, wave, lane); }
}


constexpr int SSB_V = 0, SSB_T = 65536, SSB_F = 65536 + 2048;
__device__ __forceinline__ bf16x8 cvt8(f32x4 a, f32x4 b) { return __builtin_bit_cast(bf16x8, pack8c(a, b)); }
__device__ __forceinline__ void ssb_unit(CArgs a, int L, int b, int h, LAS unsigned char* lds, int wave, int lane) {
    const int r32 = lane & 31, hi = lane >> 5; const int rowbase = PR + b * DSEQ;
    const bf16* QSB = (const bf16*)(a->ws + WS_QSB); const bf16* KSB = (const bf16*)(a->ws + WS_KSB); const bf16* VSB = (const bf16*)(a->ws + WS_VSB); bf16* OSB = (bf16*)(a->ws + WS_OSB);
    const float* ck = a->in[4] + ((((size_t)L * DBATCH + b) * PAST) * NHEAD + h) * 64; const float* cv = a->in[5] + ((((size_t)L * DBATCH + b) * PAST) * NHEAD + h) * 64;
    bf16x8 qr[4]; { const bf16* qp = QSB + (size_t)(rowbase + r32) * SBW + h * 64 + hi * 8;
#pragma unroll
        for (int d0 = 0; d0 < 4; ++d0) qr[d0] = *(const bf16x8*)(qp + d0 * 16); }
    f32x16 o0 = {}, o1 = {}; float cacc = 1.0f;
    LAS unsigned char* vreg = lds + SSB_V + wave * 8192; LAS float* Tx = (LAS float*)(lds + SSB_T);
    for (int rd = 0; rd < 9; ++rd) { const int ut = 57 - 8 * rd + wave;
        f32x16 w0 = {}, w1 = {}; float T = 1.0f;
        if (ut >= 0) {
            bf16x8 kf[8];
            if (ut == 64) {
#pragma unroll
                for (int d0 = 0; d0 < 4; ++d0) { kf[2 * d0] = *(const bf16x8*)(KSB + (size_t)(rowbase + r32) * SBW + h * 64 + d0 * 16 + hi * 8); kf[2 * d0 + 1] = (bf16x8){0, 0, 0, 0, 0, 0, 0, 0}; }
                const v4u z4 = {0u, 0u, 0u, 0u};
#pragma unroll
                for (int pc = 0; pc < 8; ++pc) { v4u x = z4; if (lane < 32) x = *(const v4u*)(VSB + (size_t)(rowbase + lane) * SBW + h * 64 + pc * 8);
                    *(LAS v4u*)(vreg + (pc >> 2) * 4096 + lane * 64 + (pc & 3) * 16) = x; }
            } else {
                const float* kp = ck + (size_t)(64 * ut + r32) * SBW + hi * 8; const float* vp = cv + (size_t)(64 * ut + lane) * SBW;
                f32x4 kx[16], vx[16];
#pragma unroll
                for (int d0 = 0; d0 < 4; ++d0) { kx[4 * d0] = *(const f32x4*)(kp + d0 * 16); kx[4 * d0 + 1] = *(const f32x4*)(kp + d0 * 16 + 4);
                    kx[4 * d0 + 2] = *(const f32x4*)(kp + (size_t)32 * SBW + d0 * 16); kx[4 * d0 + 3] = *(const f32x4*)(kp + (size_t)32 * SBW + d0 * 16 + 4); }
#pragma unroll
                for (int i = 0; i < 16; ++i) vx[i] = *(const f32x4*)(vp + 4 * i);
#pragma unroll
                for (int d0 = 0; d0 < 4; ++d0) { kf[2 * d0] = cvt8(kx[4 * d0], kx[4 * d0 + 1]); kf[2 * d0 + 1] = cvt8(kx[4 * d0 + 2], kx[4 * d0 + 3]); }
#pragma unroll
                for (int pc = 0; pc < 8; ++pc) *(LAS v4u*)(vreg + (pc >> 2) * 4096 + lane * 64 + (pc & 3) * 16) = pack8c(vx[2 * pc], vx[2 * pc + 1]);
            }
            f32x16 p0 = {}, p1 = {};
#pragma unroll
            for (int d0 = 0; d0 < 4; ++d0) { p0 = __builtin_amdgcn_mfma_f32_32x32x16_bf16(kf[2 * d0], qr[d0], p0, 0, 0, 0); p1 = __builtin_amdgcn_mfma_f32_32x32x16_bf16(kf[2 * d0 + 1], qr[d0], p1, 0, 0, 0); }
            if (ut == 64) {
#pragma unroll
                for (int r = 0; r < 16; ++r) { const int kv = 4 * hi + (r & 3) + 8 * (r >> 2); if (kv >= r32) p0[r] = -INFINITY; p1[r] = -INFINITY; }
            }
#pragma unroll
            for (int r = 0; r < 16; ++r) { p0[r] = frcp(1.0f + fexp2(p0[r])); p1[r] = frcp(1.0f + fexp2(p1[r])); }
            float GA[8];
#pragma unroll
            for (int k = 0; k < 4; ++k) { GA[k] = (p0[4 * k] * p0[4 * k + 1]) * (p0[4 * k + 2] * p0[4 * k + 3]); GA[4 + k] = (p1[4 * k] * p1[4 * k + 1]) * (p1[4 * k + 2] * p1[4 * k + 3]); }
            float SG[8];
#pragma unroll
            for (int kk = 7; kk >= 0; --kk) { const auto sw = __builtin_amdgcn_permlane32_swap(__float_as_uint(GA[kk]), __float_as_uint(GA[kk]), false, false);
                const float G0 = __uint_as_float(sw[0]), G1 = __uint_as_float(sw[1]); const float s1 = T; T *= G1; const float s0 = T; T *= G0; SG[kk] = hi ? s1 : s0; }
#pragma unroll
            for (int k = 0; k < 4; ++k) {
                { float t = SG[k]; w0[4 * k + 3] = t * (1.0f - p0[4 * k + 3]); t *= p0[4 * k + 3]; w0[4 * k + 2] = t * (1.0f - p0[4 * k + 2]); t *= p0[4 * k + 2];
                  w0[4 * k + 1] = t * (1.0f - p0[4 * k + 1]); t *= p0[4 * k + 1]; w0[4 * k] = t * (1.0f - p0[4 * k]); }
                { float t = SG[4 + k]; w1[4 * k + 3] = t * (1.0f - p1[4 * k + 3]); t *= p1[4 * k + 3]; w1[4 * k + 2] = t * (1.0f - p1[4 * k + 2]); t *= p1[4 * k + 2];
                  w1[4 * k + 1] = t * (1.0f - p1[4 * k + 1]); t *= p1[4 * k + 1]; w1[4 * k] = t * (1.0f - p1[4 * k]); } }
        }
        LAS float* Tr = Tx + (rd & 1) * 256;
        if (hi == 0) Tr[wave * 32 + r32] = T;
        asm volatile("s_waitcnt lgkmcnt(0)" ::: "memory"); __builtin_amdgcn_s_barrier(); asm volatile("" ::: "memory");
        float F = cacc, all = cacc;
#pragma unroll
        for (int w2 = 7; w2 >= 0; --w2) { const float tv = Tr[w2 * 32 + r32]; all *= tv; if (w2 > wave) F *= tv; }
        cacc = all;
        if (ut >= 0) {
#pragma unroll
            for (int r = 0; r < 16; ++r) { w0[r] *= F; w1[r] *= F; }
            const bf16x8 pa0 = pk8(w0, 0), pa1 = pk8(w0, 8), pa2 = pk8(w1, 0), pa3 = pk8(w1, 8);
            LAS unsigned char* vb = vreg + ((lane >> 4) & 1) * 32 + (lane & 3) * 8 + (4 * hi + ((lane & 15) >> 2)) * 64;
#pragma unroll
            for (int ks = 0; ks < 4; ++ks) { const bf16x8 pa = ks == 0 ? pa0 : ks == 1 ? pa1 : ks == 2 ? pa2 : pa3;
                const bf16x8 v0 = cat8(vtr(vb + ks * 1024), vtr(vb + ks * 1024 + 512)), v1 = cat8(vtr(vb + 4096 + ks * 1024), vtr(vb + 4096 + ks * 1024 + 512));
                o0 = __builtin_amdgcn_mfma_f32_32x32x16_bf16(pa, v0, o0, 0, 0, 0); o1 = __builtin_amdgcn_mfma_f32_32x32x16_bf16(pa, v1, o1, 0, 0, 0); }
            asm volatile("s_waitcnt lgkmcnt(0)" ::: "memory");
        }
#if SB_EARLY
        if (__all(cacc < SB_TINY)) break;
#endif
    }
    __builtin_amdgcn_s_barrier(); asm volatile("" ::: "memory");
    { LAS float* po = (LAS float*)(lds + SSB_V + wave * 8192);
#pragma unroll
        for (int r = 0; r < 16; ++r) { const int q = crow(r, hi); po[q * 64 + r32] = o0[r]; po[q * 64 + 32 + r32] = o1[r]; } }
    asm volatile("s_waitcnt lgkmcnt(0)" ::: "memory"); __builtin_amdgcn_s_barrier(); asm volatile("" ::: "memory");
    { const int t = wave * 64 + lane, q = t >> 4, d4 = (t & 15) * 4; f32x4 s = {0.f, 0.f, 0.f, 0.f};
#pragma unroll
        for (int w2 = 0; w2 < 8; ++w2) s += *(LAS f32x4*)(lds + SSB_V + w2 * 8192 + (q * 64 + d4) * 4);
        unsigned long long pk = (unsigned long long)pg8::cvt_pk_bf16_c(s[0], s[1]) | ((unsigned long long)pg8::cvt_pk_bf16_c(s[2], s[3]) << 32);
        *(unsigned long long*)(OSB + (size_t)(rowbase + q) * SBW + h * 64 + d4) = pk; }
    asm volatile("s_waitcnt lgkmcnt(0)" ::: "memory"); __builtin_amdgcn_s_barrier(); asm volatile("" ::: "memory");
}
__device__ __forceinline__ void sb_sample(CArgs a, int L, LAS unsigned char* lds, int vcu, int G, int wave, int lane) {
    for (int u = vcu; u < DBATCH * NHEAD; u += G) ssb_unit(a, L, u >> 3, u & 7, lds, wave, lane);
}


constexpr size_t WS_PO = 1546 * MiB, WS_PML = 1580 * MiB, WS_SLAB = 1581 * MiB, WS_END2 = 1626 * MiB;
static_assert(WS_PO >= WS_END && WS_PO + (size_t)DBATCH * 8 * NHEAD * DSEQ * LORA * 4 <= WS_PML && WS_PML + (size_t)DBATCH * 8 * NHEAD * DSEQ * 2 * 4 <= WS_SLAB && WS_SLAB + 11 * (size_t)SR * DM * 4 <= WS_END2, "partials map");
__device__ __forceinline__ void smla_unit(CArgs a, int L, int b, int sp, LAS unsigned char* lds, int wave, int lane) {
    const int r32 = lane & 31, hi = lane >> 5, h = wave; const int NT = sp == 7 ? 9 : 8; const int qrow = PR + b * DSEQ;
    const bf16* QLAT = (const bf16*)(a->ws + WS_QLAT); const bf16* QROPE = (const bf16*)(a->ws + WS_QROPE); const bf16* CKVB = (const bf16*)(a->ws + WS_CKVB); const bf16* KRB = (const bf16*)(a->ws + WS_KRB);
    const float* cc = a->in[6] + ((size_t)L * DBATCH + b) * PAST * LORA + (size_t)sp * 512 * LORA; const float* cr = a->in[7] + ((size_t)L * DBATCH + b) * PAST * ROPE + (size_t)sp * 512 * ROPE;
    f32x4 st[6];
#define SM_LOAD(j) do { if ((j) < 8) { const float* p = cc + (unsigned)(((j) * 64 + lane) * LORA + wave * 8); st[0] = *(const f32x4*)p; st[1] = *(const f32x4*)(p + 4); st[2] = *(const f32x4*)(p + 64); st[3] = *(const f32x4*)(p + 68); \
            if (wave < 4) { const float* q = cr + (unsigned)(((j) * 64 + lane) * ROPE + 4 * wave); st[4] = *(const f32x4*)q; st[5] = *(const f32x4*)(q + 16); } } \
        else { st[0] = st[1] = st[2] = (f32x4){0.f, 0.f, 0.f, 0.f}; if (lane < 32) { const bf16* p = CKVB + (size_t)(qrow + lane) * LORA + wave * 8; st[0] = *(const f32x4*)p; st[1] = *(const f32x4*)(p + 64); \
            if (wave < 4) st[2] = *(const f32x4*)(KRB + (size_t)(qrow + lane) * ROPE + wave * 8); } } } while (0)
#define SM_STORE(j, bsel) do { LAS unsigned char* kd = lds + MLA_K + (bsel) * 20480; LAS unsigned char* vd = lds + MLA_V + (bsel) * 16384; v4u x0, x1, x2; \
        if ((j) < 8) { x0 = pack8c(st[0], st[1]); x1 = pack8c(st[2], st[3]); x2 = pack8c(st[4], st[5]); } else { x0 = __builtin_bit_cast(v4u, st[0]); x1 = __builtin_bit_cast(v4u, st[1]); x2 = __builtin_bit_cast(v4u, st[2]); } \
        *(LAS v4u*)(kd + wave * 1024 + lane * 16) = x0; *(LAS v4u*)(kd + (wave + 8) * 1024 + lane * 16) = x1; if (wave < 4) *(LAS v4u*)(kd + (16 + wave) * 1024 + lane * 16) = x2; \
        *(LAS v4u*)(vd + (wave >> 2) * 4096 + lane * 64 + (wave & 3) * 16) = x0; *(LAS v4u*)(vd + ((wave + 8) >> 2) * 4096 + lane * 64 + (wave & 3) * 16) = x1; } while (0)
    SM_LOAD(0);
    bf16x8 qr[10]; { const bf16* qp = QLAT + (size_t)(qrow + r32) * QLW + h * 128 + hi * 8; const bf16* rp = QROPE + (size_t)(qrow + r32) * QRW + h * 32 + hi * 8;
#pragma unroll
        for (int d0 = 0; d0 < 8; ++d0) qr[d0] = *(const bf16x8*)(qp + d0 * 16);
        qr[8] = *(const bf16x8*)rp; qr[9] = *(const bf16x8*)(rp + 16); }
    SM_STORE(0, 0);
    f32x16 o[4]; o[0] = f32x16{}; o[1] = f32x16{}; o[2] = f32x16{}; o[3] = f32x16{};
    float m = -INFINITY, l = 0.f; LAS float* wsf = (LAS float*)(lds + MLA_WS) + wave * 64;
    ATT_WAITBAR();
    for (int jt = 0; jt < NT; ++jt) { const int cur = jt & 1;
        LAS unsigned char* Kb = lds + MLA_K + cur * 20480 + hi * 1024 + r32 * 16;
        f32x16 p0 = {}, p1 = {};
#pragma unroll
        for (int d0 = 0; d0 < 10; ++d0) { const bf16x8 b0 = *(LAS bf16x8*)(Kb + d0 * 2048), b1 = *(LAS bf16x8*)(Kb + d0 * 2048 + 512);
            p0 = __builtin_amdgcn_mfma_f32_32x32x16_bf16(b0, qr[d0], p0, 0, 0, 0); p1 = __builtin_amdgcn_mfma_f32_32x32x16_bf16(b1, qr[d0], p1, 0, 0, 0); }
        if (jt == 8) {
#pragma unroll
            for (int r = 0; r < 16; ++r) p1[r] = -INFINITY; }
        float mx = fmaxf(p0[0], p1[0]);
#pragma unroll
        for (int r = 1; r < 16; ++r) mx = fmaxf(mx, fmaxf(p0[r], p1[r]));
        { const auto sw = __builtin_amdgcn_permlane32_swap(__float_as_uint(mx), __float_as_uint(mx), false, false); mx = fmaxf(__uint_as_float(sw[0]), __uint_as_float(sw[1])); }
        const float mn = fmaxf(m, mx), al = fexp2(m - mn); m = mn;
        float ps = 0.f;
#pragma unroll
        for (int r = 0; r < 16; ++r) { p0[r] = fexp2(p0[r] - mn); p1[r] = fexp2(p1[r] - mn); ps += p0[r] + p1[r]; }
        l = l * al + ps;
        if (__any(al != 1.0f)) {
            if (hi == 0) wsf[r32] = al;
            asm volatile("s_waitcnt lgkmcnt(0)" ::: "memory");
#pragma unroll
            for (int r = 0; r < 16; ++r) { const float f = wsf[crow(r, hi)]; o[0][r] *= f; o[1][r] *= f; o[2][r] *= f; o[3][r] *= f; }
        }
        const bf16x8 pa0 = pk8(p0, 0), pa1 = pk8(p0, 8), pa2 = pk8(p1, 0), pa3 = pk8(p1, 8);
        if (jt + 1 < NT) SM_LOAD(jt + 1);
        LAS unsigned char* vb = lds + MLA_V + cur * 16384 + ((lane >> 4) & 1) * 32 + (lane & 3) * 8 + (4 * hi + ((lane & 15) >> 2)) * 64;
#pragma unroll
        for (int ks = 0; ks < 4; ++ks) { const bf16x8 pa = ks == 0 ? pa0 : ks == 1 ? pa1 : ks == 2 ? pa2 : pa3;
#pragma unroll
            for (int d0 = 0; d0 < 4; ++d0) { const bf16x8 vf = cat8(vtr(vb + d0 * 4096 + ks * 1024), vtr(vb + d0 * 4096 + ks * 1024 + 512)); o[d0] = __builtin_amdgcn_mfma_f32_32x32x16_bf16(pa, vf, o[d0], 0, 0, 0); } }
        if (jt + 1 < NT) SM_STORE(jt + 1, cur ^ 1);
        ATT_WAITBAR();
    }
#undef SM_LOAD
#undef SM_STORE
    { const auto sw = __builtin_amdgcn_permlane32_swap(__float_as_uint(l), __float_as_uint(l), false, false); l = __uint_as_float(sw[0]) + __uint_as_float(sw[1]); }
    const size_t ub = ((size_t)(b * 8 + sp) * NHEAD + h) * DSEQ;
    float* PO = (float*)(a->ws + WS_PO) + ub * LORA; float* PML = (float*)(a->ws + WS_PML) + ub * 2;
    if (hi == 0) { PML[r32 * 2] = m; PML[r32 * 2 + 1] = l; }
#pragma unroll
    for (int r = 0; r < 16; ++r) { const int q = crow(r, hi);
#pragma unroll
        for (int d0 = 0; d0 < 4; ++d0) PO[(size_t)q * LORA + d0 * 32 + r32] = o[d0][r]; }
}
__device__ __forceinline__ void mla_sample(CArgs a, int L, LAS unsigned char* lds, int vcu, int G, int wave, int lane) {
    for (int u = vcu; u < DBATCH * 8; u += G) smla_unit(a, L, u >> 3, u & 7, lds, wave, lane);
}
__device__ __forceinline__ void smla_combine(CArgs a, int vcu, int G, int wave, int lane) {
    const int gw = vcu * 8 + wave, NGW = G * 8; bf16* OLAT = (bf16*)(a->ws + WS_OLAT); const float* PO = (const float*)(a->ws + WS_PO); const float* PML = (const float*)(a->ws + WS_PML);
    for (int it = gw; it < SR * NHEAD; it += NGW) { const int row = it >> 3, h = it & 7, b = row >> 5, q = row & 31;
        float ms[8], ls[8], M = -INFINITY;
#pragma unroll
        for (int s = 0; s < 8; ++s) { const size_t ub = (((size_t)(b * 8 + s) * NHEAD + h) * DSEQ + q); ms[s] = PML[ub * 2]; ls[s] = PML[ub * 2 + 1]; M = fmaxf(M, ms[s]); }
        float den = 0.f, o0 = 0.f, o1 = 0.f;
#pragma unroll
        for (int s = 0; s < 8; ++s) { const float w = fexp2(ms[s] - M); den += w * ls[s]; const size_t ub = (((size_t)(b * 8 + s) * NHEAD + h) * DSEQ + q);
            const float2 v = *(const float2*)(PO + ub * LORA + 2 * lane); o0 += w * v.x; o1 += w * v.y; }
        const float id = 1.0f / den;
        *(unsigned*)(OLAT + (size_t)(PR + row) * QLW + h * 128 + 2 * lane) = pg8::cvt_pk_bf16(o0 * id, o1 * id);
    }
}

__device__ __forceinline__ int lane_now() { int l; asm volatile("v_mbcnt_lo_u32_b32 %0, -1, 0\n\tv_mbcnt_hi_u32_b32 %0, -1, %0" : "=v"(l)); return l; }
__device__ __forceinline__ int fresh_bx(int bx) { asm volatile("" : "+s"(bx)); return bx; }
__device__ __forceinline__ CArgs fresh_args() { CArgs p = (CArgs)__builtin_amdgcn_kernarg_segment_ptr(); asm volatile("" : "+s"(p)); return p; }
__global__ void __launch_bounds__(512, 2) fwd(Args args_byval) {
    extern __shared__ __attribute__((aligned(16))) unsigned char lds_raw[];
    LAS unsigned char* lds = (LAS unsigned char*)lds_raw;
    volatile LAS unsigned* MISC = (volatile LAS unsigned*)(lds + MISC_OFF);
    const int wave = __builtin_amdgcn_readfirstlane((int)threadIdx.x >> 6);
    const int G = gridDim.x; const int bx = blockIdx.x; const int vcu = (G % 8 == 0) ? (bx % 8) * (G / 8) + bx / 8 : bx;
    if (threadIdx.x < 32) MISC[threadIdx.x] = 0u;
    __syncthreads();
    XcdBarrier bar = xcd_barrier_post((unsigned*)(fresh_args()->ws + WS_CTL) + CW_BAR, MISC + 8);
    const int lo = fresh_args()->ph_lo, hi = fresh_args()->ph_hi;
#define IN(k) (lo <= (k) && (k) < hi)
#define SEAM(k) do { if (IN(k) && IN((k) + 1)) xcd_barrier(bar); } while (0)
#define SEAM_LOCAL(k) do { } while (0)
    const int gw = vcu * 8 + wave, NGW = G * 8;

    if (IN(0)) REP(2) p0_prologue(fresh_args(), lds, vcu, G, fresh_bx(wave), lane_now());
    SEAM(0);
#pragma unroll 1
    for (int L = 0; L < DEPTH; ++L) {
        const int pb = 2 + 12 * L;
        if (IN(pb + 0)) REP(1) {
            CArgs a = fresh_args(); unsigned char* ws = a->ws;
            pg8::Gemm g{(const bf16*)(ws + WS_XN), (const bf16*)(ws + WS_W + (size_t)L * WL + W_IN), R, NIN, DM, DM}; Ord<NIN / 256> S; S.init(G, fresh_bx(bx));
            EpiIn E{ws, a->out, L, a->in[10] + (size_t)L * LORA, (LAS float*)(lds + XL_OFF)};
            pg8::gemm_phase<EpiIn, decltype(S), true, true>(lds, g, S, E, fresh_bx(wave));
        }
        SEAM(pb + 0);
        if (IN(pb + 1)) REP(0) {
#if FAST_SB
            sb_prompt(fresh_args(), lds, vcu, G, fresh_bx(wave), lane_now());
#endif
#if FAST_MLA
            mla_prompt(fresh_args(), lds, vcu, G, fresh_bx(wave), lane_now());
#endif
#if FAST_SSB
            sb_sample(fresh_args(), L, lds, vcu, G, fresh_bx(wave), lane_now());
#endif
#if FAST_SMLA
            mla_sample(fresh_args(), L, lds, vcu, G, fresh_bx(wave), lane_now());
#endif
#if !(FAST_SB && FAST_SSB)
            naive_sb(fresh_args(), L, vcu, G, fresh_bx(wave), lane_now());
#endif
#if !(FAST_MLA && FAST_SMLA)
            naive_mla(fresh_args(), L, vcu, G, fresh_bx(wave), lane_now());
#endif
        }
        SEAM(pb + 1);
        if (IN(pb + 2)) {
#if FAST_SMLA
            smla_combine(fresh_args(), vcu, G, fresh_bx(wave), lane_now());
#endif
            unsigned char* ws = fresh_args()->ws;
            pg8::Gemm g{(const bf16*)(ws + WS_OSB), (const bf16*)(ws + WS_W + (size_t)L * WL + W_SB), R, DM, SBW, SBW}; Ord<DM / 256> S; S.init(G, fresh_bx(bx));
            EpiGate<false> E{(const bf16*)(ws + WS_GA), (bf16*)(ws + WS_MG)};
            pg8::gemm_phase<EpiGate<false>, decltype(S), true, true>(lds, g, S, E, fresh_bx(wave));
        }
        SEAM_LOCAL(pb + 2);
        if (IN(pb + 3)) {
            unsigned char* ws = fresh_args()->ws;
            pg8::Gemm g{(const bf16*)(ws + WS_OLAT), (const bf16*)(ws + WS_W + (size_t)L * WL + W_YB), R, DM, QLW, QLW}; Ord<DM / 256> S; S.init(G, fresh_bx(bx));
            EpiGate<true> E{(const bf16*)(ws + WS_GB), (bf16*)(ws + WS_MG)};
            pg8::gemm_phase<EpiGate<true>, decltype(S), true, true>(lds, g, S, E, fresh_bx(wave));
        }
        SEAM(pb + 3);
        if (IN(pb + 4)) REP(5) {
            unsigned char* ws = fresh_args()->ws;
            { pg8::Gemm g{(const bf16*)(ws + WS_MG), (const bf16*)(ws + WS_W + (size_t)L * WL + W_OUT), PR, DM, DM, DM}; Ord<DM / 256, PR / 256, 8> S; S.init(G, fresh_bx(bx));
              EpiF32 E{(float*)(ws + WS_MIX), DM};
              pg8::gemm_phase<EpiF32, decltype(S), true, true>(lds, g, S, E, fresh_bx(wave)); }
#if SPLITK
            { pg8::Gemm g{(const bf16*)(ws + WS_MG), (const bf16*)(ws + WS_W + (size_t)L * WL + W_OUT), R, DM, fresh_bx(256), DM}; OrdSplit<4> S; S.init(G, fresh_bx(bx));
              EpiSlab E{(float*)(ws + WS_SLAB), DM};
              pg8::gemm_phase<EpiSlab, decltype(S), true, true>(lds, g, S, E, fresh_bx(wave)); }
#else
            { pg8::Gemm g{(const bf16*)(ws + WS_MG), (const bf16*)(ws + WS_W + (size_t)L * WL + W_OUT), R, DM, DM, DM}; OrdSplit<1> S; S.init(G, fresh_bx(bx));
              EpiF32 E{(float*)(ws + WS_MIX), DM};
              pg8::gemm_phase<EpiF32, decltype(S), true, true>(lds, g, S, E, fresh_bx(wave)); }
#endif
        }
        SEAM(pb + 4);
        if (IN(pb + 5)) {
            CArgs a = fresh_args(); float* X = a->out + O_Y; const float* MIX = (const float*)(a->ws + WS_MIX); bf16* XN = (bf16*)(a->ws + WS_XN);
            const float* g1 = a->in[17] + (size_t)L * DM; const float* g2 = a->in[18] + (size_t)L * DM;
            const int lane = lane_now();
            const float* SL = (const float*)(a->ws + WS_SLAB);
            for (int m = gw; m < R; m += NGW) { const bool sp = SPLITK && m >= PR; const float* xin = L > 0 ? X + (size_t)m * DM : (m < PR ? a->in[0] + (size_t)m * DM : a->in[1] + (size_t)(m - PR) * DM);
                row_op(lane, xin, sp ? SL + (size_t)(m - PR) * DM : MIX + (size_t)m * DM, g1, X + (size_t)m * DM, XN + (size_t)m * DM, g2, sp ? 4 : 1, (size_t)SR * DM); }
        }
        SEAM(pb + 5);
        if (IN(pb + 6)) REP(1) {
            CArgs a = fresh_args(); unsigned char* ws = a->ws;
            pg8::Gemm g{(const bf16*)(ws + WS_XN), (const bf16*)(ws + WS_W + (size_t)L * WL + W_UP), R, UPW, DM, DM}; Ord<UPW / 256> S; S.init(G, fresh_bx(bx));
            EpiBf E{(bf16*)(ws + WS_U), UPW, a->out + O_CONV_P + (size_t)L * NB * 2 * UPW, a->out + O_CONV_S + (size_t)L * DBATCH * 2 * UPW};
            pg8::gemm_phase<EpiBf, decltype(S), true, true>(lds, g, S, E, fresh_bx(wave));
        }
        SEAM(pb + 6);
#ifndef NO_CONV
        if (IN(pb + 7)) {
            REP(3) conv_phase(fresh_args(), L, vcu, G, fresh_bx(wave), lane_now()); }
#endif
        SEAM(pb + 7);
        if (IN(pb + 8)) REP(4) {
            unsigned char* ws = fresh_args()->ws;
            { pg8::Gemm g{(const bf16*)(ws + WS_ACT), (const bf16*)(ws + WS_W + (size_t)L * WL + W_DOWN), PR, DM, DFF, DFF}; Ord<DM / 256, PR / 256, 8> S; S.init(G, fresh_bx(bx));
              EpiF32 E{(float*)(ws + WS_MIX), DM};
              pg8::gemm_phase<EpiF32, decltype(S), true, true>(lds, g, S, E, fresh_bx(wave)); }
#if SPLITK
            { pg8::Gemm g{(const bf16*)(ws + WS_ACT), (const bf16*)(ws + WS_W + (size_t)L * WL + W_DOWN), R, DM, fresh_bx(256), DFF}; OrdSplit<11> S; S.init(G, fresh_bx(bx));
              EpiSlab E{(float*)(ws + WS_SLAB), DM};
              pg8::gemm_phase<EpiSlab, decltype(S), true, true>(lds, g, S, E, fresh_bx(wave)); }
#else
            { pg8::Gemm g{(const bf16*)(ws + WS_ACT), (const bf16*)(ws + WS_W + (size_t)L * WL + W_DOWN), R, DM, DFF, DFF}; OrdSplit<1> S; S.init(G, fresh_bx(bx));
              EpiF32 E{(float*)(ws + WS_MIX), DM};
              pg8::gemm_phase<EpiF32, decltype(S), true, true>(lds, g, S, E, fresh_bx(wave)); }
#endif
        }
        SEAM(pb + 8);
        if (IN(pb + 9)) {
            CArgs a = fresh_args(); float* X = a->out + O_Y; const float* MIX = (const float*)(a->ws + WS_MIX); bf16* XB = (bf16*)(a->ws + WS_XB);
            const float* g1 = a->in[19] + (size_t)L * DM;
            const int lane = lane_now();
            const float* SL = (const float*)(a->ws + WS_SLAB);
            for (int m = gw; m < R; m += NGW) { const bool sp = SPLITK && m >= PR; row_op(lane, X + (size_t)m * DM, sp ? SL + (size_t)(m - PR) * DM : MIX + (size_t)m * DM, g1, X + (size_t)m * DM, XB + (size_t)m * DM, nullptr, sp ? 11 : 1, (size_t)SR * DM); }
        }
        SEAM(pb + 9);
        if (IN(pb + 10)) {
            CArgs a = fresh_args(); unsigned char* ws = a->ws;
            { pg8::Gemm g{(const bf16*)(ws + WS_PB) + (size_t)L * R * DPLE, (const bf16*)(ws + WS_W + (size_t)L * WL + W_PP), R, DM, DPLE, DPLE}; Ord<DM / 256> S; S.init(G, fresh_bx(bx));
              EpiBf E{(bf16*)(ws + WS_PP) + (size_t)L * R * DM, DM, nullptr, nullptr};
              pg8::gemm_phase<EpiBf, decltype(S), true, true>(lds, g, S, E, fresh_bx(wave)); }
            pg8::Gemm g{(const bf16*)(ws + WS_XB), (const bf16*)(ws + WS_W + (size_t)L * WL + W_PG), R, DM, DM, DM}; Ord<DM / 256> S; S.init(G, fresh_bx(bx));
            EpiPle E{a->out + O_Y, (const bf16*)(ws + WS_PP) + (size_t)L * R * DM};
            pg8::gemm_phase<EpiPle, decltype(S), true, true>(lds, g, S, E, fresh_bx(wave));
        }
        SEAM(pb + 10);
        if (IN(pb + 11) && L + 1 < DEPTH) {
            CArgs a = fresh_args(); const float* X = a->out + O_Y; bf16* XN = (bf16*)(a->ws + WS_XN); const float* g2 = a->in[16] + (size_t)(L + 1) * DM;
            const int lane = lane_now();
            for (int m = gw; m < R; m += NGW) row_op(lane, X + (size_t)m * DM, nullptr, nullptr, nullptr, XN + (size_t)m * DM, g2);
        }
        SEAM(pb + 11);
    }

#ifdef MK_DUMP
    {
        __syncthreads(); const int lane = lane_now(); unsigned char* ws = fresh_args()->ws; float* X = fresh_args()->out + O_Y;
        if (fresh_args()->ph_lo == NPHASE)
        for (int m = gw; m < R; m += NGW) for (int j = 0; j < 16; ++j) { const int c = j * 64 + lane; float v = 0.f;
            if (MK_DUMP & 1) v += bf2f(((const bf16*)(ws + WS_OSB))[(size_t)m * SBW + (c & 511)]);
            if (MK_DUMP & 2) v += bf2f(((const bf16*)(ws + WS_OLAT))[(size_t)m * QLW + c]);
            if (MK_DUMP & 4) v += bf2f(((const bf16*)(ws + WS_GA))[(size_t)m * DM + c]) + bf2f(((const bf16*)(ws + WS_GB))[(size_t)m * DM + c]);
            if (MK_DUMP & 8) v += bf2f(((const bf16*)(ws + WS_QLAT))[(size_t)m * QLW + c]) + bf2f(((const bf16*)(ws + WS_QSB))[(size_t)m * SBW + (c & 511)]) + bf2f(((const bf16*)(ws + WS_QROPE))[(size_t)m * QRW + (c & 255)]);
            if (MK_DUMP & 16) v += bf2f(((const bf16*)(ws + WS_PP))[(size_t)m * DM + c]) + bf2f(((const bf16*)(ws + WS_PP))[((size_t)R + m) * DM + c]);
            if (MK_DUMP & 32) v += bf2f(((const bf16*)(ws + WS_MG))[(size_t)m * DM + c]);
            if (MK_DUMP & 64) v += ((const float*)(ws + WS_MIX))[(size_t)m * DM + c];
            X[(size_t)m * DM + c] = v; }
    }
#endif
#undef IN
#undef SEAM
}

extern "C" void kernel_launch(void* const* d_in, const int* in_sizes, int n_in, void* d_out, int out_size, void* d_ws, size_t ws_size, hipStream_t stream) {
    static int grid = 0;
    if (grid == 0) {
        if (n_in != 26 || (size_t)out_size != O_END || ws_size < WS_END2) { fprintf(stderr, "kernel_launch: unexpected shapes (n_in %d, out %d, ws %zu); nothing launched\n", n_in, out_size, ws_size); grid = -1; return; }
        int dev = 0, cus = 0, per_cu = 0;
        if (hipGetDevice(&dev) != hipSuccess || hipDeviceGetAttribute(&cus, hipDeviceAttributeMultiprocessorCount, dev) != hipSuccess) { grid = -1; return; }
        if (hipFuncSetAttribute((const void*)fwd, hipFuncAttributeMaxDynamicSharedMemorySize, LDS_BYTES) != hipSuccess) { fprintf(stderr, "kernel_launch: hipFuncSetAttribute failed\n"); grid = -1; return; }
        if (hipOccupancyMaxActiveBlocksPerMultiprocessor(&per_cu, (const void*)fwd, 512, LDS_BYTES) != hipSuccess || per_cu < 1) fprintf(stderr, "kernel_launch: occupancy query reports %d\n", per_cu);
        (void)hipGetLastError();
        grid = cus;
    }
    if (grid < 0) return;
    if (hipMemsetAsync((char*)d_ws + WS_CTL, 0, CTL_ZERO_BYTES, stream) != hipSuccess) return;
    Args a{};
    for (int i = 0; i < 26; ++i) a.in[i] = (const float*)d_in[i];
    a.out = (float*)d_out; a.ws = (unsigned char*)d_ws;
#if MK_PER_PHASE
    for (int ph = 0; ph < NPHASE; ++ph) { a.ph_lo = ph; a.ph_hi = ph + 1; hipLaunchKernelGGL(fwd, dim3(grid), dim3(512), LDS_BYTES, stream, a); }
#ifdef MK_DUMP
    a.ph_lo = NPHASE; a.ph_hi = NPHASE + 1; hipLaunchKernelGGL(fwd, dim3(grid), dim3(512), LDS_BYTES, stream, a);
#endif
#else
    a.ph_lo = 0; a.ph_hi = NPHASE; hipLaunchKernelGGL(fwd, dim3(grid), dim3(512), LDS_BYTES, stream, a);
#endif
}
```

```cpp
#include <hip/hip_runtime.h>
#include <cstdio>
#include <cstdint>
#include <cmath>
#define MK_PER_PHASE 0
namespace pg8 {
#define PG8_LAS __attribute__((address_space(3)))
typedef unsigned short bf16_t;
typedef short bf16x8 __attribute__((ext_vector_type(8)));
typedef float f32x4 __attribute__((ext_vector_type(4)));
typedef unsigned u32x4 __attribute__((ext_vector_type(4)));
constexpr int BM = 256, BK = 64, HALF = 128, HTB = HALF * BK * 2  , STAGE_BYTES = 8 * HTB, NXCD = 8, WGM = 8;

__host__ __device__ __forceinline__ int lds_byte(int r, int c) { const int st = (r >> 4) * 2 + (c >> 5), rr = r & 15, cc = c & 31, ob = rr * 64 + cc * 2; return st * 1024 + (ob ^ (((ob >> 9) & 1) << 5)); }
__host__ __device__ __forceinline__ void stage_rc(int b, int& R, int& C) { const int st = b / 1024, sb = b % 1024, swz = sb ^ (((sb >> 9) & 1) << 5); R = (st >> 1) * 16 + swz / 64; C = (st & 1) * 32 + (swz % 64) / 2; }
__host__ __device__ __forceinline__ int perm32(int rho) { const int n = rho >> 4, i = rho & 15; return 8 * (i >> 2) + 4 * n + (i & 3); }

struct Unit { int pm, pn, pk; };
struct Gemm { const bf16_t* A; const bf16_t* Bt; int M, N, K, ld; };

struct StaticOrder {
    int nM, nN, nwg, G, c;
    __host__ __device__ void init(int M, int N, int G_, int c_) { nM = M / BM; nN = N / BM; nwg = nM * nN; G = G_; c = c_; }
    __host__ __device__ bool next(int i, Unit& u) const {
        const long L = (long)i * G + c; if (L >= nwg) return false;
        int wgid = (int)L; { const int q = nwg / NXCD, r = nwg % NXCD, xcd = wgid % NXCD, off = wgid / NXCD; wgid = (xcd < r ? xcd * (q + 1) : r * (q + 1) + (xcd - r) * q) + off; }
        const int nig = WGM * nN, gid = wgid / nig, fm = gid * WGM, gsz = (nM - fm) < WGM ? (nM - fm) : WGM;
        u.pm = fm + ((wgid % nig) % gsz); u.pn = (wgid % nig) / gsz; return true;
    }
    __device__ __forceinline__ void a_ready(const Unit&) const {}
    __device__ __forceinline__ void done(const Unit&) const {}
};

typedef float f32x2_cv __attribute__((ext_vector_type(2))); typedef __bf16 bf16x2_cv __attribute__((ext_vector_type(2)));
__device__ __forceinline__ unsigned cvt_pk_bf16(float lo, float hi) { unsigned r; asm volatile("v_cvt_pk_bf16_f32 %0, %1, %2" : "=v"(r) : "v"(lo), "v"(hi)); return r; }
__device__ __forceinline__ unsigned cvt_pk_bf16_c(float lo, float hi) { f32x2_cv v = {lo, hi}; bf16x2_cv b = __builtin_convertvector(v, bf16x2_cv); return __builtin_bit_cast(unsigned, b); }
typedef float f32x2 __attribute__((ext_vector_type(2)));
template <class Epi, class Sched, bool ALIGN_EPI = false, bool SP2 = false>
__device__ __forceinline__ void gemm_phase(PG8_LAS unsigned char* lds, const Gemm g, const Sched& S, const Epi& E, const int wave_id) {
    int tid_; asm volatile("v_mbcnt_lo_u32_b32 %0, -1, 0\n\tv_mbcnt_hi_u32_b32 %0, -1, %0" : "=v"(tid_)); tid_ += wave_id * 64;
    const int tid = tid_, wid = __builtin_amdgcn_readfirstlane(tid >> 6), lane = tid & 63, wr = wid >> 2, wc = wid & 3, fr = lane & 15, fq = lane >> 4;
    const int K = g.K, nt = K / BK, LD = g.ld;
    unsigned voffA[2], voffB[2];
#pragma unroll
    for (int i = 0; i < 2; ++i) { int R, C; stage_rc(tid * 16 + i * 8192, R, C); const int Rb = Epi::PERM ? ((R & ~31) + perm32(R & 31)) : R;
        voffA[i] = (unsigned)(R * LD + C) * 2u; voffB[i] = (unsigned)(Rb * LD + C) * 2u; }
    const size_t kstep = (size_t)(BK * 2);
    const size_t hstep = (size_t)HALF * LD * 2;
    const size_t tstep = 2 * hstep;
    const unsigned ldsw = (unsigned)wid * 1024u;
    const int aoff = lds_byte(wr * 64 + fr, fq * 8), boff = lds_byte(wc * 32 + fr, fq * 8);
#define PG8_SA(b, h) (((b) * 2 + (h)) * HTB)
#define PG8_SB(b, h) ((4 + (b) * 2 + (h)) * HTB)
#define PG8_STAGE(bufoff, gbase, voff) do { _Pragma("unroll") for (int _i = 0; _i < 2; ++_i) \
        __builtin_amdgcn_global_load_lds((const unsigned*)((const char*)(gbase) + (voff)[_i]), (PG8_LAS unsigned*)(lds + (bufoff) + ldsw + _i * 8192), 16, 0, 0); } while (0)
#define PG8_LDA(dst, b, h) do { _Pragma("unroll") for (int m = 0; m < 4; ++m) _Pragma("unroll") for (int k = 0; k < 2; ++k) dst[m][k] = *(const PG8_LAS bf16x8*)(lds + PG8_SA(b, h) + aoff + m * 2048 + k * 1024); } while (0)
#define PG8_LDB(dst, b, h) do { _Pragma("unroll") for (int n = 0; n < 2; ++n) _Pragma("unroll") for (int k = 0; k < 2; ++k) dst[n][k] = *(const PG8_LAS bf16x8*)(lds + PG8_SB(b, h) + boff + n * 2048 + k * 1024); } while (0)
#define PG8_MMA(ai, bj, At, Bt) do { __builtin_amdgcn_s_setprio(1); _Pragma("unroll") for (int m = 0; m < 4; ++m) _Pragma("unroll") for (int n = 0; n < 2; ++n) _Pragma("unroll") for (int k = 0; k < 2; ++k) \
        acc[ai][bj][m][n] = __builtin_amdgcn_mfma_f32_16x16x32_bf16(Bt[n][k], At[m][k], acc[ai][bj][m][n], 0, 0, 0); __builtin_amdgcn_s_setprio(0); } while (0)
#define PG8_WAIT_V(n) asm volatile("s_waitcnt vmcnt(" #n ")" ::: "memory")
#define PG8_WAIT_L(n) asm volatile("s_waitcnt lgkmcnt(" #n ")" ::: "memory")
#define PG8_BAR __builtin_amdgcn_s_barrier()
#define PG8_SCHED __builtin_amdgcn_sched_barrier(0)
    Unit cur, nxt; int ui = 0;
    if (!S.next(0, cur)) return;
    f32x4 acc[2][2][4][2];
#pragma unroll
    for (int a = 0; a < 2; ++a)
#pragma unroll
        for (int b = 0; b < 2; ++b)
#pragma unroll
            for (int m = 0; m < 4; ++m)
#pragma unroll
                for (int n = 0; n < 2; ++n) acc[a][b][m][n] = (f32x4){0.f, 0.f, 0.f, 0.f};
    bf16x8 At[4][2], B0[2][2], B1[2][2];
    const char* cA = (const char*)g.A + (size_t)cur.pm * tstep + (size_t)cur.pk * K * 2; const char* cB = (const char*)g.Bt + (size_t)cur.pn * tstep + (size_t)cur.pk * K * 2;
    S.a_ready(cur);
    if constexpr (SP2) {
        PG8_STAGE(PG8_SB(0, 0), cB, voffB); PG8_STAGE(PG8_SB(0, 1), cB + hstep, voffB); PG8_STAGE(PG8_SA(0, 0), cA, voffA); PG8_STAGE(PG8_SA(0, 1), cA + hstep, voffA);
        if (wr == 1) PG8_BAR;
        PG8_WAIT_V(2); PG8_BAR;
        PG8_STAGE(PG8_SB(1, 0), cB + kstep, voffB); PG8_STAGE(PG8_SA(1, 0), cA + kstep, voffA); PG8_STAGE(PG8_SB(1, 1), cB + hstep + kstep, voffB);
        PG8_WAIT_V(6); PG8_BAR;
    } else {
        PG8_STAGE(PG8_SB(0, 0), cB, voffB); PG8_STAGE(PG8_SA(0, 0), cA, voffA); PG8_STAGE(PG8_SB(0, 1), cB + hstep, voffB); PG8_STAGE(PG8_SA(0, 1), cA + hstep, voffA);
        if (wr == 1) PG8_BAR;
        PG8_WAIT_V(4); PG8_BAR;
        PG8_STAGE(PG8_SB(1, 0), cB + kstep, voffB); PG8_STAGE(PG8_SA(1, 0), cA + kstep, voffA); PG8_STAGE(PG8_SB(1, 1), cB + hstep + kstep, voffB);
        PG8_WAIT_V(6); PG8_BAR;
    }
    for (;;) {
        const bool has_next = S.next(ui + 1, nxt);
        const char* nA = has_next ? (const char*)g.A + (size_t)nxt.pm * tstep + (size_t)nxt.pk * K * 2 : cA; const char* nB = has_next ? (const char*)g.Bt + (size_t)nxt.pn * tstep + (size_t)nxt.pk * K * 2 : cB;
        for (int t = 0; t < nt; t += 2) {
            const bool last = (t == nt - 2);
            const char* a1 = cA + (size_t)(t + 1) * kstep;
            const char* a2 = last ? nA : cA + (size_t)(t + 2) * kstep; const char* b2 = last ? nB : cB + (size_t)(t + 2) * kstep;
            const char* a3 = a2 + kstep; const char* b3 = b2 + kstep;
            if (last && has_next) S.a_ready(nxt);
            if constexpr (SP2) {
            PG8_LDB(B0, 0, 0); PG8_LDB(B1, 0, 1); PG8_SCHED; PG8_LDA(At, 0, 0); PG8_STAGE(PG8_SA(1, 1), a1 + hstep, voffA);
            PG8_WAIT_V(8); PG8_WAIT_L(0); PG8_BAR; PG8_MMA(0, 0, At, B0); PG8_MMA(0, 1, At, B1); PG8_BAR; PG8_SCHED;
            PG8_LDA(At, 0, 1); PG8_STAGE(PG8_SB(0, 0), b2, voffB); PG8_STAGE(PG8_SB(0, 1), b2 + hstep, voffB); PG8_STAGE(PG8_SA(0, 0), a2, voffA);
            PG8_WAIT_V(8); PG8_WAIT_L(0); PG8_BAR; PG8_MMA(1, 0, At, B0); PG8_MMA(1, 1, At, B1); PG8_BAR; PG8_SCHED;
            PG8_LDB(B0, 1, 0); PG8_LDB(B1, 1, 1); PG8_SCHED; PG8_LDA(At, 1, 0); PG8_STAGE(PG8_SA(0, 1), a2 + hstep, voffA);
            PG8_WAIT_V(8); PG8_WAIT_L(0); PG8_BAR; PG8_MMA(0, 0, At, B0); PG8_MMA(0, 1, At, B1); PG8_BAR; PG8_SCHED;
            PG8_LDA(At, 1, 1); PG8_STAGE(PG8_SB(1, 0), b3, voffB); PG8_STAGE(PG8_SB(1, 1), b3 + hstep, voffB); PG8_STAGE(PG8_SA(1, 0), a3, voffA);
            PG8_WAIT_V(8); PG8_WAIT_L(0); PG8_BAR; PG8_MMA(1, 0, At, B0); PG8_MMA(1, 1, At, B1); PG8_BAR; PG8_SCHED;
            } else {
            PG8_LDB(B0, 0, 0); PG8_SCHED; PG8_LDA(At, 0, 0); PG8_STAGE(PG8_SA(1, 1), a1 + hstep, voffA);
            PG8_WAIT_L(8); PG8_BAR; PG8_WAIT_L(0); PG8_MMA(0, 0, At, B0); PG8_BAR; PG8_SCHED;
            PG8_LDB(B1, 0, 1); PG8_STAGE(PG8_SB(0, 0), b2, voffB);
            PG8_BAR; PG8_WAIT_L(0); PG8_MMA(0, 1, At, B1); PG8_BAR;
            PG8_LDA(At, 0, 1); PG8_STAGE(PG8_SA(0, 0), a2, voffA);
            PG8_BAR; PG8_WAIT_L(0); PG8_MMA(1, 0, At, B0); PG8_BAR; PG8_SCHED;
            PG8_STAGE(PG8_SB(0, 1), b2 + hstep, voffB);
            PG8_WAIT_V(6); PG8_BAR; PG8_MMA(1, 1, At, B1); PG8_BAR;
            PG8_LDB(B0, 1, 0); PG8_SCHED; PG8_LDA(At, 1, 0); PG8_STAGE(PG8_SA(0, 1), a2 + hstep, voffA);
            PG8_WAIT_L(8); PG8_BAR; PG8_WAIT_L(0); PG8_MMA(0, 0, At, B0); PG8_BAR; PG8_SCHED;
            PG8_LDB(B1, 1, 1); PG8_STAGE(PG8_SB(1, 0), b3, voffB);
            PG8_BAR; PG8_WAIT_L(0); PG8_MMA(0, 1, At, B1); PG8_BAR;
            PG8_LDA(At, 1, 1); PG8_STAGE(PG8_SA(1, 0), a3, voffA);
            PG8_BAR; PG8_WAIT_L(0); PG8_MMA(1, 0, At, B0); PG8_BAR; PG8_SCHED;
            PG8_STAGE(PG8_SB(1, 1), b3 + hstep, voffB);
            PG8_WAIT_V(6); PG8_BAR; PG8_MMA(1, 1, At, B1); PG8_BAR;
            }
        }
        if constexpr (ALIGN_EPI) { if (wr == 0) PG8_BAR; }
        if constexpr (!Epi::AFTER_DRAIN) { E(acc, cur, wr, wc, fr, fq); S.done(cur); }
        if (!has_next) break;
#pragma unroll
        for (int a = 0; a < 2; ++a)
#pragma unroll
            for (int b = 0; b < 2; ++b)
#pragma unroll
                for (int m = 0; m < 4; ++m)
#pragma unroll
                    for (int n = 0; n < 2; ++n) acc[a][b][m][n] = (f32x4){0.f, 0.f, 0.f, 0.f};
        cur = nxt; cA = nA; cB = nB; ++ui;
        if constexpr (ALIGN_EPI) { if (wr == 1) PG8_BAR; }
    }
    PG8_WAIT_V(0);
    if constexpr (!ALIGN_EPI) { if (wr == 0) PG8_BAR; }
    PG8_BAR;
    if constexpr (Epi::AFTER_DRAIN) { E.fused(acc, cur, wr, wc, fr, fq, lds, wid, lane); S.done(cur); }
#undef PG8_SA
#undef PG8_SB
#undef PG8_STAGE
#undef PG8_LDA
#undef PG8_LDB
#undef PG8_MMA
#undef PG8_WAIT_V
#undef PG8_WAIT_L
#undef PG8_BAR
#undef PG8_SCHED
}
}
#define GAS __attribute__((address_space(1)))
#define LAS __attribute__((address_space(3)))
typedef unsigned short bf16;
typedef unsigned v4u __attribute__((ext_vector_type(4)));
typedef float f32x4 __attribute__((ext_vector_type(4)));
typedef short bf16x8 __attribute__((ext_vector_type(8)));
typedef GAS unsigned gu32;
typedef GAS unsigned long long gu64;
#define RLX_AGENT __ATOMIC_RELAXED, __HIP_MEMORY_SCOPE_AGENT
#define LDS_WAIT() asm volatile("s_waitcnt lgkmcnt(0)" ::: "memory")
#define VM_WAIT() asm volatile("s_waitcnt vmcnt(0)" ::: "memory")
__device__ __forceinline__ unsigned long long rt() { return __builtin_amdgcn_s_memrealtime(); }
__device__ __forceinline__ unsigned f2bf(float f) { unsigned u = __builtin_bit_cast(unsigned, f); return (u + 0x7fffu + ((u >> 16) & 1u)) >> 16; }
__device__ __forceinline__ unsigned pk2(float lo, float hi) { return f2bf(lo) | (f2bf(hi) << 16); }

#define XB_TMO      128
#define XB_XCNT(j)  (256  + 64 * (j))
#define XB_XSUB(j)  (1280 + 64 * (j))
#define XB_XGEN(j)  (2304 + 64 * (j))
#define XB_TOP      3328
#define XB_TOPGEN   3392
#define XCD_BAR_WORDS 3456
#define XB_SPIN_CAP (1u << 18)

__device__ __forceinline__ unsigned xb_ld(unsigned* p)              { return __hip_atomic_load(p, __ATOMIC_RELAXED, __HIP_MEMORY_SCOPE_AGENT); }
__device__ __forceinline__ unsigned xb_add(unsigned* p, unsigned v) { return __hip_atomic_fetch_add(p, v, __ATOMIC_RELAXED, __HIP_MEMORY_SCOPE_AGENT); }
__device__ __forceinline__ unsigned xb_xcc_id() { return (unsigned)__builtin_amdgcn_s_getreg((3 << 11) | 20) & 0xFu; }
#define XB_SPIN(cond, bar) do { unsigned _sp = 0; while (cond) { __builtin_amdgcn_s_sleep(1); \
    if ((++_sp & 255u) == 0u) { if (xb_ld(&(bar)[XB_TMO])) break; if (_sp > XB_SPIN_CAP) { atomicAdd(&(bar)[XB_TMO], 1u); break; } } } } while (0)

struct XcdBarrier {
    unsigned* bar; unsigned x; unsigned w;
    volatile LAS unsigned* st;
};

__device__ __forceinline__ XcdBarrier xcd_barrier_post(unsigned* bar, volatile LAS unsigned* st) {
    XcdBarrier b; b.bar = bar; b.x = xb_xcc_id(); b.st = st; b.w = (unsigned)__builtin_amdgcn_readfirstlane((int)threadIdx.x >> 6);
    if (threadIdx.x == 0) (void)xb_add(&bar[XB_XCNT(b.x)], 1u);
    return b;
}
__device__ __forceinline__ void xcd_barrier_complete(unsigned* bar, unsigned x, unsigned& nloc, unsigned& nx) {
    const unsigned G = gridDim.x * gridDim.y * gridDim.z;
    unsigned sum, cnt, mine, sp = 0u;
    for (;;) {
        sum = 0u; cnt = 0u; mine = 0u;
#pragma unroll
        for (unsigned j = 0; j < 16; ++j) { const unsigned c = xb_ld(&bar[XB_XCNT(j)]); sum += c; cnt += (c > 0u) ? 1u : 0u; mine = (j == x) ? c : mine; }
        if (sum == G) break;
        __builtin_amdgcn_s_sleep(1);
        if ((++sp & 255u) == 0u) { if (xb_ld(&bar[XB_TMO])) break; if (sp > XB_SPIN_CAP) { atomicAdd(&bar[XB_TMO], 1u); break; } }
    }
    nloc = mine > 0u ? mine : 1u; nx = cnt > 0u ? cnt : 1u;
}

__device__ __forceinline__ void xcd_barrier(const XcdBarrier& b) {
    asm volatile("s_waitcnt vmcnt(0)" ::: "memory");
    __syncthreads();
    int l0_; asm volatile("v_mbcnt_lo_u32_b32 %0, -1, 0\n\tv_mbcnt_hi_u32_b32 %0, -1, %0" : "=v"(l0_));
    if (b.w == 0u && l0_ == 0) {
        unsigned* bar = b.bar; unsigned bx_ = b.x; asm volatile("" : "+s"(bar), "+s"(bx_));
        __builtin_amdgcn_s_waitcnt(0);
        unsigned nloc = b.st[0], nx = b.st[1];
        if (nloc == 0u) { xcd_barrier_complete(bar, bx_, nloc, nx); b.st[0] = nloc; b.st[1] = nx; }
        const unsigned old = xb_add(&bar[XB_XSUB(bx_)], 1u);
        const unsigned gen = old / nloc;
        if (old + 1u == (gen + 1u) * nloc) {
            __builtin_amdgcn_fence(__ATOMIC_RELEASE, "agent");
            asm volatile("s_waitcnt vmcnt(0)" ::: "memory");
            const unsigned og = xb_add(&bar[XB_TOP], 1u);
            const unsigned tg = og / nx;
            if (og + 1u == (tg + 1u) * nx) xb_add(&bar[XB_TOPGEN], 1u);
            else XB_SPIN(xb_ld(&bar[XB_TOPGEN]) == tg, bar);
            __builtin_amdgcn_fence(__ATOMIC_ACQUIRE, "agent");
            xb_add(&bar[XB_XGEN(bx_)], 1u);
            asm volatile("s_waitcnt vmcnt(0)" ::: "memory");
        } else {
            XB_SPIN(xb_ld(&bar[XB_XGEN(bx_)]) == gen, bar);
            __builtin_amdgcn_fence(__ATOMIC_ACQUIRE, "agent");
            asm volatile("s_waitcnt vmcnt(0)" ::: "memory");
        }
    }
    __syncthreads();
}

constexpr int DM = 1024, NB = 16, SEQ = 2048, DEPTH = 2, DBATCH = 32, DSEQ = 32, PAST = 4096;
constexpr int PR = NB * SEQ, SR = DBATCH * DSEQ, R = PR + SR;
constexpr int SBW = 512, LORA = 128, ROPE = 32, QLW = 1024, QRW = 256, DFF = 2816, UPW = 5632, DPLE = 256, NHEAD = 8;
constexpr int INC = 4512, NIN = 5120;
constexpr float EPS = 1e-6f, LOG2E = 1.4426950408889634f;
constexpr float QS_SB = 0.125f * LOG2E;
constexpr float QS_MLA = 0.10206207261596575f * LOG2E;
constexpr int NSLOT = 2048 + 32;

constexpr size_t O_Y = 0;
constexpr size_t O_SBK_P = (size_t)R * DM;
constexpr size_t O_SBV_P = O_SBK_P + (size_t)DEPTH * PR * SBW;
constexpr size_t O_CKV_P = O_SBV_P + (size_t)DEPTH * PR * SBW;
constexpr size_t O_KR_P = O_CKV_P + (size_t)DEPTH * PR * LORA;
constexpr size_t O_CONV_P = O_KR_P + (size_t)DEPTH * PR * ROPE;
constexpr size_t O_SBK_S = O_CONV_P + (size_t)DEPTH * NB * 2 * UPW;
constexpr size_t O_SBV_S = O_SBK_S + (size_t)DEPTH * SR * SBW;
constexpr size_t O_CKV_S = O_SBV_S + (size_t)DEPTH * SR * SBW;
constexpr size_t O_KR_S = O_CKV_S + (size_t)DEPTH * SR * LORA;
constexpr size_t O_CONV_S = O_KR_S + (size_t)DEPTH * SR * ROPE;
constexpr size_t O_END = O_CONV_S + (size_t)DEPTH * DBATCH * 2 * UPW;
static_assert(O_END == 115703808ull, "output map");

constexpr size_t MiB = 1u << 20;
constexpr size_t WS_CTL = 0, CTL_ZERO_BYTES = 1 * MiB;
constexpr size_t WS_ROPE = 1 * MiB;
constexpr size_t WS_W = 4 * MiB, WL = 36 * MiB;
constexpr size_t W_IN = 0, W_SB = 10 * MiB, W_YB = 11 * MiB, W_OUT = 13 * MiB, W_UP = 15 * MiB, W_DOWN = 26 * MiB, W_PG = 32 * MiB, W_PP = 34 * MiB;
constexpr size_t WS_XN = 80 * MiB, WS_QSB = 146 * MiB, WS_KSB = 179 * MiB, WS_VSB = 212 * MiB, WS_QLAT = 245 * MiB, WS_QROPE = 311 * MiB,
                 WS_CKVB = 328 * MiB, WS_KRB = 337 * MiB, WS_GA = 340 * MiB, WS_GB = 406 * MiB, WS_OSB = 472 * MiB, WS_OLAT = 505 * MiB,
                 WS_MG = 571 * MiB, WS_MIX = 637 * MiB, WS_XB = 769 * MiB, WS_PP = 835 * MiB, WS_PB = 967 * MiB, WS_U = 1000 * MiB,
                 WS_ACT = 1363 * MiB, WS_END = 1546 * MiB;
static_assert(W_PP + (size_t)DM * DPLE * 2 <= WL && WS_W + 2 * WL <= WS_XN, "weights map");
static_assert(WS_ACT + (size_t)R * DFF * 2 <= WS_END && WS_U + (size_t)R * UPW * 2 <= WS_ACT && WS_PB + 2 * (size_t)R * DPLE * 2 <= WS_U, "ws map");
constexpr int CW_BAR = 4096;

constexpr int RING_BYTES = 131072, XL_OFF = RING_BYTES, MISC_OFF = RING_BYTES + 8192, LDS_BYTES = 147456;

#ifndef MK_PER_PHASE
#define MK_PER_PHASE 0
#endif
#ifndef MK_PH_END
#define MK_PH_END (2 + 12 * DEPTH)
#endif
constexpr int NPHASE = MK_PH_END;
#ifndef MK_DBL
#define MK_DBL 0
#endif
#define REP(bit) for (int rep_ = 0; rep_ < ((MK_DBL >> (bit)) & 1) + 1; ++rep_)
#ifndef SPLITK
#define SPLITK 1
#endif
#ifndef FAST_SB
#define FAST_SB 1
#endif
#ifndef FAST_MLA
#define FAST_MLA 1
#endif
#ifndef FAST_SSB
#define FAST_SSB 1
#endif
#ifndef FAST_SMLA
#define FAST_SMLA 1
#endif

__device__ __forceinline__ float bf2f(unsigned short b) { return __uint_as_float((unsigned)b << 16); }
__device__ __forceinline__ float lo2f(unsigned w) { return __uint_as_float(w << 16); }
__device__ __forceinline__ float hi2f(unsigned w) { return __uint_as_float(w & 0xffff0000u); }
__device__ __forceinline__ float fexp2(float x) { return __builtin_amdgcn_exp2f(x); }
__device__ __forceinline__ float frcp(float x) { return __builtin_amdgcn_rcpf(x); }
__device__ __forceinline__ float sigm(float x) { return frcp(1.0f + fexp2(-LOG2E * x)); }
template <int O> __device__ __forceinline__ float xshfl(float v) {
    if constexpr (O == 32) { const auto sw = __builtin_amdgcn_permlane32_swap(__float_as_uint(v), __float_as_uint(v), false, false); const float a = __uint_as_float(sw[0]), b = __uint_as_float(sw[1]); return (a == v) ? b : a; }
    else return __uint_as_float((unsigned)__builtin_amdgcn_ds_swizzle((int)__float_as_uint(v), (O << 10) | 0x1f));
}
__device__ __forceinline__ float wave_sum(float v) {
    v += xshfl<1>(v); v += xshfl<2>(v); v += xshfl<4>(v); v += xshfl<8>(v); v += xshfl<16>(v);
    { const auto sw = __builtin_amdgcn_permlane32_swap(__float_as_uint(v), __float_as_uint(v), false, false); v = __uint_as_float(sw[0]) + __uint_as_float(sw[1]); }
    return v;
}
__device__ __forceinline__ v4u pack8(f32x4 a, f32x4 b) { v4u w; w.x = pg8::cvt_pk_bf16(a[0], a[1]); w.y = pg8::cvt_pk_bf16(a[2], a[3]); w.z = pg8::cvt_pk_bf16(b[0], b[1]); w.w = pg8::cvt_pk_bf16(b[2], b[3]); return w; }
__device__ __forceinline__ v4u pack8c(f32x4 a, f32x4 b) { v4u w; w.x = pg8::cvt_pk_bf16_c(a[0], a[1]); w.y = pg8::cvt_pk_bf16_c(a[2], a[3]); w.z = pg8::cvt_pk_bf16_c(b[0], b[1]); w.w = pg8::cvt_pk_bf16_c(b[2], b[3]); return w; }
__device__ __forceinline__ int ridx(int p) { return ((p >> 2) & 1) * 16 + 4 * (p >> 3) + (p & 3); }
__device__ __forceinline__ int pos_slot(int row) { return row < PR ? (row & (SEQ - 1)) : SEQ + ((row - PR) & (DSEQ - 1)); }

typedef pg8::f32x4 A4;

template <int NN, int NM = R / 256, int WG = 6> struct Ord {
    static constexpr int NWG = NM * NN, NIG = WG * NN, Q = NWG / 8, RM = NWG % 8;
    static_assert(NM % WG == 0, "row panels per group");
    int G, c;
    __device__ __forceinline__ void init(int G_, int c_) { G = G_; c = c_; }
    __device__ __forceinline__ bool next(int i, pg8::Unit& u) const {
        const int Lx = i * G + c; if (Lx >= NWG) return false;
        const int xcd = Lx & 7, off = Lx >> 3; const int wgid = (xcd < RM ? xcd * (Q + 1) : RM * (Q + 1) + (xcd - RM) * Q) + off;
        const int gid = wgid / NIG, rem = wgid - gid * NIG; u.pm = gid * WG + rem % WG; u.pn = rem / WG; u.pk = 0; return true;
    }
    __device__ __forceinline__ void a_ready(const pg8::Unit&) const {}
    __device__ __forceinline__ void done(const pg8::Unit&) const {}
};
template <int KS> struct OrdSplit {
    int G, c;
    __device__ __forceinline__ void init(int G_, int c_) { G = G_; c = c_; }
    __device__ __forceinline__ bool next(int i, pg8::Unit& u) const { const int Lx = i * G + c; if (Lx >= 16 * KS) return false; u.pk = Lx >> 4; u.pm = PR / 256 + (Lx & 3); u.pn = (Lx >> 2) & 3; return true; }
    __device__ __forceinline__ void a_ready(const pg8::Unit&) const {}
    __device__ __forceinline__ void done(const pg8::Unit&) const {}
};
struct EpiIn {
    static constexpr bool PERM = true, AFTER_DRAIN = false;
    unsigned char* ws_; float* out_; int L; const float* gain; LAS float* xl;
    __device__ __forceinline__ void operator()(const A4 (&acc)[2][2][4][2], const pg8::Unit& u, int wr, int wc, int fr, int fq) const {
        unsigned char* ws = ws_; float* out = out_; asm volatile("" : "+s"(ws), "+s"(out));
        const int pn = u.pn; const bool samp = u.pm >= PR / 256;
        const int row0 = u.pm * 256 + wr * 64 + fr;
        if (pn < 2) { bf16* const QSB = (bf16*)(ws + WS_QSB);
#pragma unroll
            for (int ai = 0; ai < 2; ++ai)
#pragma unroll
                for (int m = 0; m < 4; ++m) { const int row = row0 + ai * 128 + m * 16;
#pragma unroll
                    for (int bj = 0; bj < 2; ++bj) { const int col = pn * 256 + bj * 128 + wc * 32 + 8 * fq;
                        *(v4u*)(QSB + (size_t)row * SBW + col) = pack8(acc[ai][bj][m][0] * QS_SB, acc[ai][bj][m][1] * QS_SB); } }
        } else if (pn < 6) {
            const int which = (pn - 2) >> 1; bf16* B = (bf16*)(ws + (which ? WS_VSB : WS_KSB));
            float* O = out + (samp ? (which ? O_SBV_S : O_SBK_S) + (size_t)L * SR * SBW : (which ? O_SBV_P : O_SBK_P) + (size_t)L * PR * SBW);
#pragma unroll
            for (int ai = 0; ai < 2; ++ai)
#pragma unroll
                for (int m = 0; m < 4; ++m) { const int row = row0 + ai * 128 + m * 16, prow = samp ? row - PR : row;
#pragma unroll
                    for (int bj = 0; bj < 2; ++bj) { const int col = ((pn - 2) & 1) * 256 + bj * 128 + wc * 32 + 8 * fq;
                        const A4 v0 = acc[ai][bj][m][0], v1 = acc[ai][bj][m][1];
                        float* op = O + (size_t)prow * SBW + col; *(A4*)op = v0; *(A4*)(op + 4) = v1;
                        *(v4u*)(B + (size_t)row * SBW + col) = pack8(v0, v1); } }
        } else if (pn < 10) { bf16* const QLAT = (bf16*)(ws + WS_QLAT);
#pragma unroll
            for (int ai = 0; ai < 2; ++ai)
#pragma unroll
                for (int m = 0; m < 4; ++m) { const int row = row0 + ai * 128 + m * 16;
#pragma unroll
                    for (int bj = 0; bj < 2; ++bj) { const int col = (pn - 6) * 256 + bj * 128 + wc * 32 + 8 * fq;
                        *(v4u*)(QLAT + (size_t)row * QLW + col) = pack8(acc[ai][bj][m][0] * QS_MLA, acc[ai][bj][m][1] * QS_MLA); } }
        } else if (pn == 10) { bf16* const QROPE = (bf16*)(ws + WS_QROPE); const float* const tab = (const float*)(ws + WS_ROPE);
#pragma unroll
            for (int ai = 0; ai < 2; ++ai)
#pragma unroll
                for (int m = 0; m < 4; ++m) { const int row = row0 + ai * 128 + m * 16; const float* tp = tab + pos_slot(row) * 32 + 4 * fq;
                    const A4 cs = *(const A4*)tp, sn = *(const A4*)(tp + 16);
#pragma unroll
                    for (int bj = 0; bj < 2; ++bj) { const int head = bj * 4 + wc; const A4 x1 = acc[ai][bj][m][0], x2 = acc[ai][bj][m][1];
                        const A4 y1 = (x1 * cs - x2 * sn) * QS_MLA, y2 = (x1 * sn + x2 * cs) * QS_MLA;
                        *(v4u*)(QROPE + (size_t)row * QRW + head * 32 + 8 * fq) = pack8(y1, y2); } }
        } else if (pn == 11) { bf16* const CKVB = (bf16*)(ws + WS_CKVB); bf16* const KRB = (bf16*)(ws + WS_KRB); const float* const tab = (const float*)(ws + WS_ROPE);
            float* const ckv_o = out + (samp ? O_CKV_S + (size_t)L * SR * LORA : O_CKV_P + (size_t)L * PR * LORA); float* const kr_o = out + (samp ? O_KR_S + (size_t)L * SR * ROPE : O_KR_P + (size_t)L * PR * ROPE);
#pragma unroll
            for (int ai = 0; ai < 2; ++ai)
#pragma unroll
                for (int m = 0; m < 4; ++m) { const A4 a = acc[ai][0][m][0], b = acc[ai][0][m][1];
                    float s = (a[0] * a[0] + a[1] * a[1]) + (a[2] * a[2] + a[3] * a[3]) + (b[0] * b[0] + b[1] * b[1]) + (b[2] * b[2] + b[3] * b[3]);
                    s += xshfl<16>(s); { const auto sw = __builtin_amdgcn_permlane32_swap(__float_as_uint(s), __float_as_uint(s), false, false); s = __uint_as_float(sw[0]) + __uint_as_float(sw[1]); }
                    if (fq == 0) xl[(ai * 128 + wr * 64 + m * 16 + fr) * 4 + wc] = s; }
            asm volatile("s_waitcnt lgkmcnt(0)" ::: "memory"); __builtin_amdgcn_s_barrier(); asm volatile("" ::: "memory");
            const int ccol = wc * 32 + 8 * fq; const A4 g0 = *(const A4*)(gain + ccol), g1 = *(const A4*)(gain + ccol + 4);
#pragma unroll
            for (int ai = 0; ai < 2; ++ai)
#pragma unroll
                for (int m = 0; m < 4; ++m) { const int row = row0 + ai * 128 + m * 16, prow = samp ? row - PR : row;
                    const A4 p = *(const LAS A4*)(xl + (ai * 128 + wr * 64 + m * 16 + fr) * 4);
                    const float rs = 1.0f / sqrtf(((p[0] + p[1]) + (p[2] + p[3])) * (1.0f / LORA) + EPS);
                    const A4 v0 = acc[ai][0][m][0] * rs * g0, v1 = acc[ai][0][m][1] * rs * g1;
                    float* op = ckv_o + (size_t)prow * LORA + ccol; *(A4*)op = v0; *(A4*)(op + 4) = v1;
                    *(v4u*)(CKVB + (size_t)row * LORA + ccol) = pack8(v0, v1);
                    if (wc == 0) {
                        const float* tp = tab + pos_slot(row) * 32 + 4 * fq; const A4 cs = *(const A4*)tp, sn = *(const A4*)(tp + 16);
                        const A4 x1 = acc[ai][1][m][0], x2 = acc[ai][1][m][1];
                        const A4 y1 = x1 * cs - x2 * sn, y2 = x1 * sn + x2 * cs;
                        float* kp = kr_o + (size_t)prow * ROPE + 4 * fq; *(A4*)kp = y1; *(A4*)(kp + 16) = y2;
                        *(v4u*)(KRB + (size_t)row * ROPE + 8 * fq) = pack8(y1, y2); } }
        } else {
            bf16* G = (bf16*)(ws + (pn < 16 ? WS_GA : WS_GB));
#pragma unroll
            for (int ai = 0; ai < 2; ++ai)
#pragma unroll
                for (int m = 0; m < 4; ++m) { const int row = row0 + ai * 128 + m * 16;
#pragma unroll
                    for (int bj = 0; bj < 2; ++bj) { const int col = ((pn - 12) & 3) * 256 + bj * 128 + wc * 32 + 8 * fq;
                        const A4 a = acc[ai][bj][m][0], b = acc[ai][bj][m][1];
                        const A4 sa = {sigm(a[0]), sigm(a[1]), sigm(a[2]), sigm(a[3])}, sb = {sigm(b[0]), sigm(b[1]), sigm(b[2]), sigm(b[3])};
                        *(v4u*)(G + (size_t)row * DM + col) = pack8c(sa, sb); } }
        }
    }
};
template <bool ADD> struct EpiGate {
    static constexpr bool PERM = true, AFTER_DRAIN = false;
    const bf16* G; bf16* MG;
    __device__ __forceinline__ void operator()(const A4 (&acc)[2][2][4][2], const pg8::Unit& u, int wr, int wc, int fr, int fq) const {
        const int row0 = u.pm * 256 + wr * 64 + fr;
#pragma unroll
        for (int ai = 0; ai < 2; ++ai)
#pragma unroll
            for (int m = 0; m < 4; ++m) { const int row = row0 + ai * 128 + m * 16;
#pragma unroll
                for (int bj = 0; bj < 2; ++bj) { const size_t off = (size_t)row * DM + u.pn * 256 + bj * 128 + wc * 32 + 8 * fq;
                    const v4u g = *(const v4u*)(G + off);
                    A4 a = acc[ai][bj][m][0] * (A4){lo2f(g.x), hi2f(g.x), lo2f(g.y), hi2f(g.y)}, b = acc[ai][bj][m][1] * (A4){lo2f(g.z), hi2f(g.z), lo2f(g.w), hi2f(g.w)};
                    if (ADD) { const v4u o = *(const v4u*)(MG + off); a += (A4){lo2f(o.x), hi2f(o.x), lo2f(o.y), hi2f(o.y)}; b += (A4){lo2f(o.z), hi2f(o.z), lo2f(o.w), hi2f(o.w)}; }
                    *(v4u*)(MG + off) = pack8(a, b); } }
    }
};
struct EpiF32 {
    static constexpr bool PERM = true, AFTER_DRAIN = false;
    float* O; int ldc;
    __device__ __forceinline__ void operator()(const A4 (&acc)[2][2][4][2], const pg8::Unit& u, int wr, int wc, int fr, int fq) const {
        const int row0 = u.pm * 256 + wr * 64 + fr;
#pragma unroll
        for (int ai = 0; ai < 2; ++ai)
#pragma unroll
            for (int m = 0; m < 4; ++m) { const int row = row0 + ai * 128 + m * 16;
#pragma unroll
                for (int bj = 0; bj < 2; ++bj) { float* op = O + (size_t)row * ldc + u.pn * 256 + bj * 128 + wc * 32 + 8 * fq;
                    *(A4*)op = acc[ai][bj][m][0]; *(A4*)(op + 4) = acc[ai][bj][m][1]; } }
    }
};
struct EpiSlab {
    static constexpr bool PERM = true, AFTER_DRAIN = false;
    float* O; int ldc;
    __device__ __forceinline__ void operator()(const A4 (&acc)[2][2][4][2], const pg8::Unit& u, int wr, int wc, int fr, int fq) const {
        const int row0 = (u.pm - PR / 256) * 256 + wr * 64 + fr; float* Ob = O + (size_t)u.pk * SR * ldc;
#pragma unroll
        for (int ai = 0; ai < 2; ++ai)
#pragma unroll
            for (int m = 0; m < 4; ++m) { const int row = row0 + ai * 128 + m * 16;
#pragma unroll
                for (int bj = 0; bj < 2; ++bj) { float* op = Ob + (size_t)row * ldc + u.pn * 256 + bj * 128 + wc * 32 + 8 * fq;
                    *(A4*)op = acc[ai][bj][m][0]; *(A4*)(op + 4) = acc[ai][bj][m][1]; } }
    }
};
struct EpiBf {
    static constexpr bool PERM = true, AFTER_DRAIN = false;
    bf16* O; int ldc; float* conv_p; float* conv_s;
    __device__ __forceinline__ void operator()(const A4 (&acc)[2][2][4][2], const pg8::Unit& u, int wr, int wc, int fr, int fq) const {
        const int row0 = u.pm * 256 + wr * 64 + fr; const bool samp = u.pm >= PR / 256;
#pragma unroll
        for (int ai = 0; ai < 2; ++ai)
#pragma unroll
            for (int m = 0; m < 4; ++m) { const int row = row0 + ai * 128 + m * 16;
                int ci = -1;
                if (conv_p) { if (!samp) { const int t = row & (SEQ - 1); if (t >= SEQ - 2) ci = (row >> 11) * 2 + (t - (SEQ - 2)); }
                              else { const int t = (row - PR) & (DSEQ - 1); if (t >= DSEQ - 2) ci = ((row - PR) >> 5) * 2 + (t - (DSEQ - 2)); } }
#pragma unroll
                for (int bj = 0; bj < 2; ++bj) { const int col = u.pn * 256 + bj * 128 + wc * 32 + 8 * fq;
                    *(v4u*)(O + (size_t)row * ldc + col) = pack8(acc[ai][bj][m][0], acc[ai][bj][m][1]);
                    if (ci >= 0) { float* cp = (samp ? conv_s : conv_p) + (size_t)ci * UPW + col; *(A4*)cp = acc[ai][bj][m][0]; *(A4*)(cp + 4) = acc[ai][bj][m][1]; } } }
    }
};
struct EpiPle {
    static constexpr bool PERM = true, AFTER_DRAIN = false;
    float* X; const bf16* PP;
    __device__ __forceinline__ void operator()(const A4 (&acc)[2][2][4][2], const pg8::Unit& u, int wr, int wc, int fr, int fq) const {
        const int row0 = u.pm * 256 + wr * 64 + fr;
#pragma unroll
        for (int ai = 0; ai < 2; ++ai)
#pragma unroll
            for (int m = 0; m < 4; ++m) { const int row = row0 + ai * 128 + m * 16;
#pragma unroll
                for (int bj = 0; bj < 2; ++bj) { const size_t off = (size_t)row * DM + u.pn * 256 + bj * 128 + wc * 32 + 8 * fq;
                    const v4u p = *(const v4u*)(PP + off); float* xp = X + off; const A4 x0 = *(const A4*)xp, x1 = *(const A4*)(xp + 4);
                    const A4 a = acc[ai][bj][m][0], b = acc[ai][bj][m][1];
                    const A4 sa = {sigm(a[0]), sigm(a[1]), sigm(a[2]), sigm(a[3])}, sb = {sigm(b[0]), sigm(b[1]), sigm(b[2]), sigm(b[3])};
                    *(A4*)xp = x0 + sa * (A4){lo2f(p.x), hi2f(p.x), lo2f(p.y), hi2f(p.y)}; *(A4*)(xp + 4) = x1 + sb * (A4){lo2f(p.z), hi2f(p.z), lo2f(p.w), hi2f(p.w)}; } }
    }
};

struct Args { const float* in[26]; float* out; unsigned char* ws; int ph_lo, ph_hi; };
typedef const __attribute__((address_space(4))) Args* CArgs;

__device__ __forceinline__ void row_op(int lane, const float* xin, const float* addsrc, const float* g_add, float* xout, bf16* bout, const float* g_out, int nadd = 1, size_t addstride = 0) {
    const f32x4* xr = (const f32x4*)xin + lane; f32x4 v[4];
#pragma unroll
    for (int j = 0; j < 4; ++j) v[j] = xr[64 * j];
    if (addsrc) {
        const f32x4* ar = (const f32x4*)addsrc + lane; const f32x4* gr = (const f32x4*)g_add + lane; f32x4 a[4]; float s = 0.f;
#pragma unroll
        for (int j = 0; j < 4; ++j) { a[j] = ar[64 * j]; for (int sl = 1; sl < nadd; ++sl) a[j] += *(const f32x4*)(addsrc + (size_t)sl * addstride + 4 * (lane + 64 * j));
            s += (a[j].x * a[j].x + a[j].y * a[j].y) + (a[j].z * a[j].z + a[j].w * a[j].w); }
        const float r = 1.0f / sqrtf(wave_sum(s) * (1.0f / DM) + EPS);
#pragma unroll
        for (int j = 0; j < 4; ++j) v[j] += a[j] * r * gr[64 * j];
    }
    if (xout) { f32x4* xo = (f32x4*)xout + lane;
#pragma unroll
        for (int j = 0; j < 4; ++j) xo[64 * j] = v[j]; }
    if (bout) {
        if (g_out) { float s = 0.f; const f32x4* gr = (const f32x4*)g_out + lane;
#pragma unroll
            for (int j = 0; j < 4; ++j) s += (v[j].x * v[j].x + v[j].y * v[j].y) + (v[j].z * v[j].z + v[j].w * v[j].w);
            const float r = 1.0f / sqrtf(wave_sum(s) * (1.0f / DM) + EPS);
#pragma unroll
            for (int j = 0; j < 4; ++j) v[j] = v[j] * r * gr[64 * j]; }
        unsigned long long* o8 = (unsigned long long*)bout + lane;
#pragma unroll
        for (int j = 0; j < 4; ++j) o8[64 * j] = (unsigned long long)pg8::cvt_pk_bf16(v[j].x, v[j].y) | ((unsigned long long)pg8::cvt_pk_bf16(v[j].z, v[j].w) << 32);
    }
}

__device__ __forceinline__ void tr_item(const float* W, int N, bf16* WT, int K, int k0, int n0, int s0, bool perm, bool zero, LAS float* scr, int lane) {
    if (!zero) {
#pragma unroll 8
        for (int i = 0; i < 32; ++i) { const int kk = 2 * i + (lane >> 5); scr[kk * 33 + (lane & 31)] = W[(size_t)(k0 + kk) * N + s0 + (lane & 31)]; }
    }
    LDS_WAIT(); asm volatile("" ::: "memory");
    const int c = lane & 7;
#pragma unroll
    for (int j = 0; j < 4; ++j) { const int n = (lane >> 3) + 8 * j; const int sc = perm ? ridx(n) : n; const LAS float* s = scr + (8 * c) * 33 + sc;
        v4u o; o.x = pk2(s[0 * 33], s[1 * 33]); o.y = pk2(s[2 * 33], s[3 * 33]); o.z = pk2(s[4 * 33], s[5 * 33]); o.w = pk2(s[6 * 33], s[7 * 33]);
        if (zero) o = (v4u){0u, 0u, 0u, 0u};
        *(GAS v4u*)(WT + (size_t)(n0 + n) * K + k0 + 8 * c) = o; }
    LDS_WAIT(); asm volatile("" ::: "memory");
}
__device__ __forceinline__ void absorb_tile(const float* A, int lda, const float* B, int ldb, bool bjmajor, bf16* dst, int ldd, LAS float* As, LAS float* Bs, int t) {
#pragma unroll
    for (int i = 0; i < 2; ++i) { const int idx = t + 512 * i, row = idx >> 4, c4 = idx & 15; const f32x4 v = *(const f32x4*)(A + (size_t)row * lda + 4 * c4);
        As[(4 * c4) * 68 + row] = v.x; As[(4 * c4 + 1) * 68 + row] = v.y; As[(4 * c4 + 2) * 68 + row] = v.z; As[(4 * c4 + 3) * 68 + row] = v.w; }
    if (!bjmajor) {
#pragma unroll
        for (int i = 0; i < 4; ++i) { const int idx = t + 512 * i, row = idx >> 4, c4 = idx & 15; const f32x4 v = *(const f32x4*)(B + (size_t)row * ldb + 4 * c4);
            Bs[(4 * c4) * 132 + row] = v.x; Bs[(4 * c4 + 1) * 132 + row] = v.y; Bs[(4 * c4 + 2) * 132 + row] = v.z; Bs[(4 * c4 + 3) * 132 + row] = v.w; }
    } else {
#pragma unroll
        for (int i = 0; i < 4; ++i) { const int idx = t + 512 * i, j = idx >> 5, c4 = idx & 31; *(LAS f32x4*)(Bs + j * 132 + 4 * c4) = *(const f32x4*)(B + (size_t)j * ldb + 4 * c4); }
    }
    __syncthreads();
    const int tm = t & 15, tn = t >> 4; f32x4 acc[4];
#pragma unroll
    for (int ni = 0; ni < 4; ++ni) acc[ni] = (f32x4){0.f, 0.f, 0.f, 0.f};
#pragma unroll 8
    for (int j = 0; j < 64; ++j) { const f32x4 a4 = *(LAS f32x4*)(As + j * 68 + 4 * tm), b4 = *(LAS f32x4*)(Bs + j * 132 + 4 * tn);
        acc[0] += a4 * b4.x; acc[1] += a4 * b4.y; acc[2] += a4 * b4.z; acc[3] += a4 * b4.w; }
#pragma unroll
    for (int ni = 0; ni < 4; ++ni) *(unsigned long long*)(dst + (size_t)(4 * tn + ni) * ldd + 4 * tm) = (unsigned long long)pk2(acc[ni].x, acc[ni].y) | ((unsigned long long)pk2(acc[ni].z, acc[ni].w) << 32);
    __syncthreads();
}
struct Seg { const float* W; bf16* WT; int N, K, n0, s0, sstride, ng, perm, zero; };
__device__ __forceinline__ Seg get_seg(CArgs a, int L, int s) {
    unsigned char* wb = a->ws + WS_W + (size_t)L * WL; const float* win = a->in[9] + (size_t)L * DM * INC; bf16* wint = (bf16*)(wb + W_IN);
    Seg g{win, wint, INC, DM, 0, 0, 32, 0, 0, 0};
    switch (s) {
        case 0: g.n0 = 0; g.s0 = 0; g.ng = 48; break;
        case 1: g.n0 = 2560; g.s0 = 1536 + 64; g.sstride = 96; g.ng = 8; g.perm = 1; break;
        case 2: g.n0 = 2816; g.s0 = 2304; g.ng = 4; break;
        case 3: g.n0 = 2944; g.s0 = 2432; g.ng = 1; g.perm = 1; break;
        case 4: g.n0 = 2976; g.s0 = 0; g.sstride = 0; g.ng = 3; g.zero = 1; break;
        case 5: g.n0 = 3072; g.s0 = 2464; g.ng = 64; break;
        case 6: g.W = a->in[13] + (size_t)L * SBW * DM; g.WT = (bf16*)(wb + W_SB); g.N = DM; g.K = SBW; g.ng = 32; break;
        case 7: g.W = a->in[15] + (size_t)L * DM * DM; g.WT = (bf16*)(wb + W_OUT); g.N = DM; g.K = DM; g.ng = 32; break;
        case 8: g.W = a->in[20] + (size_t)L * DM * UPW; g.WT = (bf16*)(wb + W_UP); g.N = UPW; g.K = DM; g.ng = 176; break;
        case 9: g.W = a->in[23] + (size_t)L * DFF * DM; g.WT = (bf16*)(wb + W_DOWN); g.N = DM; g.K = DFF; g.ng = 32; break;
        case 10: g.W = a->in[24] + (size_t)L * DM * DM; g.WT = (bf16*)(wb + W_PG); g.N = DM; g.K = DM; g.ng = 32; break;
        default: g.W = a->in[25] + (size_t)L * DPLE * DM; g.WT = (bf16*)(wb + W_PP); g.N = DM; g.K = DPLE; g.ng = 32; break;
    }
    return g;
}
constexpr int NSEG = 12;

__device__ __forceinline__ void sincos_d(float ang, float& s, float& c) {
    const double x = (double)ang; const double q = rint(x * 0.63661977236758134308); const double r = x - q * 1.57079632679489661923; const double r2 = r * r;
    double sp = -2.5052108385441718775e-08; sp = sp * r2 + 2.7557319223985890653e-06; sp = sp * r2 - 1.9841269841269841270e-04; sp = sp * r2 + 8.3333333333333333333e-03; sp = sp * r2 - 1.6666666666666666667e-01; sp = r + r * r2 * sp;
    double cp = 2.0876756987868098979e-09; cp = cp * r2 - 2.7557319223985890653e-07; cp = cp * r2 + 2.4801587301587301587e-05; cp = cp * r2 - 1.3888888888888888889e-03; cp = cp * r2 + 4.1666666666666666667e-02; cp = cp * r2 - 0.5; cp = 1.0 + r2 * cp;
    const int qi = (int)((long long)q & 3);
    const double ss = (qi == 0) ? sp : (qi == 1) ? cp : (qi == 2) ? -sp : -cp;
    const double cc = (qi == 0) ? cp : (qi == 1) ? -sp : (qi == 2) ? -cp : sp;
    s = (float)ss; c = (float)cc;
}

__device__ __forceinline__ void p0_prologue(CArgs a, LAS unsigned char* lds, int vcu, int G, int wave, int lane) {
    const int gw = vcu * 8 + wave, NGW = G * 8, gt = gw * 64 + lane, NGT = NGW * 64;
    LAS float* scr = (LAS float*)(lds + wave * 16384);
    for (int L = 0; L < DEPTH; ++L)
        for (int s = 0; s < NSEG; ++s) { const Seg g = get_seg(a, L, s); const int nit = (g.K / 64) * g.ng;
            for (int it = gw; it < nit; it += NGW) { const int kb = it / g.ng, gi = it - kb * g.ng;
                tr_item(g.W, g.N, g.WT, g.K, 64 * kb, g.n0 + 32 * gi, g.s0 + g.sstride * gi, g.perm != 0, g.zero != 0, scr, lane); } }
    __syncthreads();
    for (int tix = vcu; tix < DEPTH * 256; tix += G) { const int L = tix >> 8, r = tix & 255;
        unsigned char* wb = a->ws + WS_W + (size_t)L * WL;
        if (r < 128) { const int h = r >> 4, kt = r & 15;
            absorb_tile(a->in[9] + (size_t)L * DM * INC + (size_t)(kt * 64) * INC + 1536 + 96 * h, INC, a->in[11] + (size_t)L * LORA * NHEAD * 64 + h * 64, NHEAD * 64, false,
                        (bf16*)(wb + W_IN) + (size_t)(1536 + h * 128) * DM + kt * 64, DM, (LAS float*)lds, (LAS float*)(lds + 32768), wave * 64 + lane);
        } else { const int r2 = r - 128, h = r2 >> 4, lt = (r2 >> 3) & 1, nt = r2 & 7;
            absorb_tile(a->in[12] + (size_t)L * LORA * NHEAD * 64 + ((size_t)(lt * 64) * NHEAD + h) * 64, NHEAD * 64, a->in[14] + (size_t)L * SBW * DM + (size_t)(h * 64) * DM + nt * 128, DM, true,
                        (bf16*)(wb + W_YB) + (size_t)(nt * 128) * QLW + h * 128 + lt * 64, QLW, (LAS float*)lds, (LAS float*)(lds + 32768), wave * 64 + lane);
        }
    }
    { float* tab = (float*)(a->ws + WS_ROPE);
        for (int e = gt; e < NSLOT * 16; e += NGT) { const int slot = e >> 4, i = e & 15; const int pos = slot < SEQ ? slot : PAST + (slot - SEQ);
            const float freq = exp2f(-(float)i * (13.287712379549449f / 16.0f));
            float s, c; sincos_d((float)pos * freq, s, c); tab[slot * 32 + i] = c; tab[slot * 32 + 16 + i] = s; } }
    for (int m = gw; m < R; m += NGW) { const float* xin = m < PR ? a->in[0] + (size_t)m * DM : a->in[1] + (size_t)(m - PR) * DM;
        row_op(lane, xin, nullptr, nullptr, nullptr, (bf16*)(a->ws + WS_XN) + (size_t)m * DM, a->in[16]); }
    for (int e = gt; e < DEPTH * R * (DPLE / 8); e += NGT) { const int c8 = e & 31, rr = e >> 5, L = rr / R, row = rr - L * R;
        const float* src = row < PR ? a->in[2] + ((size_t)L * PR + row) * DPLE + 8 * c8 : a->in[3] + ((size_t)L * SR + (row - PR)) * DPLE + 8 * c8;
        const f32x4 x0 = *(const f32x4*)src, x1 = *(const f32x4*)(src + 4);
        *(v4u*)((bf16*)(a->ws + WS_PB) + ((size_t)L * R + row) * DPLE + 8 * c8) = pack8(x0, x1); }
}

__device__ __forceinline__ void conv_phase(CArgs a, int L, int vcu, int G, int wave, int lane) {
    const int gw = vcu * 8 + wave, NGW = G * 8; constexpr int NCG = (DFF / 8 + 63) / 64;
    const bf16* U = (const bf16*)(a->ws + WS_U); bf16* ACT = (bf16*)(a->ws + WS_ACT);
    const float* cw = a->in[21] + (size_t)L * 3 * UPW; const float* cb = a->in[22] + (size_t)L * UPW;
    for (int it = gw; it < (R / 16) * NCG; it += NGW) { const int strip = it / NCG, cg = it - strip * NCG; const int c8 = cg * 64 + lane; if (c8 >= DFF / 8) continue;
        const int col = 8 * c8, r0 = strip * 16; const bool samp = r0 >= PR; const bool first = samp ? (((r0 - PR) & (DSEQ - 1)) == 0) : ((r0 & (SEQ - 1)) == 0);
        float w[2][3][8], bs[2][8], p2[2][8], p1[2][8];
#pragma unroll
        for (int gv = 0; gv < 2; ++gv) {
#pragma unroll
            for (int i = 0; i < 3; ++i) { const f32x4 x0 = *(const f32x4*)(cw + (size_t)i * UPW + gv * DFF + col), x1 = *(const f32x4*)(cw + (size_t)i * UPW + gv * DFF + col + 4);
                w[gv][i][0] = x0.x; w[gv][i][1] = x0.y; w[gv][i][2] = x0.z; w[gv][i][3] = x0.w; w[gv][i][4] = x1.x; w[gv][i][5] = x1.y; w[gv][i][6] = x1.z; w[gv][i][7] = x1.w; }
            const f32x4 b0 = *(const f32x4*)(cb + gv * DFF + col), b1 = *(const f32x4*)(cb + gv * DFF + col + 4);
            bs[gv][0] = b0.x; bs[gv][1] = b0.y; bs[gv][2] = b0.z; bs[gv][3] = b0.w; bs[gv][4] = b1.x; bs[gv][5] = b1.y; bs[gv][6] = b1.z; bs[gv][7] = b1.w;
            if (samp && first) { const float* st = a->in[8] + (((size_t)L * DBATCH + ((r0 - PR) >> 5)) * 2) * UPW + gv * DFF + col;
                const f32x4 a0 = *(const f32x4*)st, a1 = *(const f32x4*)(st + 4), c0 = *(const f32x4*)(st + UPW), c1 = *(const f32x4*)(st + UPW + 4);
                p2[gv][0] = a0.x; p2[gv][1] = a0.y; p2[gv][2] = a0.z; p2[gv][3] = a0.w; p2[gv][4] = a1.x; p2[gv][5] = a1.y; p2[gv][6] = a1.z; p2[gv][7] = a1.w;
                p1[gv][0] = c0.x; p1[gv][1] = c0.y; p1[gv][2] = c0.z; p1[gv][3] = c0.w; p1[gv][4] = c1.x; p1[gv][5] = c1.y; p1[gv][6] = c1.z; p1[gv][7] = c1.w;
            } else if (first) {
#pragma unroll
                for (int e = 0; e < 8; ++e) { p2[gv][e] = 0.f; p1[gv][e] = 0.f; }
            } else { const v4u x2 = *(const v4u*)(U + (size_t)(r0 - 2) * UPW + gv * DFF + col), x1 = *(const v4u*)(U + (size_t)(r0 - 1) * UPW + gv * DFF + col);
                p2[gv][0] = lo2f(x2.x); p2[gv][1] = hi2f(x2.x); p2[gv][2] = lo2f(x2.y); p2[gv][3] = hi2f(x2.y); p2[gv][4] = lo2f(x2.z); p2[gv][5] = hi2f(x2.z); p2[gv][6] = lo2f(x2.w); p2[gv][7] = hi2f(x2.w);
                p1[gv][0] = lo2f(x1.x); p1[gv][1] = hi2f(x1.x); p1[gv][2] = lo2f(x1.y); p1[gv][3] = hi2f(x1.y); p1[gv][4] = lo2f(x1.z); p1[gv][5] = hi2f(x1.z); p1[gv][6] = lo2f(x1.w); p1[gv][7] = hi2f(x1.w); }
        }
#pragma unroll 4
        for (int t = 0; t < 16; ++t) { const int row = r0 + t; float cur[2][8], uc[2][8];
#pragma unroll
            for (int gv = 0; gv < 2; ++gv) { const v4u x = *(const v4u*)(U + (size_t)row * UPW + gv * DFF + col);
                cur[gv][0] = lo2f(x.x); cur[gv][1] = hi2f(x.x); cur[gv][2] = lo2f(x.y); cur[gv][3] = hi2f(x.y); cur[gv][4] = lo2f(x.z); cur[gv][5] = hi2f(x.z); cur[gv][6] = lo2f(x.w); cur[gv][7] = hi2f(x.w);
#pragma unroll
                for (int e = 0; e < 8; ++e) { uc[gv][e] = bs[gv][e] + p2[gv][e] * w[gv][0][e] + p1[gv][e] * w[gv][1][e] + cur[gv][e] * w[gv][2][e]; p2[gv][e] = p1[gv][e]; p1[gv][e] = cur[gv][e]; } }
            float o[8];
#pragma unroll
            for (int e = 0; e < 8; ++e) { const float x = uc[0][e]; const float y = 1.5957691216057308f * (x + 0.044715f * x * x * x); o[e] = x * frcp(1.0f + fexp2(-LOG2E * y)) * uc[1][e]; }
            *(v4u*)(ACT + (size_t)row * DFF + col) = pack8((f32x4){o[0], o[1], o[2], o[3]}, (f32x4){o[4], o[5], o[6], o[7]}); }
    }
}

__device__ __forceinline__ void naive_sb(CArgs a, int L, int vcu, int G, int wave, int lane) {
    const int gw = vcu * 8 + wave, NGW = G * 8;
    const bf16* QSB = (const bf16*)(a->ws + WS_QSB); const bf16* KSB = (const bf16*)(a->ws + WS_KSB); const bf16* VSB = (const bf16*)(a->ws + WS_VSB); bf16* OSB = (bf16*)(a->ws + WS_OSB);
    constexpr int NP = NB * NHEAD * (SEQ / 64), NS = DBATCH * NHEAD;
    for (int it = gw + (FAST_SB ? NP : 0); it < NP + (FAST_SSB ? 0 : NS); it += NGW) {
        const bool samp = it >= NP; int b, h, t, qrow, nown, rowbase;
        if (!samp) { b = it >> 8; h = (it >> 5) & 7; int tb = it & 31; if ((it / NGW) & 1) tb = 31 - tb; t = tb * 64 + lane; rowbase = b * SEQ; qrow = rowbase + t; nown = tb * 64 + 63; }
        else { const int bh = it - NP; b = bh >> 3; h = bh & 7; t = lane & 31; rowbase = PR + b * DSEQ; qrow = rowbase + t; nown = DSEQ - 1; }
        b = __builtin_amdgcn_readfirstlane(b); h = __builtin_amdgcn_readfirstlane(h); rowbase = __builtin_amdgcn_readfirstlane(rowbase); nown = __builtin_amdgcn_readfirstlane(nown);
        float q[64], o[64];
        { const v4u* qp = (const v4u*)(QSB + (size_t)qrow * SBW + h * 64);
#pragma unroll
            for (int c = 0; c < 8; ++c) { const v4u x = qp[c]; q[8 * c] = lo2f(x.x); q[8 * c + 1] = hi2f(x.x); q[8 * c + 2] = lo2f(x.y); q[8 * c + 3] = hi2f(x.y); q[8 * c + 4] = lo2f(x.z); q[8 * c + 5] = hi2f(x.z); q[8 * c + 6] = lo2f(x.w); q[8 * c + 7] = hi2f(x.w); } }
#pragma unroll
        for (int d = 0; d < 64; ++d) o[d] = 0.f;
        float carry = 1.0f; int vz = 0; asm volatile("" : "+v"(vz));
        for (int s = nown - 1; s >= 0; --s) {
            const v4u* kp = (const v4u*)(KSB + (size_t)(rowbase + s) * SBW + h * 64 + vz); const v4u* vp = (const v4u*)(VSB + (size_t)(rowbase + s) * SBW + h * 64 + vz);
            float z = 0.f;
#pragma unroll
            for (int c = 0; c < 8; ++c) { const v4u x = kp[c]; z += q[8 * c] * lo2f(x.x) + q[8 * c + 1] * hi2f(x.x) + q[8 * c + 2] * lo2f(x.y) + q[8 * c + 3] * hi2f(x.y) + q[8 * c + 4] * lo2f(x.z) + q[8 * c + 5] * hi2f(x.z) + q[8 * c + 6] * lo2f(x.w) + q[8 * c + 7] * hi2f(x.w); }
            const float e = fexp2(z), rr = frcp(1.0f + e), beta = 1.0f - rr; const bool vis = s < t;
            const float w = vis ? beta * carry : 0.f; carry = vis ? carry * rr : carry;
#pragma unroll
            for (int c = 0; c < 8; ++c) { const v4u x = vp[c]; o[8 * c] += w * lo2f(x.x); o[8 * c + 1] += w * hi2f(x.x); o[8 * c + 2] += w * lo2f(x.y); o[8 * c + 3] += w * hi2f(x.y); o[8 * c + 4] += w * lo2f(x.z); o[8 * c + 5] += w * hi2f(x.z); o[8 * c + 6] += w * lo2f(x.w); o[8 * c + 7] += w * hi2f(x.w); }
        }
        if (samp) {
            const float* ck = a->in[4] + ((((size_t)L * DBATCH + b) * PAST) * NHEAD + h) * 64; const float* cv = a->in[5] + ((((size_t)L * DBATCH + b) * PAST) * NHEAD + h) * 64;
            for (int s = PAST - 1; s >= 0; --s) { const f32x4* kp = (const f32x4*)(ck + (size_t)s * SBW + vz); const f32x4* vp = (const f32x4*)(cv + (size_t)s * SBW + vz);
                float z = 0.f;
#pragma unroll
                for (int c = 0; c < 16; ++c) { const f32x4 x = kp[c]; z += q[4 * c] * x.x + q[4 * c + 1] * x.y + q[4 * c + 2] * x.z + q[4 * c + 3] * x.w; }
                const float e = fexp2(z), rr = frcp(1.0f + e), beta = 1.0f - rr; const float w = beta * carry; carry *= rr;
#pragma unroll
                for (int c = 0; c < 16; ++c) { const f32x4 x = vp[c]; o[4 * c] += w * x.x; o[4 * c + 1] += w * x.y; o[4 * c + 2] += w * x.z; o[4 * c + 3] += w * x.w; }
            }
        }
        if (!samp || lane < 32) { v4u* op = (v4u*)(OSB + (size_t)qrow * SBW + h * 64);
#pragma unroll
            for (int c = 0; c < 8; ++c) op[c] = pack8((f32x4){o[8 * c], o[8 * c + 1], o[8 * c + 2], o[8 * c + 3]}, (f32x4){o[8 * c + 4], o[8 * c + 5], o[8 * c + 6], o[8 * c + 7]}); }
    }
}
__device__ __forceinline__ void naive_mla(CArgs a, int L, int vcu, int G, int wave, int lane) {
    const int gw = vcu * 8 + wave, NGW = G * 8;
    const bf16* QLAT = (const bf16*)(a->ws + WS_QLAT); const bf16* QROPE = (const bf16*)(a->ws + WS_QROPE); const bf16* CKVB = (const bf16*)(a->ws + WS_CKVB); const bf16* KRB = (const bf16*)(a->ws + WS_KRB);
    bf16* OLAT = (bf16*)(a->ws + WS_OLAT);
    for (int it = gw + (FAST_MLA ? PR * NHEAD : 0); it < (FAST_SMLA ? PR : R) * NHEAD; it += NGW) { const int row = it >> 3, h = it & 7; const bool samp = row >= PR;
        const unsigned qw = *(const unsigned*)(QLAT + (size_t)row * QLW + h * 128 + 2 * lane); const float q0 = lo2f(qw), q1 = hi2f(qw);
        const float qr = lane < 32 ? bf2f(QROPE[(size_t)row * QRW + h * 32 + lane]) : 0.f;
        int rowbase, nk; if (!samp) { rowbase = row & ~(SEQ - 1); nk = 64 * (((row & (SEQ - 1)) >> 6) + 1); } else { rowbase = PR + (((row - PR) >> 5) << 5); nk = DSEQ; }
        float m = -INFINITY, l = 0.f, o0 = 0.f, o1 = 0.f;
        for (int s = 0; s < nk; s += 4) { float sc[4], c0[4], c1[4];
#pragma unroll
            for (int j = 0; j < 4; ++j) { const size_t kr = (size_t)(rowbase + s + j); const unsigned cw = *(const unsigned*)(CKVB + kr * LORA + 2 * lane); c0[j] = lo2f(cw); c1[j] = hi2f(cw);
                const float r = lane < 32 ? bf2f(KRB[kr * ROPE + lane]) : 0.f; sc[j] = q0 * c0[j] + q1 * c1[j] + qr * r; }
#pragma unroll
            for (int off = 1; off < 64; off <<= 1) {
#pragma unroll
                for (int j = 0; j < 4; ++j) sc[j] += __shfl_xor(sc[j], off); }
#pragma unroll
            for (int j = 0; j < 4; ++j) { const float mn = fmaxf(m, sc[j]), al = fexp2(m - mn), p = fexp2(sc[j] - mn); l = l * al + p; o0 = o0 * al + p * c0[j]; o1 = o1 * al + p * c1[j]; m = mn; }
        }
        if (samp) { const int b = (row - PR) >> 5; const float* cc = a->in[6] + ((size_t)L * DBATCH + b) * PAST * LORA; const float* cr = a->in[7] + ((size_t)L * DBATCH + b) * PAST * ROPE; const int ri = ridx(lane & 31);
            for (int s = 0; s < PAST; s += 4) { float sc[4], c0[4], c1[4];
#pragma unroll
                for (int j = 0; j < 4; ++j) { const float2 cv = *(const float2*)(cc + (size_t)(s + j) * LORA + 2 * lane); c0[j] = cv.x; c1[j] = cv.y;
                    const float r = lane < 32 ? cr[(size_t)(s + j) * ROPE + ri] : 0.f; sc[j] = q0 * c0[j] + q1 * c1[j] + qr * r; }
#pragma unroll
                for (int off = 1; off < 64; off <<= 1) {
#pragma unroll
                    for (int j = 0; j < 4; ++j) sc[j] += __shfl_xor(sc[j], off); }
#pragma unroll
                for (int j = 0; j < 4; ++j) { const float mn = fmaxf(m, sc[j]), al = fexp2(m - mn), p = fexp2(sc[j] - mn); l = l * al + p; o0 = o0 * al + p * c0[j]; o1 = o1 * al + p * c1[j]; m = mn; }
            } }
        const float il = 1.0f / l;
        *(unsigned*)(OLAT + (size_t)row * QLW + h * 128 + 2 * lane) = pg8::cvt_pk_bf16(o0 * il, o1 * il);
    }
}


typedef float f32x16 __attribute__((ext_vector_type(16)));
typedef short s16x4 __attribute__((ext_vector_type(4)));
typedef short v4i16_t __attribute__((ext_vector_type(4)));
__device__ __forceinline__ int crow(int r, int hi) { return (r & 3) + 8 * (r >> 2) + 4 * hi; }
__device__ __forceinline__ s16x4 vtr(LAS unsigned char* p) { return __builtin_bit_cast(s16x4, __builtin_amdgcn_ds_read_tr16_b64_v4i16((LAS v4i16_t*)p)); }
__device__ __forceinline__ bf16x8 cat8(s16x4 lo, s16x4 hi) { return (bf16x8){lo[0], lo[1], lo[2], lo[3], hi[0], hi[1], hi[2], hi[3]}; }
__device__ __forceinline__ bf16x8 pk8(const f32x16& w, int b) { v4u u; u.x = pg8::cvt_pk_bf16_c(w[b], w[b + 1]); u.y = pg8::cvt_pk_bf16_c(w[b + 2], w[b + 3]); u.z = pg8::cvt_pk_bf16_c(w[b + 4], w[b + 5]); u.w = pg8::cvt_pk_bf16_c(w[b + 6], w[b + 7]); return __builtin_bit_cast(bf16x8, u); }
#define ATT_WAITBAR() do { asm volatile("s_waitcnt vmcnt(0) lgkmcnt(0)" ::: "memory"); __builtin_amdgcn_s_barrier(); asm volatile("" ::: "memory"); } while (0)

#ifndef SB_EARLY
#define SB_EARLY 1
#endif
constexpr float SB_TINY = 7.8886090522101181e-31f;
constexpr int SBA_K = 0, SBA_V = 16384, SBA_ST = 32768, SBA_FL = 65536;
__device__ __forceinline__ void sb_unit(const bf16* QSB, const bf16* KSB, const bf16* VSB, bf16* OSB, int rowbase, int h, int qb, LAS unsigned char* lds, int wave, int lane) {
    const int r32 = lane & 31, hi = lane >> 5; const int q0 = qb * 256, rowmin = q0 + 32 * wave, NT = 4 * qb + 4;
    const bf16* ksrc = KSB + (size_t)(rowbase + lane) * SBW + h * 64 + wave * 8;
    const bf16* vsrc = VSB + (size_t)(rowbase + 16 * (wave & 3) + (lane >> 2)) * SBW + h * 64 + (wave >> 2) * 32 + (lane & 3) * 8;
#define SB_DMA(j, bsel) do { __builtin_amdgcn_global_load_lds((const unsigned*)(ksrc + (size_t)(j) * 64 * SBW), (LAS unsigned*)(lds + SBA_K + (bsel) * 8192 + wave * 1024), 16, 0, 0); \
                             __builtin_amdgcn_global_load_lds((const unsigned*)(vsrc + (size_t)(j) * 64 * SBW), (LAS unsigned*)(lds + SBA_V + (bsel) * 8192 + wave * 1024), 16, 0, 0); } while (0)
    SB_DMA(NT - 1, 0);
    bf16x8 qr[4]; { const bf16* qp = QSB + (size_t)(rowbase + rowmin + r32) * SBW + h * 64 + hi * 8;
#pragma unroll
        for (int d0 = 0; d0 < 4; ++d0) qr[d0] = *(const bf16x8*)(qp + d0 * 16); }
    f32x16 o0 = {}, o1 = {}; float carry = 1.0f; bool wdone = false;
    ATT_WAITBAR();
    for (int it = 0; it < NT; ++it) { const int jt = NT - 1 - it, cur = it & 1;
        if (jt > 0) SB_DMA(jt - 1, cur ^ 1);
        const int kmin = 64 * jt;
        if (kmin < rowmin + 32 && !(SB_EARLY && wdone)) {
            LAS unsigned char* Kb = lds + SBA_K + cur * 8192 + hi * 1024 + r32 * 16;
            f32x16 p0 = {}, p1 = {};
            { bf16x8 kf[8];
#pragma unroll
              for (int d0 = 0; d0 < 4; ++d0) { kf[2 * d0] = *(LAS bf16x8*)(Kb + d0 * 2048); kf[2 * d0 + 1] = *(LAS bf16x8*)(Kb + d0 * 2048 + 512); }
              __builtin_amdgcn_sched_barrier(0);
#pragma unroll
              for (int d0 = 0; d0 < 4; ++d0) { p0 = __builtin_amdgcn_mfma_f32_32x32x16_bf16(kf[2 * d0], qr[d0], p0, 0, 0, 0); p1 = __builtin_amdgcn_mfma_f32_32x32x16_bf16(kf[2 * d0 + 1], qr[d0], p1, 0, 0, 0); }
              __builtin_amdgcn_sched_barrier(0); }
            if (kmin + 64 > rowmin) {
                const int t = rowmin + r32, kb = kmin + 4 * hi;
#pragma unroll
                for (int r = 0; r < 16; ++r) { const int kv = kb + (r & 3) + 8 * (r >> 2); if (kv >= t) p0[r] = -INFINITY; if (kv + 32 >= t) p1[r] = -INFINITY; }
            }
#pragma unroll
            for (int r = 0; r < 16; ++r) { p0[r] = frcp(1.0f + fexp2(p0[r])); p1[r] = frcp(1.0f + fexp2(p1[r])); }
            float GA[8];
#pragma unroll
            for (int k = 0; k < 4; ++k) { GA[k] = (p0[4 * k] * p0[4 * k + 1]) * (p0[4 * k + 2] * p0[4 * k + 3]); GA[4 + k] = (p1[4 * k] * p1[4 * k + 1]) * (p1[4 * k + 2] * p1[4 * k + 3]); }
            float SG[8]; float T = carry;
#pragma unroll
            for (int kk = 7; kk >= 0; --kk) { const auto sw = __builtin_amdgcn_permlane32_swap(__float_as_uint(GA[kk]), __float_as_uint(GA[kk]), false, false);
                const float G0 = __uint_as_float(sw[0]), G1 = __uint_as_float(sw[1]);
                const float s1 = T; T *= G1; const float s0 = T; T *= G0; SG[kk] = hi ? s1 : s0; }
            carry = T;
            f32x16 w0, w1;
#pragma unroll
            for (int k = 0; k < 4; ++k) {
                { float t = SG[k]; w0[4 * k + 3] = t * (1.0f - p0[4 * k + 3]); t *= p0[4 * k + 3]; w0[4 * k + 2] = t * (1.0f - p0[4 * k + 2]); t *= p0[4 * k + 2];
                  w0[4 * k + 1] = t * (1.0f - p0[4 * k + 1]); t *= p0[4 * k + 1]; w0[4 * k] = t * (1.0f - p0[4 * k]); }
                { float t = SG[4 + k]; w1[4 * k + 3] = t * (1.0f - p1[4 * k + 3]); t *= p1[4 * k + 3]; w1[4 * k + 2] = t * (1.0f - p1[4 * k + 2]); t *= p1[4 * k + 2];
                  w1[4 * k + 1] = t * (1.0f - p1[4 * k + 1]); t *= p1[4 * k + 1]; w1[4 * k] = t * (1.0f - p1[4 * k]); } }
            const bf16x8 pa0 = pk8(w0, 0), pa1 = pk8(w0, 8), pa2 = pk8(w1, 0), pa3 = pk8(w1, 8);
            LAS unsigned char* vb = lds + SBA_V + cur * 8192 + ((lane >> 4) & 1) * 32 + (lane & 3) * 8 + (4 * hi + ((lane & 15) >> 2)) * 64;
            { bf16x8 vf[8];
#pragma unroll
              for (int ks = 0; ks < 4; ++ks) { vf[2 * ks] = cat8(vtr(vb + ks * 1024), vtr(vb + ks * 1024 + 512)); vf[2 * ks + 1] = cat8(vtr(vb + 4096 + ks * 1024), vtr(vb + 4096 + ks * 1024 + 512)); }
              __builtin_amdgcn_sched_barrier(0);
#pragma unroll
              for (int ks = 0; ks < 4; ++ks) { const bf16x8 pa = ks == 0 ? pa0 : ks == 1 ? pa1 : ks == 2 ? pa2 : pa3;
                  o0 = __builtin_amdgcn_mfma_f32_32x32x16_bf16(pa, vf[2 * ks], o0, 0, 0, 0); o1 = __builtin_amdgcn_mfma_f32_32x32x16_bf16(pa, vf[2 * ks + 1], o1, 0, 0, 0); }
              __builtin_amdgcn_sched_barrier(0); }
        }
#if SB_EARLY
        wdone = __all(carry < SB_TINY);
        { LAS unsigned* fl = (LAS unsigned*)(lds + SBA_FL) + (it & 1) * 8; if (lane == 0) fl[wave] = wdone ? 1u : 0u;
          ATT_WAITBAR();
          const unsigned f = (fl[0] & fl[1]) & (fl[2] & fl[3]) & (fl[4] & fl[5]) & (fl[6] & fl[7]);
          if (f) break; }
#else
        ATT_WAITBAR();
#endif
    }
#undef SB_DMA
    { LAS unsigned short* stg = (LAS unsigned short*)(lds + SBA_ST + wave * 4096);
#pragma unroll
        for (int r = 0; r < 16; ++r) { const int orow = crow(r, hi); stg[orow * 64 + r32] = (unsigned short)f2bf(o0[r]); stg[orow * 64 + 32 + r32] = (unsigned short)f2bf(o1[r]); }
        asm volatile("s_waitcnt lgkmcnt(0)" ::: "memory");
        bf16* op = OSB + (size_t)(rowbase + rowmin) * SBW + h * 64;
#pragma unroll
        for (int i = 0; i < 4; ++i) { const int row = i * 8 + (lane >> 3), ch = lane & 7; const v4u v = *(LAS v4u*)(stg + row * 64 + ch * 8); *(v4u*)(op + (size_t)row * SBW + ch * 8) = v; }
        asm volatile("s_waitcnt lgkmcnt(0)" ::: "memory");
    }
}
__device__ __forceinline__ void sb_prompt(CArgs a, LAS unsigned char* lds, int vcu, int G, int wave, int lane) {
    const bf16* QSB = (const bf16*)(a->ws + WS_QSB); const bf16* KSB = (const bf16*)(a->ws + WS_KSB); const bf16* VSB = (const bf16*)(a->ws + WS_VSB); bf16* OSB = (bf16*)(a->ws + WS_OSB);
    for (int u = vcu; u < NB * NHEAD * 8; u += G) { const int i = u >> 8, v = u & 255, bh = v >> 1, s = v & 1; const int qb = i == 0 ? s : i == 1 ? 7 - s : i == 2 ? 2 + s : 5 - s;
        sb_unit(QSB, KSB, VSB, OSB, (bh >> 3) * SEQ, bh & 7, qb, lds, wave, lane); }
}

constexpr int MLA_K = 0, MLA_V = 40960, MLA_WS = 73728, MLA_ST = 0;
__device__ __forceinline__ void mla_unit(const bf16* QLAT, const bf16* QROPE, const bf16* CKVB, const bf16* KRB, bf16* OLAT, int rowbase, int qb32, LAS unsigned char* lds, int wave, int lane) {
    const int r32 = lane & 31, hi = lane >> 5, h = wave; const int NT = (qb32 >> 1) + 1; const int qrow = rowbase + 32 * qb32;
    const bf16* kc0 = CKVB + (size_t)(rowbase + lane) * LORA + wave * 8;
    const bf16* kr0 = KRB + (size_t)(rowbase + lane) * ROPE + (wave & 3) * 8;
    const bf16* vs0 = CKVB + (size_t)(rowbase + 16 * (wave & 3) + (lane >> 2)) * LORA + (wave >> 2) * 32 + (lane & 3) * 8;
#define MLA_DMA(j, bsel) do { LAS unsigned char* kd = lds + MLA_K + (bsel) * 20480; LAS unsigned char* vd = lds + MLA_V + (bsel) * 16384; \
        __builtin_amdgcn_global_load_lds((const unsigned*)(kc0 + (size_t)(j) * 64 * LORA), (LAS unsigned*)(kd + wave * 1024), 16, 0, 0); \
        __builtin_amdgcn_global_load_lds((const unsigned*)(kc0 + (size_t)(j) * 64 * LORA + 64), (LAS unsigned*)(kd + (wave + 8) * 1024), 16, 0, 0); \
        if (wave < 4) __builtin_amdgcn_global_load_lds((const unsigned*)(kr0 + (size_t)(j) * 64 * ROPE), (LAS unsigned*)(kd + (16 + wave) * 1024), 16, 0, 0); \
        __builtin_amdgcn_global_load_lds((const unsigned*)(vs0 + (size_t)(j) * 64 * LORA), (LAS unsigned*)(vd + wave * 1024), 16, 0, 0); \
        __builtin_amdgcn_global_load_lds((const unsigned*)(vs0 + (size_t)(j) * 64 * LORA + 64), (LAS unsigned*)(vd + (wave + 8) * 1024), 16, 0, 0); } while (0)
    MLA_DMA(0, 0);
    bf16x8 qr[10]; { const bf16* qp = QLAT + (size_t)(qrow + r32) * QLW + h * 128 + hi * 8; const bf16* rp = QROPE + (size_t)(qrow + r32) * QRW + h * 32 + hi * 8;
#pragma unroll
        for (int d0 = 0; d0 < 8; ++d0) qr[d0] = *(const bf16x8*)(qp + d0 * 16);
        qr[8] = *(const bf16x8*)rp; qr[9] = *(const bf16x8*)(rp + 16); }
    f32x16 o[4]; o[0] = f32x16{}; o[1] = f32x16{}; o[2] = f32x16{}; o[3] = f32x16{};
    float m = -INFINITY, l = 0.f; LAS float* wsf = (LAS float*)(lds + MLA_WS) + wave * 64;
    ATT_WAITBAR();
    for (int jt = 0; jt < NT; ++jt) { const int cur = jt & 1;
        if (jt + 1 < NT) MLA_DMA(jt + 1, cur ^ 1);
        LAS unsigned char* Kb = lds + MLA_K + cur * 20480 + hi * 1024 + r32 * 16;
        f32x16 p0 = {}, p1 = {};
        {
            bf16x8 ka[5], kb[5];
#define MLA_LDK(dst, f0) _Pragma("unroll") for (int i_ = 0; i_ < 5; ++i_) { const int f_ = (f0) + i_; dst[i_] = *(LAS bf16x8*)(Kb + (f_ >> 1) * 2048 + (f_ & 1) * 512); }
#define MLA_MMK(src, f0) _Pragma("unroll") for (int i_ = 0; i_ < 5; ++i_) { const int f_ = (f0) + i_; if (f_ & 1) p1 = __builtin_amdgcn_mfma_f32_32x32x16_bf16(src[i_], qr[f_ >> 1], p1, 0, 0, 0); else p0 = __builtin_amdgcn_mfma_f32_32x32x16_bf16(src[i_], qr[f_ >> 1], p0, 0, 0, 0); }
            MLA_LDK(ka, 0); __builtin_amdgcn_sched_barrier(0);
            MLA_LDK(kb, 5); MLA_MMK(ka, 0); __builtin_amdgcn_sched_barrier(0);
            MLA_LDK(ka, 10); MLA_MMK(kb, 5); __builtin_amdgcn_sched_barrier(0);
            MLA_LDK(kb, 15); MLA_MMK(ka, 10); __builtin_amdgcn_sched_barrier(0);
            MLA_MMK(kb, 15); __builtin_amdgcn_sched_barrier(0);
#undef MLA_LDK
#undef MLA_MMK
        }
        float mx = fmaxf(p0[0], p1[0]);
#pragma unroll
        for (int r = 1; r < 16; ++r) mx = fmaxf(mx, fmaxf(p0[r], p1[r]));
        { const auto sw = __builtin_amdgcn_permlane32_swap(__float_as_uint(mx), __float_as_uint(mx), false, false); mx = fmaxf(__uint_as_float(sw[0]), __uint_as_float(sw[1])); }
        const float mn = fmaxf(m, mx), al = fexp2(m - mn); m = mn;
        float ps = 0.f;
#pragma unroll
        for (int r = 0; r < 16; ++r) { p0[r] = fexp2(p0[r] - mn); p1[r] = fexp2(p1[r] - mn); ps += p0[r] + p1[r]; }
        l = l * al + ps;
        if (__any(al != 1.0f)) {
            if (hi == 0) wsf[r32] = al;
            asm volatile("s_waitcnt lgkmcnt(0)" ::: "memory");
#pragma unroll
            for (int r = 0; r < 16; ++r) { const float f = wsf[crow(r, hi)]; o[0][r] *= f; o[1][r] *= f; o[2][r] *= f; o[3][r] *= f; }
        }
        const bf16x8 pa0 = pk8(p0, 0), pa1 = pk8(p0, 8), pa2 = pk8(p1, 0), pa3 = pk8(p1, 8);
        LAS unsigned char* vb = lds + MLA_V + cur * 16384 + ((lane >> 4) & 1) * 32 + (lane & 3) * 8 + (4 * hi + ((lane & 15) >> 2)) * 64;
        {
            bf16x8 va[4], vc[4];
#define MLA_LDV(dst, ks) _Pragma("unroll") for (int d_ = 0; d_ < 4; ++d_) dst[d_] = cat8(vtr(vb + d_ * 4096 + (ks) * 1024), vtr(vb + d_ * 4096 + (ks) * 1024 + 512));
#define MLA_MMV(src, pa) _Pragma("unroll") for (int d_ = 0; d_ < 4; ++d_) o[d_] = __builtin_amdgcn_mfma_f32_32x32x16_bf16(pa, src[d_], o[d_], 0, 0, 0);
            MLA_LDV(va, 0); __builtin_amdgcn_sched_barrier(0);
            MLA_LDV(vc, 1); MLA_MMV(va, pa0); __builtin_amdgcn_sched_barrier(0);
            MLA_LDV(va, 2); MLA_MMV(vc, pa1); __builtin_amdgcn_sched_barrier(0);
            MLA_LDV(vc, 3); MLA_MMV(va, pa2); __builtin_amdgcn_sched_barrier(0);
            MLA_MMV(vc, pa3); __builtin_amdgcn_sched_barrier(0);
#undef MLA_LDV
#undef MLA_MMV
        }
        ATT_WAITBAR();
    }
#undef MLA_DMA
    { const auto sw = __builtin_amdgcn_permlane32_swap(__float_as_uint(l), __float_as_uint(l), false, false); l = __uint_as_float(sw[0]) + __uint_as_float(sw[1]); }
    if (hi == 0) wsf[r32] = 1.0f / l;
    asm volatile("s_waitcnt lgkmcnt(0)" ::: "memory");
    { LAS unsigned short* stg = (LAS unsigned short*)(lds + MLA_ST + wave * 8192);
#pragma unroll
        for (int r = 0; r < 16; ++r) { const int orow = crow(r, hi); const float f = wsf[orow];
#pragma unroll
            for (int d0 = 0; d0 < 4; ++d0) stg[orow * 128 + d0 * 32 + r32] = (unsigned short)f2bf(o[d0][r] * f); }
        asm volatile("s_waitcnt lgkmcnt(0)" ::: "memory");
        bf16* op = OLAT + (size_t)qrow * QLW + h * 128;
#pragma unroll
        for (int i = 0; i < 8; ++i) { const int row = i * 4 + (lane >> 4), ch = lane & 15; const v4u v = *(LAS v4u*)(stg + row * 128 + ch * 8); *(v4u*)(op + (size_t)row * QLW + ch * 8) = v; }
    }
    ATT_WAITBAR();
}
__device__ __forceinline__ void mla_prompt(CArgs a, LAS unsigned char* lds, int vcu, int G, int wave, int lane) {
    const bf16* QLAT = (const bf16*)(a->ws + WS_QLAT); const bf16* QROPE = (const bf16*)(a->ws + WS_QROPE); const bf16* CKVB = (const bf16*)(a->ws + WS_CKVB); const bf16* KRB = (const bf16*)(a->ws + WS_KRB); bf16* OLAT = (bf16*)(a->ws + WS_OLAT);
    for (int u = vcu; u < NB * 64; u += G) { const int i = u >> 8, v = u & 255, b = v >> 4, s = v & 15; const int qb32 = i == 0 ? s : i == 1 ? 63 - s : i == 2 ? 16 + s : 47 - s;
        mla_unit(QLAT, QROPE, CKVB, KRB, OLAT, b * SEQ, qb32, lds, wave, lane); }
}


constexpr int SSB_V = 0, SSB_T = 65536, SSB_F = 65536 + 2048;
__device__ __forceinline__ bf16x8 cvt8(f32x4 a, f32x4 b) { return __builtin_bit_cast(bf16x8, pack8c(a, b)); }
__device__ __forceinline__ void ssb_unit(CArgs a, int L, int b, int h, LAS unsigned char* lds, int wave, int lane) {
    const int r32 = lane & 31, hi = lane >> 5; const int rowbase = PR + b * DSEQ;
    const bf16* QSB = (const bf16*)(a->ws + WS_QSB); const bf16* KSB = (const bf16*)(a->ws + WS_KSB); const bf16* VSB = (const bf16*)(a->ws + WS_VSB); bf16* OSB = (bf16*)(a->ws + WS_OSB);
    const float* ck = a->in[4] + ((((size_t)L * DBATCH + b) * PAST) * NHEAD + h) * 64; const float* cv = a->in[5] + ((((size_t)L * DBATCH + b) * PAST) * NHEAD + h) * 64;
    bf16x8 qr[4]; { const bf16* qp = QSB + (size_t)(rowbase + r32) * SBW + h * 64 + hi * 8;
#pragma unroll
        for (int d0 = 0; d0 < 4; ++d0) qr[d0] = *(const bf16x8*)(qp + d0 * 16); }
    f32x16 o0 = {}, o1 = {}; float cacc = 1.0f;
    LAS unsigned char* vreg = lds + SSB_V + wave * 8192; LAS float* Tx = (LAS float*)(lds + SSB_T);
    for (int rd = 0; rd < 9; ++rd) { const int ut = 57 - 8 * rd + wave;
        f32x16 w0 = {}, w1 = {}; float T = 1.0f;
        if (ut >= 0) {
            bf16x8 kf[8];
            if (ut == 64) {
#pragma unroll
                for (int d0 = 0; d0 < 4; ++d0) { kf[2 * d0] = *(const bf16x8*)(KSB + (size_t)(rowbase + r32) * SBW + h * 64 + d0 * 16 + hi * 8); kf[2 * d0 + 1] = (bf16x8){0, 0, 0, 0, 0, 0, 0, 0}; }
                const v4u z4 = {0u, 0u, 0u, 0u};
#pragma unroll
                for (int pc = 0; pc < 8; ++pc) { v4u x = z4; if (lane < 32) x = *(const v4u*)(VSB + (size_t)(rowbase + lane) * SBW + h * 64 + pc * 8);
                    *(LAS v4u*)(vreg + (pc >> 2) * 4096 + lane * 64 + (pc & 3) * 16) = x; }
            } else {
                const float* kp = ck + (size_t)(64 * ut + r32) * SBW + hi * 8; const float* vp = cv + (size_t)(64 * ut + lane) * SBW;
                f32x4 kx[16], vx[16];
#pragma unroll
                for (int d0 = 0; d0 < 4; ++d0) { kx[4 * d0] = *(const f32x4*)(kp + d0 * 16); kx[4 * d0 + 1] = *(const f32x4*)(kp + d0 * 16 + 4);
                    kx[4 * d0 + 2] = *(const f32x4*)(kp + (size_t)32 * SBW + d0 * 16); kx[4 * d0 + 3] = *(const f32x4*)(kp + (size_t)32 * SBW + d0 * 16 + 4); }
#pragma unroll
                for (int i = 0; i < 16; ++i) vx[i] = *(const f32x4*)(vp + 4 * i);
#pragma unroll
                for (int d0 = 0; d0 < 4; ++d0) { kf[2 * d0] = cvt8(kx[4 * d0], kx[4 * d0 + 1]); kf[2 * d0 + 1] = cvt8(kx[4 * d0 + 2], kx[4 * d0 + 3]); }
#pragma unroll
                for (int pc = 0; pc < 8; ++pc) *(LAS v4u*)(vreg + (pc >> 2) * 4096 + lane * 64 + (pc & 3) * 16) = pack8c(vx[2 * pc], vx[2 * pc + 1]);
            }
            f32x16 p0 = {}, p1 = {};
#pragma unroll
            for (int d0 = 0; d0 < 4; ++d0) { p0 = __builtin_amdgcn_mfma_f32_32x32x16_bf16(kf[2 * d0], qr[d0], p0, 0, 0, 0); p1 = __builtin_amdgcn_mfma_f32_32x32x16_bf16(kf[2 * d0 + 1], qr[d0], p1, 0, 0, 0); }
            if (ut == 64) {
#pragma unroll
                for (int r = 0; r < 16; ++r) { const int kv = 4 * hi + (r & 3) + 8 * (r >> 2); if (kv >= r32) p0[r] = -INFINITY; p1[r] = -INFINITY; }
            }
#pragma unroll
            for (int r = 0; r < 16; ++r) { p0[r] = frcp(1.0f + fexp2(p0[r])); p1[r] = frcp(1.0f + fexp2(p1[r])); }
            float GA[8];
#pragma unroll
            for (int k = 0; k < 4; ++k) { GA[k] = (p0[4 * k] * p0[4 * k + 1]) * (p0[4 * k + 2] * p0[4 * k + 3]); GA[4 + k] = (p1[4 * k] * p1[4 * k + 1]) * (p1[4 * k + 2] * p1[4 * k + 3]); }
            float SG[8];
#pragma unroll
            for (int kk = 7; kk >= 0; --kk) { const auto sw = __builtin_amdgcn_permlane32_swap(__float_as_uint(GA[kk]), __float_as_uint(GA[kk]), false, false);
                const float G0 = __uint_as_float(sw[0]), G1 = __uint_as_float(sw[1]); const float s1 = T; T *= G1; const float s0 = T; T *= G0; SG[kk] = hi ? s1 : s0; }
#pragma unroll
            for (int k = 0; k < 4; ++k) {
                { float t = SG[k]; w0[4 * k + 3] = t * (1.0f - p0[4 * k + 3]); t *= p0[4 * k + 3]; w0[4 * k + 2] = t * (1.0f - p0[4 * k + 2]); t *= p0[4 * k + 2];
                  w0[4 * k + 1] = t * (1.0f - p0[4 * k + 1]); t *= p0[4 * k + 1]; w0[4 * k] = t * (1.0f - p0[4 * k]); }
                { float t = SG[4 + k]; w1[4 * k + 3] = t * (1.0f - p1[4 * k + 3]); t *= p1[4 * k + 3]; w1[4 * k + 2] = t * (1.0f - p1[4 * k + 2]); t *= p1[4 * k + 2];
                  w1[4 * k + 1] = t * (1.0f - p1[4 * k + 1]); t *= p1[4 * k + 1]; w1[4 * k] = t * (1.0f - p1[4 * k]); } }
        }
        LAS float* Tr = Tx + (rd & 1) * 256;
        if (hi == 0) Tr[wave * 32 + r32] = T;
        asm volatile("s_waitcnt lgkmcnt(0)" ::: "memory"); __builtin_amdgcn_s_barrier(); asm volatile("" ::: "memory");
        float F = cacc, all = cacc;
#pragma unroll
        for (int w2 = 7; w2 >= 0; --w2) { const float tv = Tr[w2 * 32 + r32]; all *= tv; if (w2 > wave) F *= tv; }
        cacc = all;
        if (ut >= 0) {
#pragma unroll
            for (int r = 0; r < 16; ++r) { w0[r] *= F; w1[r] *= F; }
            const bf16x8 pa0 = pk8(w0, 0), pa1 = pk8(w0, 8), pa2 = pk8(w1, 0), pa3 = pk8(w1, 8);
            LAS unsigned char* vb = vreg + ((lane >> 4) & 1) * 32 + (lane & 3) * 8 + (4 * hi + ((lane & 15) >> 2)) * 64;
            { bf16x8 vf[8];
#pragma unroll
              for (int ks = 0; ks < 4; ++ks) { vf[2 * ks] = cat8(vtr(vb + ks * 1024), vtr(vb + ks * 1024 + 512)); vf[2 * ks + 1] = cat8(vtr(vb + 4096 + ks * 1024), vtr(vb + 4096 + ks * 1024 + 512)); }
              __builtin_amdgcn_sched_barrier(0);
#pragma unroll
              for (int ks = 0; ks < 4; ++ks) { const bf16x8 pa = ks == 0 ? pa0 : ks == 1 ? pa1 : ks == 2 ? pa2 : pa3;
                  o0 = __builtin_amdgcn_mfma_f32_32x32x16_bf16(pa, vf[2 * ks], o0, 0, 0, 0); o1 = __builtin_amdgcn_mfma_f32_32x32x16_bf16(pa, vf[2 * ks + 1], o1, 0, 0, 0); }
              __builtin_amdgcn_sched_barrier(0); }
            asm volatile("s_waitcnt lgkmcnt(0)" ::: "memory");
        }
#if SB_EARLY
        if (__all(cacc < SB_TINY)) break;
#endif
    }
    __builtin_amdgcn_s_barrier(); asm volatile("" ::: "memory");
    { LAS float* po = (LAS float*)(lds + SSB_V + wave * 8192);
#pragma unroll
        for (int r = 0; r < 16; ++r) { const int q = crow(r, hi); po[q * 64 + r32] = o0[r]; po[q * 64 + 32 + r32] = o1[r]; } }
    asm volatile("s_waitcnt lgkmcnt(0)" ::: "memory"); __builtin_amdgcn_s_barrier(); asm volatile("" ::: "memory");
    { const int t = wave * 64 + lane, q = t >> 4, d4 = (t & 15) * 4; f32x4 s = {0.f, 0.f, 0.f, 0.f};
#pragma unroll
        for (int w2 = 0; w2 < 8; ++w2) s += *(LAS f32x4*)(lds + SSB_V + w2 * 8192 + (q * 64 + d4) * 4);
        unsigned long long pk = (unsigned long long)pg8::cvt_pk_bf16_c(s[0], s[1]) | ((unsigned long long)pg8::cvt_pk_bf16_c(s[2], s[3]) << 32);
        *(unsigned long long*)(OSB + (size_t)(rowbase + q) * SBW + h * 64 + d4) = pk; }
    asm volatile("s_waitcnt lgkmcnt(0)" ::: "memory"); __builtin_amdgcn_s_barrier(); asm volatile("" ::: "memory");
}
__device__ __forceinline__ void sb_sample(CArgs a, int L, LAS unsigned char* lds, int vcu, int G, int wave, int lane) {
    for (int u = vcu; u < DBATCH * NHEAD; u += G) ssb_unit(a, L, u >> 3, u & 7, lds, wave, lane);
}


constexpr size_t WS_PO = 1546 * MiB, WS_PML = 1580 * MiB, WS_SLAB = 1581 * MiB, WS_END2 = 1626 * MiB;
static_assert(WS_PO >= WS_END && WS_PO + (size_t)DBATCH * 8 * NHEAD * DSEQ * LORA * 4 <= WS_PML && WS_PML + (size_t)DBATCH * 8 * NHEAD * DSEQ * 2 * 4 <= WS_SLAB && WS_SLAB + 11 * (size_t)SR * DM * 4 <= WS_END2, "partials map");
__device__ __forceinline__ void smla_unit(CArgs a, int L, int b, int sp, LAS unsigned char* lds, int wave, int lane) {
    const int r32 = lane & 31, hi = lane >> 5, h = wave; const int NT = sp == 7 ? 9 : 8; const int qrow = PR + b * DSEQ;
    const bf16* QLAT = (const bf16*)(a->ws + WS_QLAT); const bf16* QROPE = (const bf16*)(a->ws + WS_QROPE); const bf16* CKVB = (const bf16*)(a->ws + WS_CKVB); const bf16* KRB = (const bf16*)(a->ws + WS_KRB);
    const float* cc = a->in[6] + ((size_t)L * DBATCH + b) * PAST * LORA + (size_t)sp * 512 * LORA; const float* cr = a->in[7] + ((size_t)L * DBATCH + b) * PAST * ROPE + (size_t)sp * 512 * ROPE;
    f32x4 st[6];
#define SM_LOAD(j) do { if ((j) < 8) { const float* p = cc + (unsigned)(((j) * 64 + lane) * LORA + wave * 8); st[0] = *(const f32x4*)p; st[1] = *(const f32x4*)(p + 4); st[2] = *(const f32x4*)(p + 64); st[3] = *(const f32x4*)(p + 68); \
            if (wave < 4) { const float* q = cr + (unsigned)(((j) * 64 + lane) * ROPE + 4 * wave); st[4] = *(const f32x4*)q; st[5] = *(const f32x4*)(q + 16); } } \
        else { st[0] = st[1] = st[2] = (f32x4){0.f, 0.f, 0.f, 0.f}; if (lane < 32) { const bf16* p = CKVB + (size_t)(qrow + lane) * LORA + wave * 8; st[0] = *(const f32x4*)p; st[1] = *(const f32x4*)(p + 64); \
            if (wave < 4) st[2] = *(const f32x4*)(KRB + (size_t)(qrow + lane) * ROPE + wave * 8); } } } while (0)
#define SM_STORE(j, bsel) do { LAS unsigned char* kd = lds + MLA_K + (bsel) * 20480; LAS unsigned char* vd = lds + MLA_V + (bsel) * 16384; v4u x0, x1, x2; \
        if ((j) < 8) { x0 = pack8c(st[0], st[1]); x1 = pack8c(st[2], st[3]); x2 = pack8c(st[4], st[5]); } else { x0 = __builtin_bit_cast(v4u, st[0]); x1 = __builtin_bit_cast(v4u, st[1]); x2 = __builtin_bit_cast(v4u, st[2]); } \
        *(LAS v4u*)(kd + wave * 1024 + lane * 16) = x0; *(LAS v4u*)(kd + (wave + 8) * 1024 + lane * 16) = x1; if (wave < 4) *(LAS v4u*)(kd + (16 + wave) * 1024 + lane * 16) = x2; \
        *(LAS v4u*)(vd + (wave >> 2) * 4096 + lane * 64 + (wave & 3) * 16) = x0; *(LAS v4u*)(vd + ((wave + 8) >> 2) * 4096 + lane * 64 + (wave & 3) * 16) = x1; } while (0)
    SM_LOAD(0);
    bf16x8 qr[10]; { const bf16* qp = QLAT + (size_t)(qrow + r32) * QLW + h * 128 + hi * 8; const bf16* rp = QROPE + (size_t)(qrow + r32) * QRW + h * 32 + hi * 8;
#pragma unroll
        for (int d0 = 0; d0 < 8; ++d0) qr[d0] = *(const bf16x8*)(qp + d0 * 16);
        qr[8] = *(const bf16x8*)rp; qr[9] = *(const bf16x8*)(rp + 16); }
    SM_STORE(0, 0);
    f32x16 o[4]; o[0] = f32x16{}; o[1] = f32x16{}; o[2] = f32x16{}; o[3] = f32x16{};
    float m = -INFINITY, l = 0.f; LAS float* wsf = (LAS float*)(lds + MLA_WS) + wave * 64;
    ATT_WAITBAR();
    for (int jt = 0; jt < NT; ++jt) { const int cur = jt & 1;
        LAS unsigned char* Kb = lds + MLA_K + cur * 20480 + hi * 1024 + r32 * 16;
        f32x16 p0 = {}, p1 = {};
#pragma unroll
        for (int d0 = 0; d0 < 10; ++d0) { const bf16x8 b0 = *(LAS bf16x8*)(Kb + d0 * 2048), b1 = *(LAS bf16x8*)(Kb + d0 * 2048 + 512);
            p0 = __builtin_amdgcn_mfma_f32_32x32x16_bf16(b0, qr[d0], p0, 0, 0, 0); p1 = __builtin_amdgcn_mfma_f32_32x32x16_bf16(b1, qr[d0], p1, 0, 0, 0); }
        if (jt == 8) {
#pragma unroll
            for (int r = 0; r < 16; ++r) p1[r] = -INFINITY; }
        float mx = fmaxf(p0[0], p1[0]);
#pragma unroll
        for (int r = 1; r < 16; ++r) mx = fmaxf(mx, fmaxf(p0[r], p1[r]));
        { const auto sw = __builtin_amdgcn_permlane32_swap(__float_as_uint(mx), __float_as_uint(mx), false, false); mx = fmaxf(__uint_as_float(sw[0]), __uint_as_float(sw[1])); }
        const float mn = fmaxf(m, mx), al = fexp2(m - mn); m = mn;
        float ps = 0.f;
#pragma unroll
        for (int r = 0; r < 16; ++r) { p0[r] = fexp2(p0[r] - mn); p1[r] = fexp2(p1[r] - mn); ps += p0[r] + p1[r]; }
        l = l * al + ps;
        if (__any(al != 1.0f)) {
            if (hi == 0) wsf[r32] = al;
            asm volatile("s_waitcnt lgkmcnt(0)" ::: "memory");
#pragma unroll
            for (int r = 0; r < 16; ++r) { const float f = wsf[crow(r, hi)]; o[0][r] *= f; o[1][r] *= f; o[2][r] *= f; o[3][r] *= f; }
        }
        const bf16x8 pa0 = pk8(p0, 0), pa1 = pk8(p0, 8), pa2 = pk8(p1, 0), pa3 = pk8(p1, 8);
        if (jt + 1 < NT) SM_LOAD(jt + 1);
        LAS unsigned char* vb = lds + MLA_V + cur * 16384 + ((lane >> 4) & 1) * 32 + (lane & 3) * 8 + (4 * hi + ((lane & 15) >> 2)) * 64;
#pragma unroll
        for (int ks = 0; ks < 4; ++ks) { const bf16x8 pa = ks == 0 ? pa0 : ks == 1 ? pa1 : ks == 2 ? pa2 : pa3;
#pragma unroll
            for (int d0 = 0; d0 < 4; ++d0) { const bf16x8 vf = cat8(vtr(vb + d0 * 4096 + ks * 1024), vtr(vb + d0 * 4096 + ks * 1024 + 512)); o[d0] = __builtin_amdgcn_mfma_f32_32x32x16_bf16(pa, vf, o[d0], 0, 0, 0); } }
        if (jt + 1 < NT) SM_STORE(jt + 1, cur ^ 1);
        ATT_WAITBAR();
    }
#undef SM_LOAD
#undef SM_STORE
    { const auto sw = __builtin_amdgcn_permlane32_swap(__float_as_uint(l), __float_as_uint(l), false, false); l = __uint_as_float(sw[0]) + __uint_as_float(sw[1]); }
    const size_t ub = ((size_t)(b * 8 + sp) * NHEAD + h) * DSEQ;
    float* PO = (float*)(a->ws + WS_PO) + ub * LORA; float* PML = (float*)(a->ws + WS_PML) + ub * 2;
    if (hi == 0) { PML[r32 * 2] = m; PML[r32 * 2 + 1] = l; }
#pragma unroll
    for (int r = 0; r < 16; ++r) { const int q = crow(r, hi);
#pragma unroll
        for (int d0 = 0; d0 < 4; ++d0) PO[(size_t)q * LORA + d0 * 32 + r32] = o[d0][r]; }
}
__device__ __forceinline__ void mla_sample(CArgs a, int L, LAS unsigned char* lds, int vcu, int G, int wave, int lane) {
    for (int u = vcu; u < DBATCH * 8; u += G) smla_unit(a, L, u >> 3, u & 7, lds, wave, lane);
}
__device__ __forceinline__ void smla_combine(CArgs a, int vcu, int G, int wave, int lane) {
    const int gw = vcu * 8 + wave, NGW = G * 8; bf16* OLAT = (bf16*)(a->ws + WS_OLAT); const float* PO = (const float*)(a->ws + WS_PO); const float* PML = (const float*)(a->ws + WS_PML);
    for (int it = gw; it < SR * NHEAD; it += NGW) { const int row = it >> 3, h = it & 7, b = row >> 5, q = row & 31;
        float ms[8], ls[8], M = -INFINITY;
#pragma unroll
        for (int s = 0; s < 8; ++s) { const size_t ub = (((size_t)(b * 8 + s) * NHEAD + h) * DSEQ + q); ms[s] = PML[ub * 2]; ls[s] = PML[ub * 2 + 1]; M = fmaxf(M, ms[s]); }
        float den = 0.f, o0 = 0.f, o1 = 0.f;
#pragma unroll
        for (int s = 0; s < 8; ++s) { const float w = fexp2(ms[s] - M); den += w * ls[s]; const size_t ub = (((size_t)(b * 8 + s) * NHEAD + h) * DSEQ + q);
            const float2 v = *(const float2*)(PO + ub * LORA + 2 * lane); o0 += w * v.x; o1 += w * v.y; }
        const float id = 1.0f / den;
        *(unsigned*)(OLAT + (size_t)(PR + row) * QLW + h * 128 + 2 * lane) = pg8::cvt_pk_bf16(o0 * id, o1 * id);
    }
}

__device__ __forceinline__ int lane_now() { int l; asm volatile("v_mbcnt_lo_u32_b32 %0, -1, 0\n\tv_mbcnt_hi_u32_b32 %0, -1, %0" : "=v"(l)); return l; }
__device__ __forceinline__ int fresh_bx(int bx) { asm volatile("" : "+s"(bx)); return bx; }
__device__ __forceinline__ CArgs fresh_args() { CArgs p = (CArgs)__builtin_amdgcn_kernarg_segment_ptr(); asm volatile("" : "+s"(p)); return p; }
__global__ void __launch_bounds__(512, 2) fwd(Args args_byval) {
    extern __shared__ __attribute__((aligned(16))) unsigned char lds_raw[];
    LAS unsigned char* lds = (LAS unsigned char*)lds_raw;
    volatile LAS unsigned* MISC = (volatile LAS unsigned*)(lds + MISC_OFF);
    const int wave = __builtin_amdgcn_readfirstlane((int)threadIdx.x >> 6);
    const int G = gridDim.x; const int bx = blockIdx.x; const int vcu = (G % 8 == 0) ? (bx % 8) * (G / 8) + bx / 8 : bx;
    if (threadIdx.x < 32) MISC[threadIdx.x] = 0u;
    __syncthreads();
    XcdBarrier bar = xcd_barrier_post((unsigned*)(fresh_args()->ws + WS_CTL) + CW_BAR, MISC + 8);
    const int lo = fresh_args()->ph_lo, hi = fresh_args()->ph_hi;
#define IN(k) (lo <= (k) && (k) < hi)
#define SEAM(k) do { if (IN(k) && IN((k) + 1)) xcd_barrier(bar); } while (0)
#define SEAM_LOCAL(k) do { } while (0)
    const int gw = vcu * 8 + wave, NGW = G * 8;

    if (IN(0)) REP(2) p0_prologue(fresh_args(), lds, vcu, G, fresh_bx(wave), lane_now());
    SEAM(0);
#pragma unroll 1
    for (int L = 0; L < DEPTH; ++L) {
        const int pb = 2 + 12 * L;
        if (IN(pb + 0)) REP(1) {
            CArgs a = fresh_args(); unsigned char* ws = a->ws;
            pg8::Gemm g{(const bf16*)(ws + WS_XN), (const bf16*)(ws + WS_W + (size_t)L * WL + W_IN), R, NIN, DM, DM}; Ord<NIN / 256> S; S.init(G, fresh_bx(bx));
            EpiIn E{ws, a->out, L, a->in[10] + (size_t)L * LORA, (LAS float*)(lds + XL_OFF)};
            pg8::gemm_phase<EpiIn, decltype(S), true, true>(lds, g, S, E, fresh_bx(wave));
        }
        SEAM(pb + 0);
        if (IN(pb + 1)) REP(0) {
#if FAST_SB
            REP(6) sb_prompt(fresh_args(), lds, vcu, G, fresh_bx(wave), lane_now());
#endif
#if FAST_MLA
            REP(7) mla_prompt(fresh_args(), lds, vcu, G, fresh_bx(wave), lane_now());
#endif
#if FAST_SSB
            REP(8) sb_sample(fresh_args(), L, lds, vcu, G, fresh_bx(wave), lane_now());
#endif
#if FAST_SMLA
            REP(9) mla_sample(fresh_args(), L, lds, vcu, G, fresh_bx(wave), lane_now());
#endif
#if !(FAST_SB && FAST_SSB)
            naive_sb(fresh_args(), L, vcu, G, fresh_bx(wave), lane_now());
#endif
#if !(FAST_MLA && FAST_SMLA)
            naive_mla(fresh_args(), L, vcu, G, fresh_bx(wave), lane_now());
#endif
        }
        SEAM(pb + 1);
        if (IN(pb + 2)) {
#if FAST_SMLA
            smla_combine(fresh_args(), vcu, G, fresh_bx(wave), lane_now());
#endif
            unsigned char* ws = fresh_args()->ws;
            pg8::Gemm g{(const bf16*)(ws + WS_OSB), (const bf16*)(ws + WS_W + (size_t)L * WL + W_SB), R, DM, SBW, SBW}; Ord<DM / 256> S; S.init(G, fresh_bx(bx));
            EpiGate<false> E{(const bf16*)(ws + WS_GA), (bf16*)(ws + WS_MG)};
            pg8::gemm_phase<EpiGate<false>, decltype(S), true, true>(lds, g, S, E, fresh_bx(wave));
        }
        SEAM_LOCAL(pb + 2);
        if (IN(pb + 3)) {
            unsigned char* ws = fresh_args()->ws;
            pg8::Gemm g{(const bf16*)(ws + WS_OLAT), (const bf16*)(ws + WS_W + (size_t)L * WL + W_YB), R, DM, QLW, QLW}; Ord<DM / 256> S; S.init(G, fresh_bx(bx));
            EpiGate<true> E{(const bf16*)(ws + WS_GB), (bf16*)(ws + WS_MG)};
            pg8::gemm_phase<EpiGate<true>, decltype(S), true, true>(lds, g, S, E, fresh_bx(wave));
        }
        SEAM(pb + 3);
        if (IN(pb + 4)) REP(5) {
            unsigned char* ws = fresh_args()->ws;
            { pg8::Gemm g{(const bf16*)(ws + WS_MG), (const bf16*)(ws + WS_W + (size_t)L * WL + W_OUT), PR, DM, DM, DM}; Ord<DM / 256, PR / 256, 8> S; S.init(G, fresh_bx(bx));
              EpiF32 E{(float*)(ws + WS_MIX), DM};
              pg8::gemm_phase<EpiF32, decltype(S), true, true>(lds, g, S, E, fresh_bx(wave)); }
#if SPLITK
            { pg8::Gemm g{(const bf16*)(ws + WS_MG), (const bf16*)(ws + WS_W + (size_t)L * WL + W_OUT), R, DM, fresh_bx(256), DM}; OrdSplit<4> S; S.init(G, fresh_bx(bx));
              EpiSlab E{(float*)(ws + WS_SLAB), DM};
              pg8::gemm_phase<EpiSlab, decltype(S), true, true>(lds, g, S, E, fresh_bx(wave)); }
#else
            { pg8::Gemm g{(const bf16*)(ws + WS_MG), (const bf16*)(ws + WS_W + (size_t)L * WL + W_OUT), R, DM, DM, DM}; OrdSplit<1> S; S.init(G, fresh_bx(bx));
              EpiF32 E{(float*)(ws + WS_MIX), DM};
              pg8::gemm_phase<EpiF32, decltype(S), true, true>(lds, g, S, E, fresh_bx(wave)); }
#endif
        }
        SEAM(pb + 4);
        if (IN(pb + 5)) {
            CArgs a = fresh_args(); float* X = a->out + O_Y; const float* MIX = (const float*)(a->ws + WS_MIX); bf16* XN = (bf16*)(a->ws + WS_XN);
            const float* g1 = a->in[17] + (size_t)L * DM; const float* g2 = a->in[18] + (size_t)L * DM;
            const int lane = lane_now();
            const float* SL = (const float*)(a->ws + WS_SLAB);
            for (int m = gw; m < R; m += NGW) { const bool sp = SPLITK && m >= PR; const float* xin = L > 0 ? X + (size_t)m * DM : (m < PR ? a->in[0] + (size_t)m * DM : a->in[1] + (size_t)(m - PR) * DM);
                row_op(lane, xin, sp ? SL + (size_t)(m - PR) * DM : MIX + (size_t)m * DM, g1, X + (size_t)m * DM, XN + (size_t)m * DM, g2, sp ? 4 : 1, (size_t)SR * DM); }
        }
        SEAM(pb + 5);
        if (IN(pb + 6)) REP(1) {
            CArgs a = fresh_args(); unsigned char* ws = a->ws;
            pg8::Gemm g{(const bf16*)(ws + WS_XN), (const bf16*)(ws + WS_W + (size_t)L * WL + W_UP), R, UPW, DM, DM}; Ord<UPW / 256> S; S.init(G, fresh_bx(bx));
            EpiBf E{(bf16*)(ws + WS_U), UPW, a->out + O_CONV_P + (size_t)L * NB * 2 * UPW, a->out + O_CONV_S + (size_t)L * DBATCH * 2 * UPW};
            pg8::gemm_phase<EpiBf, decltype(S), true, true>(lds, g, S, E, fresh_bx(wave));
        }
        SEAM(pb + 6);
#ifndef NO_CONV
        if (IN(pb + 7)) {
            REP(3) conv_phase(fresh_args(), L, vcu, G, fresh_bx(wave), lane_now()); }
#endif
        SEAM(pb + 7);
        if (IN(pb + 8)) REP(4) {
            unsigned char* ws = fresh_args()->ws;
            { pg8::Gemm g{(const bf16*)(ws + WS_ACT), (const bf16*)(ws + WS_W + (size_t)L * WL + W_DOWN), PR, DM, DFF, DFF}; Ord<DM / 256, PR / 256, 8> S; S.init(G, fresh_bx(bx));
              EpiF32 E{(float*)(ws + WS_MIX), DM};
              pg8::gemm_phase<EpiF32, decltype(S), true, true>(lds, g, S, E, fresh_bx(wave)); }
#if SPLITK
            { pg8::Gemm g{(const bf16*)(ws + WS_ACT), (const bf16*)(ws + WS_W + (size_t)L * WL + W_DOWN), R, DM, fresh_bx(256), DFF}; OrdSplit<11> S; S.init(G, fresh_bx(bx));
              EpiSlab E{(float*)(ws + WS_SLAB), DM};
              pg8::gemm_phase<EpiSlab, decltype(S), true, true>(lds, g, S, E, fresh_bx(wave)); }
#else
            { pg8::Gemm g{(const bf16*)(ws + WS_ACT), (const bf16*)(ws + WS_W + (size_t)L * WL + W_DOWN), R, DM, DFF, DFF}; OrdSplit<1> S; S.init(G, fresh_bx(bx));
              EpiF32 E{(float*)(ws + WS_MIX), DM};
              pg8::gemm_phase<EpiF32, decltype(S), true, true>(lds, g, S, E, fresh_bx(wave)); }
#endif
        }
        SEAM(pb + 8);
        if (IN(pb + 9)) {
            CArgs a = fresh_args(); float* X = a->out + O_Y; const float* MIX = (const float*)(a->ws + WS_MIX); bf16* XB = (bf16*)(a->ws + WS_XB);
            const float* g1 = a->in[19] + (size_t)L * DM;
            const int lane = lane_now();
            const float* SL = (const float*)(a->ws + WS_SLAB);
            for (int m = gw; m < R; m += NGW) { const bool sp = SPLITK && m >= PR; row_op(lane, X + (size_t)m * DM, sp ? SL + (size_t)(m - PR) * DM : MIX + (size_t)m * DM, g1, X + (size_t)m * DM, XB + (size_t)m * DM, nullptr, sp ? 11 : 1, (size_t)SR * DM); }
        }
        SEAM(pb + 9);
        if (IN(pb + 10)) {
            CArgs a = fresh_args(); unsigned char* ws = a->ws;
            { pg8::Gemm g{(const bf16*)(ws + WS_PB) + (size_t)L * R * DPLE, (const bf16*)(ws + WS_W + (size_t)L * WL + W_PP), R, DM, DPLE, DPLE}; Ord<DM / 256> S; S.init(G, fresh_bx(bx));
              EpiBf E{(bf16*)(ws + WS_PP) + (size_t)L * R * DM, DM, nullptr, nullptr};
              pg8::gemm_phase<EpiBf, decltype(S), true, true>(lds, g, S, E, fresh_bx(wave)); }
            pg8::Gemm g{(const bf16*)(ws + WS_XB), (const bf16*)(ws + WS_W + (size_t)L * WL + W_PG), R, DM, DM, DM}; Ord<DM / 256> S; S.init(G, fresh_bx(bx));
            EpiPle E{a->out + O_Y, (const bf16*)(ws + WS_PP) + (size_t)L * R * DM};
            pg8::gemm_phase<EpiPle, decltype(S), true, true>(lds, g, S, E, fresh_bx(wave));
        }
        SEAM(pb + 10);
        if (IN(pb + 11) && L + 1 < DEPTH) {
            CArgs a = fresh_args(); const float* X = a->out + O_Y; bf16* XN = (bf16*)(a->ws + WS_XN); const float* g2 = a->in[16] + (size_t)(L + 1) * DM;
            const int lane = lane_now();
            for (int m = gw; m < R; m += NGW) row_op(lane, X + (size_t)m * DM, nullptr, nullptr, nullptr, XN + (size_t)m * DM, g2);
        }
        SEAM(pb + 11);
    }

#ifdef MK_DUMP
    {
        __syncthreads(); const int lane = lane_now(); unsigned char* ws = fresh_args()->ws; float* X = fresh_args()->out + O_Y;
        if (fresh_args()->ph_lo == NPHASE)
        for (int m = gw; m < R; m += NGW) for (int j = 0; j < 16; ++j) { const int c = j * 64 + lane; float v = 0.f;
            if (MK_DUMP & 1) v += bf2f(((const bf16*)(ws + WS_OSB))[(size_t)m * SBW + (c & 511)]);
            if (MK_DUMP & 2) v += bf2f(((const bf16*)(ws + WS_OLAT))[(size_t)m * QLW + c]);
            if (MK_DUMP & 4) v += bf2f(((const bf16*)(ws + WS_GA))[(size_t)m * DM + c]) + bf2f(((const bf16*)(ws + WS_GB))[(size_t)m * DM + c]);
            if (MK_DUMP & 8) v += bf2f(((const bf16*)(ws + WS_QLAT))[(size_t)m * QLW + c]) + bf2f(((const bf16*)(ws + WS_QSB))[(size_t)m * SBW + (c & 511)]) + bf2f(((const bf16*)(ws + WS_QROPE))[(size_t)m * QRW + (c & 255)]);
            if (MK_DUMP & 16) v += bf2f(((const bf16*)(ws + WS_PP))[(size_t)m * DM + c]) + bf2f(((const bf16*)(ws + WS_PP))[((size_t)R + m) * DM + c]);
            if (MK_DUMP & 32) v += bf2f(((const bf16*)(ws + WS_MG))[(size_t)m * DM + c]);
            if (MK_DUMP & 64) v += ((const float*)(ws + WS_MIX))[(size_t)m * DM + c];
            X[(size_t)m * DM + c] = v; }
    }
#endif
#undef IN
#undef SEAM
}

extern "C" void kernel_launch(void* const* d_in, const int* in_sizes, int n_in, void* d_out, int out_size, void* d_ws, size_t ws_size, hipStream_t stream) {
    static int grid = 0;
    if (grid == 0) {
        if (n_in != 26 || (size_t)out_size != O_END || ws_size < WS_END2) { fprintf(stderr, "kernel_launch: unexpected shapes (n_in %d, out %d, ws %zu); nothing launched\n", n_in, out_size, ws_size); grid = -1; return; }
        int dev = 0, cus = 0, per_cu = 0;
        if (hipGetDevice(&dev) != hipSuccess || hipDeviceGetAttribute(&cus, hipDeviceAttributeMultiprocessorCount, dev) != hipSuccess) { grid = -1; return; }
        if (hipFuncSetAttribute((const void*)fwd, hipFuncAttributeMaxDynamicSharedMemorySize, LDS_BYTES) != hipSuccess) { fprintf(stderr, "kernel_launch: hipFuncSetAttribute failed\n"); grid = -1; return; }
        if (hipOccupancyMaxActiveBlocksPerMultiprocessor(&per_cu, (const void*)fwd, 512, LDS_BYTES) != hipSuccess || per_cu < 1) fprintf(stderr, "kernel_launch: occupancy query reports %d\n", per_cu);
        (void)hipGetLastError();
        grid = cus;
    }
    if (grid < 0) return;
    if (hipMemsetAsync((char*)d_ws + WS_CTL, 0, CTL_ZERO_BYTES, stream) != hipSuccess) return;
    Args a{};
    for (int i = 0; i < 26; ++i) a.in[i] = (const float*)d_in[i];
    a.out = (float*)d_out; a.ws = (unsigned char*)d_ws;
#if MK_PER_PHASE
    for (int ph = 0; ph < NPHASE; ++ph) { a.ph_lo = ph; a.ph_hi = ph + 1; hipLaunchKernelGGL(fwd, dim3(grid), dim3(512), LDS_BYTES, stream, a); }
#ifdef MK_DUMP
    a.ph_lo = NPHASE; a.ph_hi = NPHASE + 1; hipLaunchKernelGGL(fwd, dim3(grid), dim3(512), LDS_BYTES, stream, a);
#endif
#else
    a.ph_lo = 0; a.ph_hi = NPHASE; hipLaunchKernelGGL(fwd, dim3(grid), dim3(512), LDS_BYTES, stream, a);
#endif
}
```
